# Optimizing an MI355X kernel written in HIP

```python
import jax, jax.numpy as jnp
from jax import lax
import numpy as np

D_MODEL = 1024
BATCH = 8
SEQ = 8192
DEPTH = 4

N_A_LAYERS = DEPTH // 2
N_B_LAYERS = DEPTH - N_A_LAYERS
D_FF = 2816
FFN_HALF = 0.5
EPS = 1e-6
MEM_TOKENS = 256
MEM_HEADS = 4
MEM_HEAD_DIM = 64
MEM_WIDTH = MEM_HEADS * MEM_HEAD_DIM
MIX_WIDTH = D_MODEL - MEM_WIDTH
CONV_CH = MIX_WIDTH
CONV_WIDTH = 3
MLA_HEADS = 6
QK_NOPE_DIM = 128
QK_ROPE_DIM = 64
QK_HEAD_DIM = QK_NOPE_DIM + QK_ROPE_DIM
V_HEAD_DIM = 128
Q_LORA_RANK = 384
KV_LORA_RANK = 256
ROPE_THETA = 10000.0
Q_BLOCK = 128

kernel_name = "yoco_shortconv_mla_macaron_memory"


def rms_norm(x, g):
    xf = x.astype(jnp.float32)
    y = xf * lax.rsqrt(jnp.mean(xf * xf, axis=-1, keepdims=True) + EPS)
    return (y * g.astype(jnp.float32)).astype(x.dtype)


def swiglu(h, w13, w2):
    gate, up = jnp.split(h @ w13, 2, axis=-1)
    return (jax.nn.silu(gate) * up) @ w2


def rope_tables(positions):
    inv_freq = ROPE_THETA ** (-jnp.arange(0, QK_ROPE_DIM, 2, dtype=jnp.float32) / QK_ROPE_DIM)
    ang = positions.astype(jnp.float32)[..., None] * inv_freq
    return jnp.cos(ang), jnp.sin(ang)


def apply_rope(x, cos, sin):
    x1, x2 = jnp.split(x, 2, axis=-1)
    return jnp.concatenate([x1 * cos - x2 * sin, x2 * cos + x1 * sin], axis=-1).astype(x.dtype)


def causal_short_conv(u, w):
    seq = u.shape[1]
    up = jnp.pad(u, ((0, 0), (CONV_WIDTH - 1, 0), (0, 0)))
    y = w[0] * up[:, 0:seq]
    for tap in range(1, CONV_WIDTH):
        y = y + w[tap] * up[:, tap:tap + seq]
    return y


def short_conv_mixer(h, w_in, conv_w):
    proj = h @ w_in
    gate_b, gate_c, xt, q_mem = jnp.split(proj, [CONV_CH, 2 * CONV_CH, 3 * CONV_CH], axis=-1)
    y = gate_b * causal_short_conv(gate_c * xt, conv_w)
    return y, q_mem


def memory_attention(q_mem, mem, mem_norm_g, w_mem_kv, g_q, g_k):
    b, s, _ = q_mem.shape
    q = rms_norm(q_mem.reshape(b, s, MEM_HEADS, MEM_HEAD_DIM), g_q)
    k, v = jnp.split(rms_norm(mem, mem_norm_g) @ w_mem_kv, 2, axis=-1)
    m = mem.shape[1]
    k = rms_norm(k.reshape(b, m, MEM_HEADS, MEM_HEAD_DIM), g_k)
    v = v.reshape(b, m, MEM_HEADS, MEM_HEAD_DIM)
    scores = jnp.einsum('bqhd,bmhd->bhqm', q, k).astype(jnp.float32) * (MEM_HEAD_DIM ** -0.5)
    p = jax.nn.softmax(scores, axis=-1).astype(v.dtype)
    o = jnp.einsum('bhqm,bmhd->bqhd', p, v)
    return o.reshape(b, s, MEM_WIDTH)


def shared_mla_kv(x, kv_norm_g, w_dkv, g_ckv, w_ukv, w_kr, g_k_nope, g_k_rope, cos, sin):
    b, s, _ = x.shape
    h = rms_norm(x, kv_norm_g)
    c_kv = rms_norm(h @ w_dkv, g_ckv)
    kv = (c_kv @ w_ukv).reshape(b, s, MLA_HEADS, QK_NOPE_DIM + V_HEAD_DIM)
    k_nope = rms_norm(kv[..., :QK_NOPE_DIM], g_k_nope)
    v = kv[..., QK_NOPE_DIM:]
    k_rope = apply_rope(rms_norm(h @ w_kr, g_k_rope), cos, sin)
    return k_nope, k_rope, v


def mla_queries(h, w_in, g_q_lora, w_uq, g_q_nope, g_q_rope, cos, sin):
    b, s, _ = h.shape
    c_q, q_mem = jnp.split(h @ w_in, [Q_LORA_RANK], axis=-1)
    q = (rms_norm(c_q, g_q_lora) @ w_uq).reshape(b, s, MLA_HEADS, QK_HEAD_DIM)
    q_nope = rms_norm(q[..., :QK_NOPE_DIM], g_q_nope)
    q_rope = apply_rope(rms_norm(q[..., QK_NOPE_DIM:], g_q_rope), cos[:, :, None, :], sin[:, :, None, :])
    return q_nope, q_rope, q_mem


def causal_mla_attention(q_nope, q_rope, k_nope, k_rope, v):
    b, seq = q_nope.shape[0], q_nope.shape[1]
    scale = QK_HEAD_DIM ** -0.5
    outs = []
    for blk in range(seq // Q_BLOCK):
        start, end = blk * Q_BLOCK, (blk + 1) * Q_BLOCK
        qn, qr = q_nope[:, start:end], q_rope[:, start:end]
        scores = (jnp.einsum('bqhd,bkhd->bhqk', qn, k_nope[:, :end])
                  + jnp.einsum('bqhd,bkd->bhqk', qr, k_rope[:, :end])).astype(jnp.float32) * scale
        mask = (start + jnp.arange(Q_BLOCK))[:, None] >= jnp.arange(end)[None, :]
        scores = jnp.where(mask, scores, -jnp.inf)
        p = jax.nn.softmax(scores, axis=-1).astype(v.dtype)
        outs.append(jnp.einsum('bhqk,bkhd->bqhd', p, v[:, :end]))
    o = jnp.concatenate(outs, axis=1)
    return o.reshape(b, seq, MLA_HEADS * V_HEAD_DIM)


def setup_inputs(seed: int = 0) -> dict:
    key = jax.random.key(seed)
    ks = jax.random.split(key, 26)
    f32 = jnp.float32

    def w(k, shape, fan_in):
        return jax.random.normal(k, shape, f32) * (fan_in ** -0.5)

    def g(k, shape):
        return 1.0 + 0.02 * jax.random.normal(k, shape, f32)

    offsets = jax.random.randint(ks[2], (BATCH, 1), 0, 1024, dtype=jnp.int32)
    positions = (offsets + jnp.arange(SEQ, dtype=jnp.int32)[None, :]).astype(jnp.int32)
    return {
        'x': jax.random.normal(ks[0], (BATCH, SEQ, D_MODEL), f32),
        'mem': jax.random.normal(ks[1], (BATCH, MEM_TOKENS, D_MODEL), f32),
        'positions': positions,
        'norm_g': g(ks[3], (DEPTH, 3, D_MODEL)),
        'ffn_w13': w(ks[4], (DEPTH, 2, D_MODEL, 2 * D_FF), D_MODEL),
        'ffn_w2': w(ks[5], (DEPTH, 2, D_FF, D_MODEL), D_FF),
        'w_out': w(ks[6], (DEPTH, D_MODEL, D_MODEL), D_MODEL),
        'mem_norm_g': g(ks[7], (DEPTH, D_MODEL)),
        'w_mem_kv': w(ks[8], (DEPTH, D_MODEL, 2 * MEM_WIDTH), D_MODEL),
        'g_mem_q': g(ks[9], (DEPTH, MEM_HEAD_DIM)),
        'g_mem_k': g(ks[10], (DEPTH, MEM_HEAD_DIM)),
        'conv_w_in': w(ks[11], (N_A_LAYERS, D_MODEL, 3 * CONV_CH + MEM_WIDTH), D_MODEL),
        'conv_w': w(ks[12], (N_A_LAYERS, CONV_WIDTH, CONV_CH), CONV_WIDTH),
        'mla_w_in': w(ks[13], (N_B_LAYERS, D_MODEL, Q_LORA_RANK + MEM_WIDTH), D_MODEL),
        'g_q_lora': g(ks[14], (N_B_LAYERS, Q_LORA_RANK)),
        'w_uq': w(ks[15], (N_B_LAYERS, Q_LORA_RANK, MLA_HEADS * QK_HEAD_DIM), Q_LORA_RANK),
        'g_q_nope': g(ks[16], (N_B_LAYERS, QK_NOPE_DIM)),
        'g_q_rope': g(ks[17], (N_B_LAYERS, QK_ROPE_DIM)),
        'kv_norm_g': g(ks[18], (D_MODEL,)),
        'w_dkv': w(ks[19], (D_MODEL, KV_LORA_RANK), D_MODEL),
        'g_ckv': g(ks[20], (KV_LORA_RANK,)),
        'w_ukv': w(ks[21], (KV_LORA_RANK, MLA_HEADS * (QK_NOPE_DIM + V_HEAD_DIM)), KV_LORA_RANK),
        'w_kr': w(ks[22], (D_MODEL, QK_ROPE_DIM), D_MODEL),
        'g_k_nope': g(ks[23], (QK_NOPE_DIM,)),
        'g_k_rope': g(ks[24], (QK_ROPE_DIM,)),
    }


def reference(x, mem, positions, norm_g, ffn_w13, ffn_w2, w_out, mem_norm_g, w_mem_kv, g_mem_q, g_mem_k,
              conv_w_in, conv_w, mla_w_in, g_q_lora, w_uq, g_q_nope, g_q_rope,
              kv_norm_g, w_dkv, g_ckv, w_ukv, w_kr, g_k_nope, g_k_rope):
    cos, sin = rope_tables(positions)
    shared = None
    for layer in range(DEPTH):
        if layer == N_A_LAYERS:
            shared = shared_mla_kv(x, kv_norm_g, w_dkv, g_ckv, w_ukv, w_kr, g_k_nope, g_k_rope, cos, sin)
        x = x + FFN_HALF * swiglu(rms_norm(x, norm_g[layer, 0]), ffn_w13[layer, 0], ffn_w2[layer, 0])
        h = rms_norm(x, norm_g[layer, 1])
        if layer < N_A_LAYERS:
            y_mix, q_mem = short_conv_mixer(h, conv_w_in[layer], conv_w[layer])
        else:
            j = layer - N_A_LAYERS
            q_nope, q_rope, q_mem = mla_queries(h, mla_w_in[j], g_q_lora[j], w_uq[j], g_q_nope[j], g_q_rope[j], cos, sin)
            k_nope, k_rope, v = shared
            y_mix = causal_mla_attention(q_nope, q_rope, k_nope, k_rope, v)
        y_mem = memory_attention(q_mem, mem, mem_norm_g[layer], w_mem_kv[layer], g_mem_q[layer], g_mem_k[layer])
        x = x + jnp.concatenate([y_mix, y_mem], axis=-1) @ w_out[layer]
        x = x + FFN_HALF * swiglu(rms_norm(x, norm_g[layer, 2]), ffn_w13[layer, 1], ffn_w2[layer, 1])
    return x
```

```cpp
#include <hip/hip_runtime.h>
#include <hip/hip_cooperative_groups.h>
#include <cstdio>
#include <cstdint>
namespace cg = cooperative_groups;
namespace pg8 {
#define PG8_LAS __attribute__((address_space(3)))
typedef unsigned short bf16_t;
typedef short bf16x8 __attribute__((ext_vector_type(8)));
typedef float f32x4 __attribute__((ext_vector_type(4)));
typedef unsigned u32x4 __attribute__((ext_vector_type(4)));
constexpr int BM = 256, BK = 64, HALF = 128, HTB = HALF * BK * 2  , STAGE_BYTES = 8 * HTB, NXCD = 8, WGM = 8;

__host__ __device__ __forceinline__ int lds_byte(int r, int c) { const int st = (r >> 4) * 2 + (c >> 5), rr = r & 15, cc = c & 31, ob = rr * 64 + cc * 2; return st * 1024 + (ob ^ (((ob >> 9) & 1) << 5)); }
__host__ __device__ __forceinline__ void stage_rc(int b, int& R, int& C) { const int st = b / 1024, sb = b % 1024, swz = sb ^ (((sb >> 9) & 1) << 5); R = (st >> 1) * 16 + swz / 64; C = (st & 1) * 32 + (swz % 64) / 2; }
__host__ __device__ __forceinline__ int perm32(int rho) { const int n = rho >> 4, i = rho & 15; return 8 * (i >> 2) + 4 * n + (i & 3); }

struct Unit { int pm, pn; };
struct Gemm { const bf16_t* A; const bf16_t* Bt; int M, N, K, lda; };

struct StaticOrder {
    int nM, nN, nwg, G, c;
    __host__ __device__ void init(int M, int N, int G_, int c_) { nM = M / BM; nN = N / BM; nwg = nM * nN; G = G_; c = c_; }
    __host__ __device__ bool next(int i, Unit& u) const {
        const long L = (long)i * G + c; if (L >= nwg) return false;
        int wgid = (int)L; { const int q = nwg / NXCD, r = nwg % NXCD, xcd = wgid % NXCD, off = wgid / NXCD; wgid = (xcd < r ? xcd * (q + 1) : r * (q + 1) + (xcd - r) * q) + off; }
        const int nig = WGM * nN, gid = wgid / nig, fm = gid * WGM, gsz = (nM - fm) < WGM ? (nM - fm) : WGM;
        u.pm = fm + ((wgid % nig) % gsz); u.pn = (wgid % nig) / gsz; return true;
    }
    __device__ __forceinline__ void a_ready(const Unit&) const {}
    __device__ __forceinline__ void done(const Unit&) const {}
};

__device__ __forceinline__ unsigned cvt_pk_bf16(float lo, float hi) { unsigned r; asm volatile("v_cvt_pk_bf16_f32 %0, %1, %2" : "=v"(r) : "v"(lo), "v"(hi)); return r; }
typedef float f32x2 __attribute__((ext_vector_type(2)));
template <int XM> __device__ __forceinline__ float swz_xor(float v) { return __builtin_bit_cast(float, __builtin_amdgcn_ds_swizzle(__builtin_bit_cast(int, v), (XM << 10) | 0x1f)); }
__device__ __forceinline__ float add_xor32(float v) {
    auto r = __builtin_amdgcn_permlane32_swap(__float_as_uint(v), __float_as_uint(v), false, false); const unsigned r0 = r[0], r1 = r[1]; return __uint_as_float(r0) + __uint_as_float(r1); }
__device__ __forceinline__ float add_xor16_32(float s) { s += swz_xor<16>(s); return add_xor32(s); }
__device__ __forceinline__ float row_rs(const float* ssq, int stride, int nslots, float inv_n, int row, int fq) {
    const f32x4* p = (const f32x4*)(ssq + (size_t)row * stride); float s = 0.f;
    for (int i = 4 * fq; i < nslots; i += 16) { const f32x4 v = p[i >> 2]; s += (v[0] + v[1]) + (v[2] + v[3]); }
    s = add_xor16_32(s);
    return __builtin_amdgcn_rsqf(s * inv_n + 1e-6f);
}
__device__ __forceinline__ float sig_mul(float g, float u) {
    const float e = __builtin_amdgcn_exp2f(-1.4426950408889634f * g); return g * __builtin_amdgcn_rcpf(1.0f + e) * u;
}
struct EpiSwiglu {
    static constexpr bool PERM = true, AFTER_DRAIN = false;
    bf16_t* O; int ldc; const float* ssq;
    __device__ __forceinline__ void operator()(const f32x4 (&acc)[2][2][4][2], const Unit& u, int wr, int wc, int fr, int fq) const {
        const int row0 = u.pm * BM + wr * 64 + fr, col0 = u.pn * HALF + wc * 32 + 8 * fq;
        float rs[2][4];
#pragma unroll
        for (int ai = 0; ai < 2; ++ai)
#pragma unroll
            for (int m = 0; m < 4; ++m) rs[ai][m] = row_rs(ssq, 16, 16, 1.0f / 1024.0f, row0 + ai * HALF + m * 16, fq);
#pragma unroll
        for (int ai = 0; ai < 2; ++ai)
#pragma unroll
            for (int m = 0; m < 4; ++m) { const int row = row0 + ai * HALF + m * 16; const float r_ = rs[ai][m];
                const f32x4 g0 = acc[ai][0][m][0] * r_, g1 = acc[ai][0][m][1] * r_, u0 = acc[ai][1][m][0] * r_, u1 = acc[ai][1][m][1] * r_;
                u32x4 w; w.x = cvt_pk_bf16(sig_mul(g0[0], u0[0]), sig_mul(g0[1], u0[1])); w.y = cvt_pk_bf16(sig_mul(g0[2], u0[2]), sig_mul(g0[3], u0[3]));
                w.z = cvt_pk_bf16(sig_mul(g1[0], u1[0]), sig_mul(g1[1], u1[1])); w.w = cvt_pk_bf16(sig_mul(g1[2], u1[2]), sig_mul(g1[3], u1[3]));
                *(u32x4*)(O + (size_t)row * ldc + col0) = w; }
    }
};
typedef _Float16 h16x8 __attribute__((ext_vector_type(8)));
template <bool F16> __device__ __forceinline__ f32x4 mma16(bf16x8 a, bf16x8 b, f32x4 c) {
    if constexpr (F16) return __builtin_amdgcn_mfma_f32_16x16x32_f16(__builtin_bit_cast(h16x8, a), __builtin_bit_cast(h16x8, b), c, 0, 0, 0);
    else return __builtin_amdgcn_mfma_f32_16x16x32_bf16(a, b, c, 0, 0, 0);
}
__device__ __forceinline__ float bf_lo(unsigned w) { return __builtin_bit_cast(float, w << 16); }
__device__ __forceinline__ float bf_hi(unsigned w) { return __builtin_bit_cast(float, w & 0xffff0000u); }
struct EpiResid {
    static constexpr bool PERM = true, AFTER_DRAIN = false;
    float* fout; _Float16* XH; float* ssq; float alpha;
    __device__ __forceinline__ void operator()(const f32x4 (&acc)[2][2][4][2], const Unit& u, int wr, int wc, int fr, int fq) const {
        const int row0 = u.pm * BM + wr * 64 + fr, col0 = u.pn * BM + wc * 32 + 8 * fq;
#pragma unroll
        for (int ai = 0; ai < 2; ++ai) {
            h16x8 pre[4][2];
#pragma unroll
            for (int m = 0; m < 4; ++m)
#pragma unroll
                for (int bj = 0; bj < 2; ++bj) pre[m][bj] = *(const h16x8*)(XH + (size_t)(row0 + ai * HALF + m * 16) * 1024 + col0 + bj * HALF);
#pragma unroll
            for (int m = 0; m < 4; ++m) { const int row = row0 + ai * HALF + m * 16; _Float16* bp = XH + (size_t)row * 1024 + col0; float s = 0.f;
#pragma unroll
                for (int bj = 0; bj < 2; ++bj) { const h16x8 o = pre[m][bj];
                    const f32x4 o0 = {(float)o[0], (float)o[1], (float)o[2], (float)o[3]}, o1 = {(float)o[4], (float)o[5], (float)o[6], (float)o[7]};
                    const f32x4 v0 = o0 + acc[ai][bj][m][0] * alpha, v1 = o1 + acc[ai][bj][m][1] * alpha;
                    if (fout) { float* xp = fout + (size_t)row * 1024 + col0 + bj * HALF; *(f32x4*)xp = v0; *(f32x4*)(xp + 4) = v1; }
                    const h16x8 w = {(_Float16)v0[0], (_Float16)v0[1], (_Float16)v0[2], (_Float16)v0[3], (_Float16)v1[0], (_Float16)v1[1], (_Float16)v1[2], (_Float16)v1[3]};
                    *(h16x8*)(bp + bj * HALF) = w;
                    s += (v0[0] * v0[0] + v0[1] * v0[1]) + (v0[2] * v0[2] + v0[3] * v0[3]) + (v1[0] * v1[0] + v1[1] * v1[1]) + (v1[2] * v1[2] + v1[3] * v1[3]); }
                s = add_xor16_32(s);
                if (fq == 0) ssq[(size_t)row * 16 + u.pn * 4 + wc] = s; }
            asm volatile("" ::: "memory"); }
    }
};
struct EpiGen {
    static constexpr bool PERM = true, AFTER_DRAIN = false;
    bf16_t* O; int ldc; const float* ssq; int ssq_stride, ssq_n; float ssq_inv; int npair, col_shift; float* osq; int osq_stride;
    __device__ __forceinline__ void operator()(const f32x4 (&acc)[2][2][4][2], const Unit& u, int wr, int wc, int fr, int fq) const {
        const int row0 = u.pm * BM + wr * 64 + fr; const bool pair = u.pn < npair;
        const int col0 = (pair ? u.pn * HALF : u.pn * BM - col_shift) + wc * 32 + 8 * fq;
        float rsv[2][4];
#pragma unroll
        for (int ai = 0; ai < 2; ++ai)
#pragma unroll
            for (int m = 0; m < 4; ++m) rsv[ai][m] = ssq ? row_rs(ssq, ssq_stride, ssq_n, ssq_inv, row0 + ai * HALF + m * 16, fq) : 1.0f;
#pragma unroll
        for (int ai = 0; ai < 2; ++ai)
#pragma unroll
            for (int m = 0; m < 4; ++m) { const int row = row0 + ai * HALF + m * 16; const float rs = rsv[ai][m];
                bf16_t* rowp = O + (size_t)row * ldc + col0;
                if (pair) { const f32x4 v0 = (acc[ai][0][m][0] * rs) * (acc[ai][1][m][0] * rs), v1 = (acc[ai][0][m][1] * rs) * (acc[ai][1][m][1] * rs);
                    u32x4 w; w.x = cvt_pk_bf16(v0[0], v0[1]); w.y = cvt_pk_bf16(v0[2], v0[3]); w.z = cvt_pk_bf16(v1[0], v1[1]); w.w = cvt_pk_bf16(v1[2], v1[3]);
                    *(u32x4*)rowp = w; }
                else {
#pragma unroll
                    for (int bj = 0; bj < 2; ++bj) { const f32x4 v0 = acc[ai][bj][m][0] * rs, v1 = acc[ai][bj][m][1] * rs;
                        u32x4 w; w.x = cvt_pk_bf16(v0[0], v0[1]); w.y = cvt_pk_bf16(v0[2], v0[3]); w.z = cvt_pk_bf16(v1[0], v1[1]); w.w = cvt_pk_bf16(v1[2], v1[3]);
                        *(u32x4*)(rowp + bj * HALF) = w;
                        if (osq) { float s = (v0[0] * v0[0] + v0[1] * v0[1]) + (v0[2] * v0[2] + v0[3] * v0[3]) + (v1[0] * v1[0] + v1[1] * v1[1]) + (v1[2] * v1[2] + v1[3] * v1[3]);
                            s = add_xor16_32(s);
                            if (fq == 0) osq[(size_t)row * osq_stride + u.pn * 8 + bj * 4 + wc] = s; } } } }
    }
};
template <class Epi, class Sched, bool ALIGN_EPI = false, bool SP2 = false, bool F16 = false>
__device__ __forceinline__ void gemm_phase(PG8_LAS unsigned char* lds, const Gemm g, const Sched& S, const Epi& E, const int tid) {
    const int wid = __builtin_amdgcn_readfirstlane(tid >> 6), lane = tid & 63, wr = wid >> 2, wc = wid & 3, fr = lane & 15, fq = lane >> 4;
    const int K = g.K, nt = K / BK;
    unsigned voffA[2], voffB[2];
#pragma unroll
    for (int i = 0; i < 2; ++i) { int R, C; stage_rc(tid * 16 + i * 8192, R, C); const int Rb = Epi::PERM ? ((R & ~31) + perm32(R & 31)) : R;
        voffA[i] = (unsigned)(R * g.lda + C) * 2u; voffB[i] = (unsigned)(Rb * K + C) * 2u; }
    const size_t kstep = (size_t)(BK * 2);
    const size_t hstep = (size_t)HALF * K * 2;
    const size_t tstep = 2 * hstep; const size_t hstepA = (size_t)HALF * g.lda * 2, tstepA = 2 * hstepA;
    const unsigned ldsw = (unsigned)wid * 1024u;
    const int aoff = lds_byte(wr * 64 + fr, fq * 8), boff = lds_byte(wc * 32 + fr, fq * 8);
#define PG8_SA(b, h) (((b) * 2 + (h)) * HTB)
#define PG8_SB(b, h) ((4 + (b) * 2 + (h)) * HTB)
#define PG8_STAGE(bufoff, gbase, voff) do { _Pragma("unroll") for (int _i = 0; _i < 2; ++_i) \
        __builtin_amdgcn_global_load_lds((const unsigned*)((const char*)(gbase) + (voff)[_i]), (PG8_LAS unsigned*)(lds + (bufoff) + ldsw + _i * 8192), 16, 0, 0); } while (0)
#define PG8_LDA(dst, b, h) do { _Pragma("unroll") for (int m = 0; m < 4; ++m) _Pragma("unroll") for (int k = 0; k < 2; ++k) dst[m][k] = *(const PG8_LAS bf16x8*)(lds + PG8_SA(b, h) + aoff + m * 2048 + k * 1024); } while (0)
#define PG8_LDB(dst, b, h) do { _Pragma("unroll") for (int n = 0; n < 2; ++n) _Pragma("unroll") for (int k = 0; k < 2; ++k) dst[n][k] = *(const PG8_LAS bf16x8*)(lds + PG8_SB(b, h) + boff + n * 2048 + k * 1024); } while (0)
#define PG8_MMA(ai, bj, At, Bt) do { __builtin_amdgcn_s_setprio(1); _Pragma("unroll") for (int m = 0; m < 4; ++m) _Pragma("unroll") for (int n = 0; n < 2; ++n) _Pragma("unroll") for (int k = 0; k < 2; ++k) \
        acc[ai][bj][m][n] = mma16<F16>(Bt[n][k], At[m][k], acc[ai][bj][m][n]); __builtin_amdgcn_s_setprio(0); } while (0)
#define PG8_WAIT_V(n) asm volatile("s_waitcnt vmcnt(" #n ")" ::: "memory")
#define PG8_WAIT_L(n) asm volatile("s_waitcnt lgkmcnt(" #n ")" ::: "memory")
#define PG8_BAR __builtin_amdgcn_s_barrier()
#define PG8_SCHED __builtin_amdgcn_sched_barrier(0)
    Unit cur, nxt; int ui = 0;
    if (!S.next(0, cur)) return;
    f32x4 acc[2][2][4][2];
#pragma unroll
    for (int a = 0; a < 2; ++a)
#pragma unroll
        for (int b = 0; b < 2; ++b)
#pragma unroll
            for (int m = 0; m < 4; ++m)
#pragma unroll
                for (int n = 0; n < 2; ++n) acc[a][b][m][n] = (f32x4){0.f, 0.f, 0.f, 0.f};
    bf16x8 At[4][2], B0[2][2], B1[2][2];
    const char* cA = (const char*)g.A + (size_t)cur.pm * tstepA; const char* cB = (const char*)g.Bt + (size_t)cur.pn * tstep;
    S.a_ready(cur);
    if constexpr (SP2) {
        PG8_STAGE(PG8_SB(0, 0), cB, voffB); PG8_STAGE(PG8_SB(0, 1), cB + hstep, voffB); PG8_STAGE(PG8_SA(0, 0), cA, voffA); PG8_STAGE(PG8_SA(0, 1), cA + hstepA, voffA);
        if (wr == 1) PG8_BAR;
        PG8_WAIT_V(2); PG8_BAR;
        PG8_STAGE(PG8_SB(1, 0), cB + kstep, voffB); PG8_STAGE(PG8_SA(1, 0), cA + kstep, voffA); PG8_STAGE(PG8_SB(1, 1), cB + hstep + kstep, voffB);
        PG8_WAIT_V(6); PG8_BAR;
    } else {
        PG8_STAGE(PG8_SB(0, 0), cB, voffB); PG8_STAGE(PG8_SA(0, 0), cA, voffA); PG8_STAGE(PG8_SB(0, 1), cB + hstep, voffB); PG8_STAGE(PG8_SA(0, 1), cA + hstepA, voffA);
        if (wr == 1) PG8_BAR;
        PG8_WAIT_V(4); PG8_BAR;
        PG8_STAGE(PG8_SB(1, 0), cB + kstep, voffB); PG8_STAGE(PG8_SA(1, 0), cA + kstep, voffA); PG8_STAGE(PG8_SB(1, 1), cB + hstep + kstep, voffB);
        PG8_WAIT_V(6); PG8_BAR;
    }
    for (;;) {
        const bool has_next = S.next(ui + 1, nxt);
        const char* nA = has_next ? (const char*)g.A + (size_t)nxt.pm * tstepA : cA; const char* nB = has_next ? (const char*)g.Bt + (size_t)nxt.pn * tstep : cB;
        for (int t = 0; t < nt; t += 2) {
            const bool last = (t == nt - 2);
            const char* a1 = cA + (size_t)(t + 1) * kstep;
            const char* a2 = last ? nA : cA + (size_t)(t + 2) * kstep; const char* b2 = last ? nB : cB + (size_t)(t + 2) * kstep;
            const char* a3 = a2 + kstep; const char* b3 = b2 + kstep;
            if (last && has_next) S.a_ready(nxt);
            if constexpr (SP2) {
            PG8_LDB(B0, 0, 0); PG8_LDB(B1, 0, 1); PG8_SCHED; PG8_LDA(At, 0, 0); PG8_STAGE(PG8_SA(1, 1), a1 + hstepA, voffA);
            PG8_WAIT_V(8); PG8_WAIT_L(0); PG8_BAR; PG8_MMA(0, 0, At, B0); PG8_MMA(0, 1, At, B1); PG8_BAR; PG8_SCHED;
            PG8_LDA(At, 0, 1); PG8_STAGE(PG8_SB(0, 0), b2, voffB); PG8_STAGE(PG8_SB(0, 1), b2 + hstep, voffB); PG8_STAGE(PG8_SA(0, 0), a2, voffA);
            PG8_WAIT_V(8); PG8_WAIT_L(0); PG8_BAR; PG8_MMA(1, 0, At, B0); PG8_MMA(1, 1, At, B1); PG8_BAR; PG8_SCHED;
            PG8_LDB(B0, 1, 0); PG8_LDB(B1, 1, 1); PG8_SCHED; PG8_LDA(At, 1, 0); PG8_STAGE(PG8_SA(0, 1), a2 + hstepA, voffA);
            PG8_WAIT_V(8); PG8_WAIT_L(0); PG8_BAR; PG8_MMA(0, 0, At, B0); PG8_MMA(0, 1, At, B1); PG8_BAR; PG8_SCHED;
            PG8_LDA(At, 1, 1); PG8_STAGE(PG8_SB(1, 0), b3, voffB); PG8_STAGE(PG8_SB(1, 1), b3 + hstep, voffB); PG8_STAGE(PG8_SA(1, 0), a3, voffA);
            PG8_WAIT_V(8); PG8_WAIT_L(0); PG8_BAR; PG8_MMA(1, 0, At, B0); PG8_MMA(1, 1, At, B1); PG8_BAR; PG8_SCHED;
            } else {
            PG8_LDB(B0, 0, 0); PG8_SCHED; PG8_LDA(At, 0, 0); PG8_STAGE(PG8_SA(1, 1), a1 + hstepA, voffA);
            PG8_WAIT_L(8); PG8_BAR; PG8_WAIT_L(0); PG8_MMA(0, 0, At, B0); PG8_BAR; PG8_SCHED;
            PG8_LDB(B1, 0, 1); PG8_STAGE(PG8_SB(0, 0), b2, voffB);
            PG8_BAR; PG8_WAIT_L(0); PG8_MMA(0, 1, At, B1); PG8_BAR;
            PG8_LDA(At, 0, 1); PG8_STAGE(PG8_SA(0, 0), a2, voffA);
            PG8_BAR; PG8_WAIT_L(0); PG8_MMA(1, 0, At, B0); PG8_BAR; PG8_SCHED;
            PG8_STAGE(PG8_SB(0, 1), b2 + hstep, voffB);
            PG8_WAIT_V(6); PG8_BAR; PG8_MMA(1, 1, At, B1); PG8_BAR;
            PG8_LDB(B0, 1, 0); PG8_SCHED; PG8_LDA(At, 1, 0); PG8_STAGE(PG8_SA(0, 1), a2 + hstepA, voffA);
            PG8_WAIT_L(8); PG8_BAR; PG8_WAIT_L(0); PG8_MMA(0, 0, At, B0); PG8_BAR; PG8_SCHED;
            PG8_LDB(B1, 1, 1); PG8_STAGE(PG8_SB(1, 0), b3, voffB);
            PG8_BAR; PG8_WAIT_L(0); PG8_MMA(0, 1, At, B1); PG8_BAR;
            PG8_LDA(At, 1, 1); PG8_STAGE(PG8_SA(1, 0), a3, voffA);
            PG8_BAR; PG8_WAIT_L(0); PG8_MMA(1, 0, At, B0); PG8_BAR; PG8_SCHED;
            PG8_STAGE(PG8_SB(1, 1), b3 + hstep, voffB);
            PG8_WAIT_V(6); PG8_BAR; PG8_MMA(1, 1, At, B1); PG8_BAR;
            }
        }
        if constexpr (ALIGN_EPI) { if (wr == 0) PG8_BAR; }
        if constexpr (!Epi::AFTER_DRAIN) { E(acc, cur, wr, wc, fr, fq); S.done(cur); }
        if (!has_next) break;
#pragma unroll
        for (int a = 0; a < 2; ++a)
#pragma unroll
            for (int b = 0; b < 2; ++b)
#pragma unroll
                for (int m = 0; m < 4; ++m)
#pragma unroll
                    for (int n = 0; n < 2; ++n) acc[a][b][m][n] = (f32x4){0.f, 0.f, 0.f, 0.f};
        cur = nxt; cA = nA; cB = nB; ++ui;
        if constexpr (ALIGN_EPI) { if (wr == 1) PG8_BAR; }
    }
    PG8_WAIT_V(0);
    if constexpr (!ALIGN_EPI) { if (wr == 0) PG8_BAR; }
    PG8_BAR;
    if constexpr (Epi::AFTER_DRAIN) { E.fused(acc, cur, wr, wc, fr, fq, lds, wid, lane); S.done(cur); }
#undef PG8_SA
#undef PG8_SB
#undef PG8_STAGE
#undef PG8_LDA
#undef PG8_LDB
#undef PG8_MMA
#undef PG8_WAIT_V
#undef PG8_WAIT_L
#undef PG8_BAR
#undef PG8_SCHED
}
}
namespace att {
typedef unsigned short bf16_t;
typedef short bf16x8 __attribute__((ext_vector_type(8)));
typedef short s16x4 __attribute__((ext_vector_type(4)));
typedef float f32x16 __attribute__((ext_vector_type(16)));
typedef float f32x4 __attribute__((ext_vector_type(4)));
typedef unsigned u32x4 __attribute__((ext_vector_type(4)));
constexpr int NW = 8, QBLK = 32, KVBLK = 64, QB = NW * QBLK;
constexpr int SHM_V = KVBLK * 128 * 2, SHM_K = KVBLK * 128 * 2, SHM_KR = KVBLK * 64 * 2;
constexpr int NVB = 3;
constexpr int ATT_WS_OFF = NVB * SHM_V + 2 * SHM_K + 2 * SHM_KR;
constexpr int ATT_LDS_BYTES = ATT_WS_OFF + NW * 64 * 4;
constexpr float THR = 8.f;
template <int MODE> struct Cfg;
template <> struct Cfg<0> { static constexpr int NQF = 12, NQT = 8, NQK = 8, NPV = 4, KS = 1536, VS = 1536, OS = 1024; static constexpr bool ROPE = true; };
template <> struct Cfg<1> { static constexpr int NQF = 4, NQT = 4, NQK = 4, NPV = 2, KS = 128, VS = 128, OS = 1024; static constexpr bool ROPE = false; };

#define KSWZ(row, colB) ((row) * 256 + ((colB) ^ (((row) & 7) << 4)))
#define KRSWZ(row, colB) ((row) * 128 + ((colB) ^ ((((row) >> 1) & 7) << 4)))
#define SBAR() __builtin_amdgcn_sched_barrier(0)
__device__ __forceinline__ int v_st(int k, int c) { const int kk = (k & ~0xC) | ((k & 4) << 1) | ((k & 8) >> 1); return ((kk >> 3) * 4 + (c >> 5)) * 512 + ((kk & 7) * 32 + (c & 31)) * 2; }
__device__ __forceinline__ int v_rd_base(int lane) { return ((lane & 3) << 3) | (((lane >> 2) & 3) << 6) | (((lane >> 4) & 1) << 5) | (((lane >> 5) & 1) << 8); }
constexpr int v_rd_off(int d0, int ks, int half) { return d0 * 512 + ks * 4096 + half * 2048; }
__device__ __forceinline__ int crow(int r, int hi) { return (r & 3) + 8 * (r >> 2) + 4 * hi; }
__device__ __forceinline__ unsigned cvtpk(float lo, float hi) {
    unsigned r; asm volatile("v_cvt_pk_bf16_f32 %0, %1, %2" : "=v"(r) : "v"(lo), "v"(hi)); return r;
}
__device__ __forceinline__ bf16x8 load8(const bf16_t* p) { return *reinterpret_cast<const bf16x8*>(p); }
__device__ __forceinline__ void mask_tile(f32x16& p0, f32x16& p1, int dq, unsigned W) {
    const float NEG = -__builtin_inff();
#pragma unroll
    for (int r = 0; r < 16; ++r) {
        const int c = (r & 3) + 8 * (r >> 2);
        if ((unsigned)(dq - c) >= W) p0[r] = NEG;
        if ((unsigned)(dq - c - 32) >= W) p1[r] = NEG;
    }
}
__device__ __forceinline__ void partialSM(f32x16& p0, f32x16& p1, float& m_reg, float& mn, float& alpha) {
    float pmax = p0[0]; for (int r = 1; r < 16; ++r) pmax = fmaxf(pmax, p0[r]); for (int r = 0; r < 16; ++r) pmax = fmaxf(pmax, p1[r]);
    { auto rr = __builtin_amdgcn_permlane32_swap(__float_as_uint(pmax), __float_as_uint(pmax), false, false);
      pmax = fmaxf(__uint_as_float(rr[0]), __uint_as_float(rr[1])); }
    constexpr float C2 = 1.4426950408889634f;
    if (__builtin_expect(__all((pmax - m_reg) <= THR), 1)) { mn = m_reg; alpha = 1.f; }
    else { mn = fmaxf(m_reg, pmax); alpha = __builtin_amdgcn_exp2f((m_reg - mn) * C2); m_reg = mn; }
    const float mnL = -mn * C2;
    for (int r = 0; r < 16; ++r) p0[r] = fmaf(p0[r], C2, mnL); for (int r = 0; r < 16; ++r) p1[r] = fmaf(p1[r], C2, mnL);
    for (int r = 0; r < 16; ++r) p0[r] = __builtin_amdgcn_exp2f(p0[r]);
}
__device__ __forceinline__ void finishSM(f32x16& p0, f32x16& p1, float alpha, float& l_reg, bf16x8& pa0, bf16x8& pa1, bf16x8& pa2, bf16x8& pa3) {
    for (int r = 0; r < 16; ++r) p1[r] = __builtin_amdgcn_exp2f(p1[r]);
    float ps = 0; for (int r = 0; r < 16; ++r) ps += p0[r]; for (int r = 0; r < 16; ++r) ps += p1[r];
    { auto rr = __builtin_amdgcn_permlane32_swap(__float_as_uint(ps), __float_as_uint(ps), false, false);
      ps = __uint_as_float(rr[0]) + __uint_as_float(rr[1]); }
    l_reg = l_reg * alpha + ps;
#define PK4(P, B_, OUT) do { unsigned a0 = cvtpk(P[B_+0], P[B_+1]), a1 = cvtpk(P[B_+2], P[B_+3]);                          \
        unsigned b0 = cvtpk(P[B_+4], P[B_+5]), b1 = cvtpk(P[B_+6], P[B_+7]);                                             \
        auto r0 = __builtin_amdgcn_permlane32_swap(a0, b0, false, false); auto r1 = __builtin_amdgcn_permlane32_swap(a1, b1, false, false); \
        u32x4 w = {r0[0], r1[0], r0[1], r1[1]}; OUT = *reinterpret_cast<bf16x8*>(&w); } while (0)
    PK4(p0, 0, pa0); PK4(p0, 8, pa1); PK4(p1, 0, pa2); PK4(p1, 8, pa3);
#undef PK4
}
template <int MODE, int KB>
__device__ __forceinline__ void qkt(f32x16& p0, f32x16& p1, const char* K_lds, const char* KR_lds, int r32, int hi, const bf16x8* qr) {
    typedef Cfg<MODE> C;
    p0 = f32x16{}; p1 = f32x16{};
    const char* kb[4];
#pragma unroll
    for (int dd = 0; dd < 4; ++dd) kb[dd] = K_lds + KB * SHM_K + KSWZ(r32, (dd * 16 + hi * 8) * 2);
#pragma unroll
    for (int d0 = 0; d0 < C::NQK; ++d0) { const char* a = kb[d0 & 3] + (d0 >> 2) * 128;
        bf16x8 b0 = *reinterpret_cast<const bf16x8*>(a);
        bf16x8 b1 = *reinterpret_cast<const bf16x8*>(a + 32 * 256);
        p0 = __builtin_amdgcn_mfma_f32_32x32x16_bf16(b0, qr[d0], p0, 0, 0, 0);
        p1 = __builtin_amdgcn_mfma_f32_32x32x16_bf16(b1, qr[d0], p1, 0, 0, 0); }
    if constexpr (C::ROPE) {
#pragma unroll
        for (int dd = 0; dd < 4; ++dd) { const char* a = KR_lds + KB * SHM_KR + KRSWZ(r32, (dd * 16 + hi * 8) * 2);
            bf16x8 b0 = *reinterpret_cast<const bf16x8*>(a);
            bf16x8 b1 = *reinterpret_cast<const bf16x8*>(a + 32 * 128);
            p0 = __builtin_amdgcn_mfma_f32_32x32x16_bf16(b0, qr[8 + dd], p0, 0, 0, 0);
            p1 = __builtin_amdgcn_mfma_f32_32x32x16_bf16(b1, qr[8 + dd], p1, 0, 0, 0); }
    }
}
template <int MODE, int VB>
__device__ __forceinline__ void pv_tile(f32x16* o, int vb0, bf16x8 pa0, bf16x8 pa1, bf16x8 pa2, bf16x8 pa3) {
#define TRRD(dst, off) asm volatile("ds_read_b64_tr_b16 %0, %1 offset:%2" : "=&v"(dst) : "v"(vb0), "i"(off) : "memory")
#define PV_D0(d0) do { s16x4 l0, l1, l2, l3, h0, h1, h2, h3; constexpr int b_ = VB * SHM_V + v_rd_off(d0, 0, 0);     \
        TRRD(l0, b_); TRRD(h0, b_ + 2048); TRRD(l1, b_ + 4096); TRRD(h1, b_ + 6144); TRRD(l2, b_ + 8192); TRRD(h2, b_ + 10240); TRRD(l3, b_ + 12288); TRRD(h3, b_ + 14336); \
        asm volatile("s_waitcnt lgkmcnt(0)" ::: "memory"); SBAR();             \
        o[d0] = __builtin_amdgcn_mfma_f32_32x32x16_bf16(pa0, (bf16x8){l0[0], l0[1], l0[2], l0[3], h0[0], h0[1], h0[2], h0[3]}, o[d0], 0, 0, 0);   \
        o[d0] = __builtin_amdgcn_mfma_f32_32x32x16_bf16(pa1, (bf16x8){l1[0], l1[1], l1[2], l1[3], h1[0], h1[1], h1[2], h1[3]}, o[d0], 0, 0, 0);   \
        o[d0] = __builtin_amdgcn_mfma_f32_32x32x16_bf16(pa2, (bf16x8){l2[0], l2[1], l2[2], l2[3], h2[0], h2[1], h2[2], h2[3]}, o[d0], 0, 0, 0);   \
        o[d0] = __builtin_amdgcn_mfma_f32_32x32x16_bf16(pa3, (bf16x8){l3[0], l3[1], l3[2], l3[3], h3[0], h3[1], h3[2], h3[3]}, o[d0], 0, 0, 0); } while (0)
    PV_D0(0); PV_D0(1);
    if constexpr (Cfg<MODE>::NPV == 4) { PV_D0(2); PV_D0(3); }
#undef PV_D0
#undef TRRD
}

struct BlockRef { const bf16_t* Q; const bf16_t* K; const bf16_t* V; const bf16_t* KR; bf16_t* O; int P0; int qs; int tok; int pad; };
__device__ __forceinline__ int swa_jlo(int P0, int W) { const int lowk = P0 - W + 1; return lowk > 0 ? lowk / KVBLK : 0; }
template <int MODE>
__device__ __forceinline__ void attn_run(const BlockRef& cur, const bf16x8* qr, int skv, int W, char* lds, const int tid) {
    typedef Cfg<MODE> C;
    const int wid = __builtin_amdgcn_readfirstlane(tid >> 6), lane = tid & 63, r32 = lane & 31, hi = lane >> 5;
    const bool grpB = wid >= 4;
    const int j_lo = swa_jlo(cur.P0, W);
    int j_hi = (cur.P0 + QB - 1) / KVBLK + 1; if (j_hi > skv / KVBLK) j_hi = skv / KVBLK;
    const int NT = j_hi - j_lo;
    const int qlo = cur.P0 + wid * QBLK, qm = qlo + r32 - 4 * hi;
    char* V_lds = lds; char* K_lds = lds + NVB * SHM_V; char* KR_lds = lds + NVB * SHM_V + 2 * SHM_K;
    float* ws = (float*)(lds + ATT_WS_OFF) + wid * 64; float* li_l = ws, * al_l = ws + 32;
    float m_reg = -1e30f, l_reg = 0; f32x16 o[4] = {};
    const int sr = tid >> 4, sc = (tid & 15) * 8, vst0 = v_st(sr, sc), vst1 = v_st(32 + sr, sc), kws = KSWZ(sr, sc * 2);
    const int krr = tid >> 3, krc = (tid & 7) * 8, krw = KRSWZ(krr, krc * 2);
    const int vb0 = (int)(uintptr_t)V_lds + v_rd_base(lane);
    const bf16_t* Kh = cur.K; const bf16_t* Vh = cur.V; const bf16_t* KRh = cur.KR;
    bf16x8 st_v0, st_v1, st_k0, st_k1, st_kr;
#define ROWK(p, k0, rr) ((p) + (size_t)((k0) + (rr)) * C::KS + sc)
#define ROWV(p, k0, rr) ((p) + (size_t)((k0) + (rr)) * C::VS + sc)
#define VMW() asm volatile("s_waitcnt vmcnt(0)" ::: "memory")
#define SLOAD_H(k0) do { st_v0 = load8(ROWV(Vh, k0, sr)); st_v1 = load8(ROWV(Vh, k0, 32 + sr)); st_k0 = load8(ROWK(Kh, k0, sr)); st_k1 = load8(ROWK(Kh, k0, 32 + sr)); \
                         if constexpr (C::ROPE) st_kr = load8(KRh + (size_t)((k0) + krr) * 64 + krc); } while (0)
#define SWRITE_H(kb, vb) do { *(bf16x8*)(V_lds + (vb) * SHM_V + vst0) = st_v0; *(bf16x8*)(V_lds + (vb) * SHM_V + vst1) = st_v1;                           \
                          *(bf16x8*)(K_lds + (kb) * SHM_K + kws) = st_k0; *(bf16x8*)(K_lds + (kb) * SHM_K + kws + 32 * 256) = st_k1;                 \
                          if constexpr (C::ROPE) *(bf16x8*)(KR_lds + (kb) * SHM_KR + krw) = st_kr; } while (0)
#define RESC(a) do { if (__any((a) < 1.f)) { if (hi == 0) al_l[r32] = (a); asm volatile("s_waitcnt lgkmcnt(0)" ::: "memory");              \
                     for (int d_ = 0; d_ < C::NPV; ++d_) for (int r = 0; r < 16; ++r) o[d_][r] *= al_l[crow(r, hi)]; } } while (0)
#define KBASE(t) ((j_lo + (t)) * KVBLK)
#define MASKT(P0_, P1_, t) do { const int kb_ = KBASE(t); if (kb_ + KVBLK - 1 > qlo || kb_ <= qlo + QBLK - 1 - W) mask_tile(P0_, P1_, qm - kb_, (unsigned)W); } while (0)
    f32x16 p0, p1; float mn, al; bf16x8 pa0 = {}, pa1 = {}, pa2 = {}, pa3 = {};
    SLOAD_H(KBASE(0)); VMW(); SWRITE_H(0, 0); SBAR();
    if (NT > 1) { SLOAD_H(KBASE(1)); SBAR(); }
    __syncthreads();
    int vcur = 0, vprev = 0;
    for (int t = 0; t < NT; ++t) {
        const int kb = t & 1; const int vnext = vcur == NVB - 1 ? 0 : vcur + 1;
        SBAR();
        if (grpB && t > 0) { pv_tile<MODE, 0>(o, vb0 + vprev * SHM_V, pa0, pa1, pa2, pa3); SBAR(); }
        qkt<MODE, 0>(p0, p1, K_lds + kb * SHM_K, KR_lds + kb * SHM_KR, r32, hi, qr); SBAR();
        MASKT(p0, p1, t); partialSM(p0, p1, m_reg, mn, al); RESC(al);
        finishSM(p0, p1, al, l_reg, pa0, pa1, pa2, pa3); SBAR();
        if (!grpB) { pv_tile<MODE, 0>(o, vb0 + vcur * SHM_V, pa0, pa1, pa2, pa3); SBAR(); }
        if (t + 1 < NT) { VMW(); SWRITE_H(kb ^ 1, vnext); SBAR(); if (t + 2 < NT) { SLOAD_H(KBASE(t + 2)); SBAR(); } }
        __syncthreads();
        vprev = vcur; vcur = vnext;
    }
    if (grpB) { SBAR(); pv_tile<MODE, 0>(o, vb0 + vprev * SHM_V, pa0, pa1, pa2, pa3); SBAR(); }
    if (hi == 0) li_l[r32] = l_reg; asm volatile("s_waitcnt lgkmcnt(0)" ::: "memory");
    float rli[16];
#pragma unroll
    for (int r = 0; r < 16; ++r) rli[r] = __builtin_amdgcn_rcpf(li_l[crow(r, hi)]);
    bf16_t* Ow = cur.O + (size_t)(wid * QBLK) * C::OS;
#pragma unroll
    for (int r = 0; r < 16; ++r) { const int orow = crow(r, hi);
#pragma unroll
        for (int d0 = 0; d0 < C::NPV; ++d0) { const float v = o[d0][r] * rli[r];
            const float vn = pg8::swz_xor<1>(v);
            if ((r32 & 1) == 0) *(unsigned*)(Ow + (size_t)orow * C::OS + d0 * 32 + r32) = cvtpk(v, vn); } }
    __syncthreads();
#undef RESC
#undef KBASE
#undef MASKT
#undef ROWK
#undef ROWV
#undef VMW
#undef SLOAD_H
#undef SWRITE_H
}
}
#ifndef MK_N_LAUNCHES
#define MK_N_LAUNCHES 1
#endif
#define LAS __attribute__((address_space(3)))
typedef unsigned short bf16;
typedef float f32x4 __attribute__((ext_vector_type(4)));
typedef unsigned v4u __attribute__((ext_vector_type(4)));
typedef unsigned v2u __attribute__((ext_vector_type(2)));
typedef short bf16x8 __attribute__((ext_vector_type(8)));
constexpr int NWAVES = 8;
constexpr int T = 65536, DM = 1024, FF = 2816, NBATCH = 8, SEQ = 8192;
constexpr float EPS = 1e-6f;
constexpr int N13 = 2 * FF;
constexpr int NCONV = 2560, NMLA = 768, NUQ = 1280, NKV1 = 512, NKV2 = 1536, NMEMKV = 2048, MEMROWS = 2048;
constexpr int PSTRIDE = 1792;
constexpr size_t MiB = 1u << 20;
constexpr size_t WS_W13 = 0;
constexpr size_t WS_W2 = WS_W13 + 88 * MiB;
constexpr size_t WS_WOUT = WS_W2 + 44 * MiB;
constexpr size_t WS_CONVIN = WS_WOUT + 8 * MiB;
constexpr size_t WS_MLAIN = WS_CONVIN + 10 * MiB;
constexpr size_t WS_WUQ = WS_MLAIN + 3 * MiB;
constexpr size_t WS_WKV1 = WS_WUQ + 2 * MiB;
constexpr size_t WS_WKV2 = WS_WKV1 + 1 * MiB;
constexpr size_t WS_WMEMKV = WS_WKV2 + 1 * MiB;
constexpr size_t WS_SSQ = WS_WMEMKV + 4 * MiB;
constexpr size_t WS_CSSQ = WS_SSQ + 4 * MiB;
constexpr size_t WS_MEMB = WS_CSSQ + 6 * MiB;
constexpr size_t WS_MEMSSQ = WS_MEMB + 4 * MiB;
constexpr size_t WS_MEMKVRAW = WS_MEMSSQ + 1 * MiB;
constexpr size_t WS_KMEM = WS_MEMKVRAW + 8 * MiB;
constexpr size_t WS_VMEM = WS_KMEM + 8 * MiB;
constexpr size_t WS_XB = WS_VMEM + 8 * MiB;
constexpr size_t WS_ACT = WS_XB + 128 * MiB;
constexpr size_t WS_MIX = WS_ACT + 352 * MiB;
constexpr size_t WS_KVB = WS_MIX + 128 * MiB;
constexpr size_t WS_KR = WS_KVB + 192 * MiB;
constexpr size_t WS_CTL = WS_KR + 8 * MiB;
constexpr size_t CTL_BYTES = 65536;
constexpr size_t WS_END = WS_CTL + 1 * MiB;
static_assert(WS_END <= 1024 * MiB, "d_ws map must fit 1 GiB");
constexpr size_t ACT_QRAW = 96 * MiB;
constexpr int MISC_OFF = 143360;
constexpr int LDS_BYTES = 147456;
static_assert(att::ATT_LDS_BYTES <= LDS_BYTES, "attention LDS");

__constant__ float INVF[32] = {1.000000000e+00f, 7.498942614e-01f, 5.623413324e-01f, 4.216965139e-01f, 3.162277639e-01f, 2.371373773e-01f, 1.778279394e-01f, 1.333521307e-01f, 1.000000015e-01f, 7.498941571e-02f, 5.623413250e-02f, 4.216965288e-02f, 3.162277490e-02f, 2.371373773e-02f, 1.778279431e-02f, 1.333521493e-02f, 9.999999776e-03f, 7.498941850e-03f, 5.623413250e-03f, 4.216964822e-03f, 3.162277630e-03f, 2.371373586e-03f, 1.778279431e-03f, 1.333521446e-03f, 1.000000047e-03f, 7.498942432e-04f, 5.623413017e-04f, 4.216965172e-04f, 3.162277571e-04f, 2.371373703e-04f, 1.778279402e-04f, 1.333521504e-04f};

#define LDS_WAIT() asm volatile("s_waitcnt lgkmcnt(0)" ::: "memory")
__device__ __forceinline__ unsigned f2bf(float f) { unsigned u = __builtin_bit_cast(unsigned, f); return (u + 0x7fffu + ((u >> 16) & 1u)) >> 16; }
__device__ __forceinline__ unsigned pk2(float lo, float hi) { return f2bf(lo) | (f2bf(hi) << 16); }
__device__ __forceinline__ float bf2f(unsigned short h) { return __builtin_bit_cast(float, (unsigned)h << 16); }
__device__ __forceinline__ float wave_sum(float v) {
    v += pg8::swz_xor<1>(v); v += pg8::swz_xor<2>(v); v += pg8::swz_xor<4>(v); v += pg8::swz_xor<8>(v); v += pg8::swz_xor<16>(v);
    return pg8::add_xor32(v);
}
__device__ __forceinline__ void rope_cs(int pos, int i, float& c, float& s) {
    const float ang = (float)pos * INVF[i];
    double t = (double)ang * 0.15915494309189535; t -= __builtin_rint(t);
    const float fr = (float)t; c = __builtin_amdgcn_cosf(fr); s = __builtin_amdgcn_sinf(fr);
}

struct Args { const void* in[25]; float* out; unsigned char* ws; int lo, hi; };

enum { MAP_PLAIN = 0, MAP_GATEUP = 1, MAP_CONVIN = 2 };
__device__ __forceinline__ int map_col(int mode, int n0, int Nsrc) {
    if (mode == MAP_GATEUP) { const int tile = n0 >> 8, q = n0 & 255; return (q < 128 ? 0 : FF) + tile * 128 + (q & 127); }
    if (mode == MAP_CONVIN) { const int tile = n0 >> 8, q = n0 & 255; if (tile < 6) return (q < 128 ? 768 : 1536) + tile * 128 + (q & 127); if (tile < 9) return (tile - 6) * 256 + q; return 2304 + q; }
    return n0 < Nsrc ? n0 : -1;
}
__device__ __forceinline__ unsigned pk2h(float lo, float hi) { typedef _Float16 h2 __attribute__((ext_vector_type(2))); const h2 v = {(_Float16)lo, (_Float16)hi}; return __builtin_bit_cast(unsigned, v); }
__device__ __forceinline__ void prep_weight(const float* W, const float* g, int K, int Nsrc, bf16* WT, int Ndst, int mode, bool f16, LAS float* scr, int gw, int NGW, int lane) {
    const int nblk = Ndst / 64, nitems = (K / 64) * nblk; const int kr = lane >> 4, c4 = (lane & 15) * 4;
    for (int item = gw; item < nitems; item += NGW) {
        const int kb = item / nblk, nb = item % nblk, k0 = 64 * kb, n0 = 64 * nb; const int s0 = map_col(mode, n0, Nsrc);
        if (s0 >= 0) {
            f32x4 v[16];
#pragma unroll
            for (int i = 0; i < 16; ++i) v[i] = *(const f32x4*)(W + (size_t)(k0 + 4 * i + kr) * Nsrc + s0 + c4);
#pragma unroll
            for (int i = 0; i < 16; ++i) { const int kk = 4 * i + kr; const float gv = g ? g[k0 + kk] : 1.0f; LAS float* d = scr + kk * 65 + c4;
                d[0] = v[i].x * gv; d[1] = v[i].y * gv; d[2] = v[i].z * gv; d[3] = v[i].w * gv; }
        }
        LDS_WAIT(); asm volatile("" ::: "memory");
        const int c = lane & 7;
#pragma unroll
        for (int j = 0; j < 8; ++j) { const int n = (lane >> 3) + 8 * j; const LAS float* s = scr + (8 * c) * 65 + n;
            v4u o = {0u, 0u, 0u, 0u};
            if (s0 >= 0) { if (f16) { o.x = pk2h(s[0 * 65], s[1 * 65]); o.y = pk2h(s[2 * 65], s[3 * 65]); o.z = pk2h(s[4 * 65], s[5 * 65]); o.w = pk2h(s[6 * 65], s[7 * 65]); }
                           else { o.x = pk2(s[0 * 65], s[1 * 65]); o.y = pk2(s[2 * 65], s[3 * 65]); o.z = pk2(s[4 * 65], s[5 * 65]); o.w = pk2(s[6 * 65], s[7 * 65]); } }
            *(v4u*)(WT + (size_t)(n0 + n) * K + k0 + 8 * c) = o; }
        LDS_WAIT(); asm volatile("" ::: "memory");
    }
}
__device__ __forceinline__ void row_to_bf16(const float* xrow, bool f16, bf16* orow, float* ssq, int nslot, int lane) {
    const f32x4* xr = (const f32x4*)xrow + lane; f32x4 v[4]; float s = 0.f;
#pragma unroll
    for (int j = 0; j < 4; ++j) { v[j] = xr[64 * j]; s += (v[j].x * v[j].x + v[j].y * v[j].y) + (v[j].z * v[j].z + v[j].w * v[j].w); }
    s = wave_sum(s);
    v2u* o8 = (v2u*)orow + lane;
#pragma unroll
    for (int j = 0; j < 4; ++j) { v2u w; if (f16) { w.x = pk2h(v[j].x, v[j].y); w.y = pk2h(v[j].z, v[j].w); } else { w.x = pk2(v[j].x, v[j].y); w.y = pk2(v[j].z, v[j].w); } o8[64 * j] = w; }
    if (lane < nslot) ssq[lane] = lane == 0 ? s : 0.f;
}

__device__ __forceinline__ const void* argp(int i) {
    const char __attribute__((address_space(4)))* ka = (const char __attribute__((address_space(4)))*)__builtin_amdgcn_kernarg_segment_ptr();
    int off = i * 8; asm volatile("" : "+s"(off));
    return *(const void* const __attribute__((address_space(4)))*)(ka + off);
}
#define XB_TMO      128
#define XB_XCNT(j)  (256  + 64 * (j))
#define XB_XSUB(j)  (1280 + 64 * (j))
#define XB_XGEN(j)  (2304 + 64 * (j))
#define XB_TOP      3328
#define XB_TOPGEN   3392
#define XCD_BAR_WORDS 3456
#define XB_SPIN_CAP (1u << 18)
__device__ __forceinline__ unsigned xb_ld(unsigned* p)              { return __hip_atomic_load(p, __ATOMIC_RELAXED, __HIP_MEMORY_SCOPE_AGENT); }
__device__ __forceinline__ unsigned xb_add(unsigned* p, unsigned v) { return __hip_atomic_fetch_add(p, v, __ATOMIC_RELAXED, __HIP_MEMORY_SCOPE_AGENT); }
__device__ __forceinline__ unsigned xb_xcc_id() { return (unsigned)__builtin_amdgcn_s_getreg((3 << 11) | 20) & 0xFu; }
#define XB_SPIN(cond, bar) do { unsigned _sp = 0; while (cond) { __builtin_amdgcn_s_sleep(1); \
    if ((++_sp & 255u) == 0u) { if (xb_ld(&(bar)[XB_TMO])) break; if (_sp > XB_SPIN_CAP) { atomicAdd(&(bar)[XB_TMO], 1u); break; } } } } while (0)
struct XcdBarrier { unsigned* bar; unsigned x; volatile LAS unsigned* st; };
__device__ __forceinline__ XcdBarrier xcd_barrier_post(unsigned* bar, volatile LAS unsigned* st) {
    XcdBarrier b; b.bar = bar; b.x = xb_xcc_id(); b.st = st;
    if (threadIdx.x == 0) (void)xb_add(&bar[XB_XCNT(b.x)], 1u);
    return b;
}
__device__ __forceinline__ void xcd_barrier_complete(unsigned* bar, unsigned x, unsigned& nloc, unsigned& nx) {
    const unsigned G = gridDim.x * gridDim.y * gridDim.z;
    unsigned sum, cnt, mine, sp = 0u;
    for (;;) {
        sum = 0u; cnt = 0u; mine = 0u;
#pragma unroll
        for (unsigned j = 0; j < 16; ++j) { const unsigned c = xb_ld(&bar[XB_XCNT(j)]); sum += c; cnt += (c > 0u) ? 1u : 0u; mine = (j == x) ? c : mine; }
        if (sum == G) break;
        __builtin_amdgcn_s_sleep(1);
        if ((++sp & 255u) == 0u) { if (xb_ld(&bar[XB_TMO])) break; if (sp > XB_SPIN_CAP) { atomicAdd(&bar[XB_TMO], 1u); break; } }
    }
    nloc = mine > 0u ? mine : 1u; nx = cnt > 0u ? cnt : 1u;
}
__device__ __forceinline__ void xcd_barrier(const XcdBarrier& b, const int tid) {
    asm volatile("s_waitcnt vmcnt(0)" ::: "memory");
    __syncthreads();
    if (tid == 0) {
        unsigned* bar = b.bar;
        __builtin_amdgcn_s_waitcnt(0);
        unsigned nloc = b.st[0], nx = b.st[1];
        if (nloc == 0u) { xcd_barrier_complete(bar, b.x, nloc, nx); b.st[0] = nloc; b.st[1] = nx; }
        const unsigned old = xb_add(&bar[XB_XSUB(b.x)], 1u);
        const unsigned gen = old / nloc;
        if (old + 1u == (gen + 1u) * nloc) {
            __builtin_amdgcn_fence(__ATOMIC_RELEASE, "agent");
            asm volatile("s_waitcnt vmcnt(0)" ::: "memory");
            const unsigned og = xb_add(&bar[XB_TOP], 1u);
            const unsigned tg = og / nx;
            if (og + 1u == (tg + 1u) * nx) xb_add(&bar[XB_TOPGEN], 1u);
            else XB_SPIN(xb_ld(&bar[XB_TOPGEN]) == tg, bar);
            __builtin_amdgcn_fence(__ATOMIC_ACQUIRE, "agent");
            xb_add(&bar[XB_XGEN(b.x)], 1u);
            asm volatile("s_waitcnt vmcnt(0)" ::: "memory");
        } else {
            XB_SPIN(xb_ld(&bar[XB_XGEN(b.x)]) == gen, bar);
            __builtin_amdgcn_fence(__ATOMIC_ACQUIRE, "agent");
            asm volatile("s_waitcnt vmcnt(0)" ::: "memory");
        }
    }
    __syncthreads();
}
__global__ void __launch_bounds__(NWAVES * 64, 2) yoco_fwd(Args args) {
    extern __shared__ __attribute__((aligned(16))) unsigned char lds[];
    cg::grid_group grid = cg::this_grid();
    const int wave0 = __builtin_amdgcn_readfirstlane((int)threadIdx.x >> 6);
    const int G = gridDim.x, bx0 = blockIdx.x;
#define ARGP(i) argp(i)
#define x_in ((const float*)ARGP(0))
#define mem_in ((const float*)ARGP(1))
#define positions ((const int*)ARGP(2))
#define norm_g ((const float*)ARGP(3))
#define ffn_w13 ((const float*)ARGP(4))
#define ffn_w2 ((const float*)ARGP(5))
#define w_out ((const float*)ARGP(6))
#define mem_norm_g ((const float*)ARGP(7))
#define w_mem_kv ((const float*)ARGP(8))
#define g_mem_q ((const float*)ARGP(9))
#define g_mem_k ((const float*)ARGP(10))
#define conv_w_in ((const float*)ARGP(11))
#define conv_w ((const float*)ARGP(12))
#define mla_w_in ((const float*)ARGP(13))
#define g_q_lora ((const float*)ARGP(14))
#define w_uq ((const float*)ARGP(15))
#define g_q_nope ((const float*)ARGP(16))
#define g_q_rope ((const float*)ARGP(17))
#define kv_norm_g ((const float*)ARGP(18))
#define w_dkv ((const float*)ARGP(19))
#define g_ckv ((const float*)ARGP(20))
#define w_ukv ((const float*)ARGP(21))
#define w_kr ((const float*)ARGP(22))
#define g_k_nope ((const float*)ARGP(23))
#define g_k_rope ((const float*)ARGP(24))
#define X ((float*)ARGP(25))
#define WSB ((unsigned char*)ARGP(26))
#define W13T ((bf16*)(WSB + WS_W13))
#define W2T ((bf16*)(WSB + WS_W2))
#define WOUTT ((bf16*)(WSB + WS_WOUT))
#define CONVINT ((bf16*)(WSB + WS_CONVIN))
#define MLAINT ((bf16*)(WSB + WS_MLAIN))
#define WUQT ((bf16*)(WSB + WS_WUQ))
#define WKV1T ((bf16*)(WSB + WS_WKV1))
#define WKV2T ((bf16*)(WSB + WS_WKV2))
#define WMEMKVT ((bf16*)(WSB + WS_WMEMKV))
#define SSQ ((float*)(WSB + WS_SSQ))
#define CSSQ ((float*)(WSB + WS_CSSQ))
#define MEMB ((bf16*)(WSB + WS_MEMB))
#define MEMSSQ ((float*)(WSB + WS_MEMSSQ))
#define MEMKVRAW ((bf16*)(WSB + WS_MEMKVRAW))
#define KMEM ((bf16*)(WSB + WS_KMEM))
#define VMEM ((bf16*)(WSB + WS_VMEM))
#define XB ((bf16*)(WSB + WS_XB))
#define ACT ((bf16*)(WSB + WS_ACT))
#define MIX ((bf16*)(WSB + WS_MIX))
#define KVB ((bf16*)(WSB + WS_KVB))
#define KRB ((bf16*)(WSB + WS_KR))
#define PCONV ACT
#define CQRAW ACT
#define QRAW ((bf16*)(WSB + WS_ACT + ACT_QRAW))
#define CKVRAW ACT
    LAS unsigned char* ldsl = (LAS unsigned char*)lds;

    bool probe_done = false; (void)probe_done;
    volatile LAS unsigned* MISC = (volatile LAS unsigned*)(ldsl + MISC_OFF);
    if (threadIdx.x < 4) MISC[threadIdx.x] = 0u;
    __syncthreads();
    XcdBarrier xbar; xbar.bar = nullptr; xbar.x = 0; xbar.st = MISC;
    if (args.hi - args.lo > 1) xbar = xcd_barrier_post((unsigned*)(WSB + WS_CTL), MISC);
    for (int ph = args.lo; ph < args.hi; ++ph) {
        int wave = wave0, bx = bx0; asm volatile("" : "+s"(wave)); asm volatile("" : "+s"(bx));
        int lane = (int)__builtin_amdgcn_mbcnt_hi(~0u, __builtin_amdgcn_mbcnt_lo(~0u, 0u)); asm volatile("" : "+v"(lane)); const int tid = wave * 64 + lane; const int vcu = (G % 8 == 0) ? (bx % 8) * (G / 8) + bx / 8 : bx; const int gw = vcu * NWAVES + wave, NGW = G * NWAVES;
        int type, layer = 0, sub = 0;
        enum { PH_PREP, PH_MEMKV, PH_GLUE_MEM, PH_G1, PH_G2, PH_CONVIN, PH_CONVMIX, PH_WOUT, PH_KV1, PH_KV2, PH_GLUE_KV, PH_MLAIN, PH_UQ, PH_MLAATT };
        if (ph < 3) type = ph == 0 ? PH_PREP : (ph == 1 ? PH_MEMKV : PH_GLUE_MEM);
        else if (ph < 17) { const int q = ph - 3; layer = q / 7; const int st = q % 7;
            type = st == 0 ? PH_G1 : st == 1 ? PH_G2 : st == 2 ? PH_CONVIN : st == 3 ? PH_CONVMIX : st == 4 ? PH_WOUT : st == 5 ? PH_G1 : PH_G2; sub = st >= 5 ? 1 : 0; }
        else if (ph < 20) type = ph == 17 ? PH_KV1 : (ph == 18 ? PH_KV2 : PH_GLUE_KV);
        else { const int q = ph - 20; layer = 2 + q / 8; const int st = q % 8;
            type = st == 0 ? PH_G1 : st == 1 ? PH_G2 : st == 2 ? PH_MLAIN : st == 3 ? PH_UQ : st == 4 ? PH_MLAATT : st == 5 ? PH_WOUT : st == 6 ? PH_G1 : PH_G2; sub = st >= 6 ? 1 : 0; }

        if (type == PH_PREP) {
            LAS float* scr = (LAS float*)(ldsl + wave * 16640);
            for (int job = 0; job < 33; ++job) {
                const float* W; const float* g = nullptr; int K, Nsrc, Ndst, mode = MAP_PLAIN; bf16* dst;
                if (job < 8) { const int l = job >> 1, s = job & 1; W = ffn_w13 + (size_t)job * DM * N13; g = norm_g + (size_t)(l * 3 + (s ? 2 : 0)) * DM; K = DM; Nsrc = N13; Ndst = N13; mode = MAP_GATEUP; dst = W13T + (size_t)job * N13 * DM; }
                else if (job < 16) { const int j = job - 8; W = ffn_w2 + (size_t)j * FF * DM; K = FF; Nsrc = DM; Ndst = DM; dst = W2T + (size_t)j * DM * FF; }
                else if (job < 20) { const int l = job - 16; W = w_out + (size_t)l * DM * DM; K = DM; Nsrc = DM; Ndst = DM; dst = WOUTT + (size_t)l * DM * DM; }
                else if (job < 22) { const int l = job - 20; W = conv_w_in + (size_t)l * DM * NCONV; g = norm_g + (size_t)(l * 3 + 1) * DM; K = DM; Nsrc = NCONV; Ndst = NCONV; mode = MAP_CONVIN; dst = CONVINT + (size_t)l * NCONV * DM; }
                else if (job < 24) { const int j = job - 22; W = mla_w_in + (size_t)j * DM * 640; g = norm_g + (size_t)((2 + j) * 3 + 1) * DM; K = DM; Nsrc = 640; Ndst = NMLA; dst = MLAINT + (size_t)j * NMLA * DM; }
                else if (job < 26) { const int j = job - 24; W = w_uq + (size_t)j * 384 * 1152; g = g_q_lora + j * 384; K = 384; Nsrc = 1152; Ndst = NUQ; dst = WUQT + (size_t)j * (MiB / 2); }
                else if (job == 26) { W = w_dkv; g = kv_norm_g; K = DM; Nsrc = 256; Ndst = 256; dst = WKV1T; }
                else if (job == 27) { W = w_kr; g = kv_norm_g; K = DM; Nsrc = 64; Ndst = 256; dst = WKV1T + (size_t)256 * DM; }
                else if (job == 28) { W = w_ukv; g = g_ckv; K = 256; Nsrc = NKV2; Ndst = NKV2; dst = WKV2T; }
                else { const int l = job - 29; W = w_mem_kv + (size_t)l * DM * 512; g = mem_norm_g + l * DM; K = DM; Nsrc = 512; Ndst = 512; dst = WMEMKVT + (size_t)l * 512 * DM; }
                const bool f16w = job < 8 || (job >= 20 && job < 24) || job == 26 || job == 27;
                prep_weight(W, g, K, Nsrc, dst, Ndst, mode, f16w, scr, gw, NGW, lane);
            }
            for (int m = gw; m < T; m += NGW) row_to_bf16(x_in + (size_t)m * DM, true, XB + (size_t)m * DM, SSQ + (size_t)m * 16, 16, lane);
            for (int m = gw; m < MEMROWS; m += NGW) row_to_bf16(mem_in + (size_t)m * DM, false, MEMB + (size_t)m * DM, MEMSSQ + (size_t)m * 4, 4, lane);
        }
        else if (type == PH_GLUE_MEM) {
            for (int it = gw; it < 4 * MEMROWS * 4; it += NGW) { const int h = it & 3, row = (it >> 2) % MEMROWS, l = it / (4 * MEMROWS); const int b = row >> 8, m = row & 255;
                const float kv = bf2f(MEMKVRAW[(size_t)row * NMEMKV + l * 512 + h * 64 + lane]); const unsigned short vv = MEMKVRAW[(size_t)row * NMEMKV + l * 512 + 256 + h * 64 + lane];
                const float ss = wave_sum(kv * kv); const float kn = kv * __builtin_amdgcn_rsqf(ss * (1.0f / 64.0f) + EPS) * g_mem_k[l * 64 + lane];
                const size_t o = ((((size_t)l * NBATCH + b) * 4 + h) * 256 + m) * 128;
                KMEM[o + lane] = (bf16)f2bf(kn); KMEM[o + 64 + lane] = 0; VMEM[o + lane] = vv; VMEM[o + 64 + lane] = 0; }
        }
        else if (type == PH_GLUE_KV) {
            const int j16 = lane & 15;
            const f32x4 gn0 = *(const f32x4*)(g_k_nope + 8 * j16), gn1 = *(const f32x4*)(g_k_nope + 8 * j16 + 4), gr = *(const f32x4*)(g_k_rope + 4 * j16);
            for (int t4 = gw; t4 < T / 4; t4 += NGW) {
                const int t = t4 * 4 + (lane >> 4); const int pos = positions[t];
                bf16* kvp = KVB + (size_t)t * NKV2 + 8 * j16;
                bf16x8 kv[6];
#pragma unroll
                for (int h = 0; h < 6; ++h) kv[h] = *(const bf16x8*)(kvp + h * 256);
                const v2u krw = *(const v2u*)(CKVRAW + (size_t)t * NKV1 + 256 + 4 * j16);
#pragma unroll
                for (int h = 0; h < 6; ++h) { float f[8]; float ss = 0.f;
#pragma unroll
                    for (int e = 0; e < 8; ++e) { f[e] = bf2f((unsigned short)kv[h][e]); ss += f[e] * f[e]; }
                    ss += pg8::swz_xor<1>(ss); ss += pg8::swz_xor<2>(ss); ss += pg8::swz_xor<4>(ss); ss += pg8::swz_xor<8>(ss);
                    const float rs = __builtin_amdgcn_rsqf(ss * (1.0f / 128.0f) + EPS);
                    v4u w; w.x = pk2(f[0] * rs * gn0[0], f[1] * rs * gn0[1]); w.y = pk2(f[2] * rs * gn0[2], f[3] * rs * gn0[3]); w.z = pk2(f[4] * rs * gn1[0], f[5] * rs * gn1[1]); w.w = pk2(f[6] * rs * gn1[2], f[7] * rs * gn1[3]);
                    *(v4u*)(kvp + h * 256) = w; }
                { float x[4] = {pg8::bf_lo(krw.x), pg8::bf_hi(krw.x), pg8::bf_lo(krw.y), pg8::bf_hi(krw.y)};
                  float ss = (x[0] * x[0] + x[1] * x[1]) + (x[2] * x[2] + x[3] * x[3]);
                  ss += pg8::swz_xor<1>(ss); ss += pg8::swz_xor<2>(ss); ss += pg8::swz_xor<4>(ss); ss += pg8::swz_xor<8>(ss);
                  const float rs = __builtin_amdgcn_rsqf(ss * (1.0f / 64.0f) + EPS); float y[4];
#pragma unroll
                  for (int e = 0; e < 4; ++e) { const float mine = x[e] * rs * gr[e], other = pg8::swz_xor<8>(mine); float c, sn; rope_cs(pos, 4 * (j16 & 7) + e, c, sn);
                      y[e] = j16 < 8 ? mine * c - other * sn : mine * c + other * sn; }
                  v2u w; w.x = pk2(y[0], y[1]); w.y = pk2(y[2], y[3]); *(v2u*)(KRB + (size_t)t * 64 + 4 * j16) = w; }
            }
        }
#ifndef NO_GEMM
        else if (type == PH_G1) {
            pg8::Gemm g{XB, W13T + (size_t)(layer * 2 + sub) * N13 * DM, T, N13, DM, DM}; pg8::StaticOrder S; S.init(T, N13, G, bx);
            pg8::EpiSwiglu E{ACT, FF, SSQ};
#ifndef NO_G1
            pg8::gemm_phase<pg8::EpiSwiglu, pg8::StaticOrder, true, true, true>(ldsl, g, S, E, tid);
#endif
        }
        else if (type == PH_G2 || type == PH_WOUT) {
            const bool isw = type == PH_WOUT;
            pg8::Gemm g{isw ? MIX : ACT, isw ? WOUTT + (size_t)layer * DM * DM : W2T + (size_t)(layer * 2 + sub) * DM * FF, T, DM, isw ? DM : FF, isw ? DM : FF}; pg8::StaticOrder S; S.init(T, DM, G, bx);
            float alpha_ = isw ? 1.0f : 0.5f;
#ifdef PROBE_TYPE
            if (type == PROBE_TYPE) alpha_ *= 0.5f;
#endif
            pg8::EpiResid E{ph == 35 ? X : nullptr, (_Float16*)XB, SSQ, alpha_};
#ifndef NO_G2
            pg8::gemm_phase<pg8::EpiResid, pg8::StaticOrder, true, true>(ldsl, g, S, E, tid);
#endif
        }
        else if (type == PH_MEMKV || type == PH_CONVIN || type == PH_MLAIN || type == PH_UQ || type == PH_KV1 || type == PH_KV2) {
            pg8::Gemm g; pg8::EpiGen E; int M_ = T;
            if (type == PH_MEMKV) { g = pg8::Gemm{MEMB, WMEMKVT, MEMROWS, NMEMKV, DM, DM}; M_ = MEMROWS; E = pg8::EpiGen{MEMKVRAW, NMEMKV, MEMSSQ, 4, 4, 1.0f / 1024.0f, 0, 0, nullptr, 0}; }
            else if (type == PH_CONVIN) { g = pg8::Gemm{XB, CONVINT + (size_t)layer * NCONV * DM, T, NCONV, DM, DM}; E = pg8::EpiGen{PCONV, PSTRIDE, SSQ, 16, 16, 1.0f / 1024.0f, 6, 768, nullptr, 0}; }
            else if (type == PH_MLAIN) { g = pg8::Gemm{XB, MLAINT + (size_t)(layer - 2) * NMLA * DM, T, NMLA, DM, DM}; E = pg8::EpiGen{CQRAW, NMLA, SSQ, 16, 16, 1.0f / 1024.0f, 0, 0, CSSQ, 24}; }
            else if (type == PH_UQ) { g = pg8::Gemm{CQRAW, WUQT + (size_t)(layer - 2) * (MiB / 2), T, NUQ, 384, NMLA}; E = pg8::EpiGen{QRAW, NUQ, CSSQ, 24, 12, 1.0f / 384.0f, 0, 0, nullptr, 0}; }
            else if (type == PH_KV1) { g = pg8::Gemm{XB, WKV1T, T, NKV1, DM, DM}; E = pg8::EpiGen{CKVRAW, NKV1, SSQ, 16, 16, 1.0f / 1024.0f, 0, 0, CSSQ, 16}; }
            else { g = pg8::Gemm{CKVRAW, WKV2T, T, NKV2, 256, NKV1}; E = pg8::EpiGen{KVB, NKV2, CSSQ, 16, 8, 1.0f / 256.0f, 0, 0, nullptr, 0}; }
            pg8::StaticOrder S; S.init(M_, g.N, G, bx);
#ifndef NO_GEN
            if (type == PH_CONVIN || type == PH_MLAIN || type == PH_KV1) pg8::gemm_phase<pg8::EpiGen, pg8::StaticOrder, true, true, true>(ldsl, g, S, E, tid);
            else pg8::gemm_phase<pg8::EpiGen, pg8::StaticOrder, true, true, false>(ldsl, g, S, E, tid);
#endif
        }
#endif
        else if (type == PH_CONVMIX || type == PH_MLAATT) {
            const int W = 1 << 20;
            if (type == PH_CONVMIX) {
                const float* cw = conv_w + (size_t)layer * 3 * 768;
                for (int idx = bx * (NWAVES * 64) + tid; idx < T * 96; idx += G * NWAVES * 64) { const int t = idx / 96, c8 = (idx % 96) * 8, s = t & (SEQ - 1);
                    const bf16* up = PCONV + (size_t)t * PSTRIDE + c8; const bf16x8 u0 = *(const bf16x8*)up; const bf16x8 gb = *(const bf16x8*)(up + 768);
                    bf16x8 u1 = {0, 0, 0, 0, 0, 0, 0, 0}, u2 = {0, 0, 0, 0, 0, 0, 0, 0};
                    if (s >= 1) u1 = *(const bf16x8*)(up - PSTRIDE); if (s >= 2) u2 = *(const bf16x8*)(up - 2 * PSTRIDE);
                    float y[8];
#pragma unroll
                    for (int j = 0; j < 8; ++j) { const float acc = cw[c8 + j] * bf2f((unsigned short)u2[j]) + cw[768 + c8 + j] * bf2f((unsigned short)u1[j]) + cw[1536 + c8 + j] * bf2f((unsigned short)u0[j]);
                        y[j] = bf2f((unsigned short)gb[j]) * acc; }
                    v4u o; o.x = pk2(y[0], y[1]); o.y = pk2(y[2], y[3]); o.z = pk2(y[4], y[5]); o.w = pk2(y[6], y[7]);
                    *(v4u*)(MIX + (size_t)t * DM + c8) = o; }
            } else {
#ifndef NO_MLA
                const int j = layer - 2; const float* gqn = g_q_nope + j * 128; const float* gqr = g_q_rope + j * 64;
                for (int L = vcu; L < 768; L += G)
                    for (int pass = 0; pass < 2; ++pass) {
                        att::BlockRef cur;
                        { const int bh_ = L >> 4, x_ = L & 15, b_ = bh_ / 6, h_ = bh_ % 6, qb_ = pass ? 31 - x_ : x_; const size_t t0_ = (size_t)b_ * SEQ + (size_t)qb_ * 256;
                          cur.Q = QRAW + t0_ * NUQ + h_ * 192; cur.K = KVB + (size_t)b_ * SEQ * NKV2 + h_ * 256; cur.V = cur.K + 128; cur.KR = KRB + (size_t)b_ * SEQ * 64;
                          cur.O = MIX + t0_ * DM + h_ * 128; cur.P0 = qb_ * 256; cur.qs = NUQ; cur.tok = (int)t0_; cur.pad = 0; }
                        bf16x8 qr[12];
                        const int r32 = lane & 31, hi = lane >> 5; const int pos = positions[cur.tok + wave * 32 + r32];
#pragma unroll
                        for (int d0 = 0; d0 < 12; ++d0) qr[d0] = att::load8(cur.Q + (size_t)(wave * 32 + r32) * NUQ + d0 * 16 + hi * 8);
                        { float ss = 0.f;
#pragma unroll
                          for (int d0 = 0; d0 < 8; ++d0)
#pragma unroll
                              for (int e = 0; e < 8; ++e) { const float v = bf2f((unsigned short)qr[d0][e]); ss += v * v; }
                          ss = pg8::add_xor32(ss); const float rn = __builtin_amdgcn_rsqf(ss * (1.0f / 128.0f) + EPS) * 0.07216878364870322f;
#pragma unroll
                          for (int d0 = 0; d0 < 8; ++d0) { const f32x4 g0 = *(const f32x4*)(gqn + d0 * 16 + hi * 8), g1 = *(const f32x4*)(gqn + d0 * 16 + hi * 8 + 4); v4u w;
                              w.x = pk2(bf2f((unsigned short)qr[d0][0]) * rn * g0[0], bf2f((unsigned short)qr[d0][1]) * rn * g0[1]); w.y = pk2(bf2f((unsigned short)qr[d0][2]) * rn * g0[2], bf2f((unsigned short)qr[d0][3]) * rn * g0[3]);
                              w.z = pk2(bf2f((unsigned short)qr[d0][4]) * rn * g1[0], bf2f((unsigned short)qr[d0][5]) * rn * g1[1]); w.w = pk2(bf2f((unsigned short)qr[d0][6]) * rn * g1[2], bf2f((unsigned short)qr[d0][7]) * rn * g1[3]);
                              qr[d0] = *reinterpret_cast<bf16x8*>(&w); __builtin_amdgcn_sched_barrier(0); }
                          float s2 = 0.f;
#pragma unroll
                          for (int d0 = 8; d0 < 12; ++d0)
#pragma unroll
                              for (int e = 0; e < 8; ++e) { const float v = bf2f((unsigned short)qr[d0][e]); s2 += v * v; }
                          s2 = pg8::add_xor32(s2); const float rr = __builtin_amdgcn_rsqf(s2 * (1.0f / 64.0f) + EPS) * 0.07216878364870322f;
#pragma unroll
                          for (int d0 = 0; d0 < 2; ++d0) { float y1[8], y2[8];
#pragma unroll
                              for (int e = 0; e < 8; ++e) { const int i = d0 * 16 + hi * 8 + e; const float a = bf2f((unsigned short)qr[8 + d0][e]) * rr * gqr[i], b2 = bf2f((unsigned short)qr[10 + d0][e]) * rr * gqr[32 + i];
                                  float c, s; rope_cs(pos, i, c, s); y1[e] = a * c - b2 * s; y2[e] = b2 * c + a * s; __builtin_amdgcn_sched_barrier(0); }
                              v4u w1, w2; w1.x = pk2(y1[0], y1[1]); w1.y = pk2(y1[2], y1[3]); w1.z = pk2(y1[4], y1[5]); w1.w = pk2(y1[6], y1[7]);
                              w2.x = pk2(y2[0], y2[1]); w2.y = pk2(y2[2], y2[3]); w2.z = pk2(y2[4], y2[5]); w2.w = pk2(y2[6], y2[7]);
                              qr[8 + d0] = *reinterpret_cast<bf16x8*>(&w1); qr[10 + d0] = *reinterpret_cast<bf16x8*>(&w2); } }
                        att::attn_run<0>(cur, qr, SEQ, W, (char*)lds, tid);
                    }
#endif
            }
#ifndef NO_MEM
            {
                const bf16* QM = type == PH_CONVMIX ? PCONV + 1536 : CQRAW + 384; const int qs = type == PH_CONVMIX ? PSTRIDE : NMLA;
                const float* gq = g_mem_q + layer * 64;
                for (int L = vcu; L < 1024; L += G) {
                    att::BlockRef cur;
                    { const int tt_ = L >> 2, h_ = L & 3, b_ = tt_ >> 5; const size_t t0_ = (size_t)tt_ * 256; const size_t kvo_ = (((size_t)layer * NBATCH + b_) * 4 + h_) * 256 * 128;
                      cur.Q = QM + t0_ * qs + h_ * 64; cur.K = KMEM + kvo_; cur.V = VMEM + kvo_; cur.KR = nullptr; cur.O = MIX + t0_ * DM + 768 + h_ * 64; cur.P0 = 256; cur.qs = qs; cur.tok = (int)t0_; cur.pad = 0; }
                    bf16x8 qr[4]; const int r32 = lane & 31, hi = lane >> 5;
#pragma unroll
                    for (int d0 = 0; d0 < 4; ++d0) qr[d0] = att::load8(cur.Q + (size_t)(wave * 32 + r32) * qs + d0 * 16 + hi * 8);
                    { float ss = 0.f;
#pragma unroll
                      for (int d0 = 0; d0 < 4; ++d0)
#pragma unroll
                          for (int e = 0; e < 8; ++e) { const float v = bf2f((unsigned short)qr[d0][e]); ss += v * v; }
                      ss = pg8::add_xor32(ss); const float rn = __builtin_amdgcn_rsqf(ss * (1.0f / 64.0f) + EPS) * 0.125f;
#pragma unroll
                      for (int d0 = 0; d0 < 4; ++d0) { const f32x4 g0 = *(const f32x4*)(gq + d0 * 16 + hi * 8), g1 = *(const f32x4*)(gq + d0 * 16 + hi * 8 + 4); v4u w;
                          w.x = pk2(bf2f((unsigned short)qr[d0][0]) * rn * g0[0], bf2f((unsigned short)qr[d0][1]) * rn * g0[1]); w.y = pk2(bf2f((unsigned short)qr[d0][2]) * rn * g0[2], bf2f((unsigned short)qr[d0][3]) * rn * g0[3]);
                          w.z = pk2(bf2f((unsigned short)qr[d0][4]) * rn * g1[0], bf2f((unsigned short)qr[d0][5]) * rn * g1[1]); w.w = pk2(bf2f((unsigned short)qr[d0][6]) * rn * g1[2], bf2f((unsigned short)qr[d0][7]) * rn * g1[3]);
                          qr[d0] = *reinterpret_cast<bf16x8*>(&w); } }
                    att::attn_run<1>(cur, qr, 256, W, (char*)lds, tid);
                }
            }
#endif
        }
        bool again = false;
#ifdef PROBE_TYPE
        if (type == PROBE_TYPE && !probe_done) { probe_done = true; again = true; } else probe_done = false;
#endif
        if (again || ph + 1 < args.hi) { if (ph == 0 && !again) grid.sync(); else xcd_barrier(xbar, tid); }
#ifdef PROBE_SYNC
        if (again || ph + 1 < args.hi) xcd_barrier(xbar, tid);
#endif
        if (again) --ph;
    }
}

extern "C" void kernel_launch(void* const* d_in, const int* in_sizes, int n_in, void* d_out, int out_size, void* d_ws, size_t ws_size, hipStream_t stream) {
    static int grid = 0;
    constexpr int NPHASE = 36;
    if (grid == 0) {
        if (n_in != 25 || in_sizes[0] != T * DM || out_size != T * DM || ws_size < WS_END) { fprintf(stderr, "kernel_launch: unexpected shapes (n_in %d, in0 %d, out %d, ws %zu, need %zu)\n", n_in, n_in > 0 ? in_sizes[0] : -1, out_size, ws_size, (size_t)WS_END); grid = -1; return; }
        int dev = 0, cus = 0, per_cu = 0;
        if (hipGetDevice(&dev) != hipSuccess || hipDeviceGetAttribute(&cus, hipDeviceAttributeMultiprocessorCount, dev) != hipSuccess) { grid = -1; return; }
        if (hipFuncSetAttribute((const void*)yoco_fwd, hipFuncAttributeMaxDynamicSharedMemorySize, LDS_BYTES) != hipSuccess) { fprintf(stderr, "kernel_launch: hipFuncSetAttribute failed\n"); grid = -1; return; }
        if (hipOccupancyMaxActiveBlocksPerMultiprocessor(&per_cu, (const void*)yoco_fwd, NWAVES * 64, LDS_BYTES) != hipSuccess || per_cu < 1) { fprintf(stderr, "kernel_launch: occupancy query says %d\n", per_cu); per_cu = 1; }
        (void)hipGetLastError();
        grid = cus;
    }
    if (grid < 0) return;
    Args a{};
    for (int i = 0; i < 25; ++i) a.in[i] = d_in[i];
    a.out = (float*)d_out; a.ws = (unsigned char*)d_ws;
#if MK_N_LAUNCHES == 1
    if (hipMemsetAsync((char*)d_ws + WS_CTL, 0, CTL_BYTES, stream) != hipSuccess) { fprintf(stderr, "kernel_launch: memset of the barrier words failed\n"); return; }
    a.lo = 0; a.hi = NPHASE;
    void* kargs[] = {&a};
    hipError_t e = hipLaunchCooperativeKernel((const void*)yoco_fwd, dim3(grid), dim3(NWAVES * 64), kargs, LDS_BYTES, stream);
    if (e != hipSuccess) fprintf(stderr, "kernel_launch: cooperative launch failed: %s (grid %d)\n", hipGetErrorString(e), grid);
#else
    for (int p = 0; p < NPHASE; ++p) { a.lo = p; a.hi = p + 1; hipLaunchKernelGGL(yoco_fwd, dim3(grid), dim3(NWAVES * 64), LDS_BYTES, stream, a); }
#endif
}
```

```cpp
#include <hip/hip_runtime.h>
#include <hip/hip_cooperative_groups.h>
#include <cstdio>
#include <cstdint>
namespace cg = cooperative_groups;
namespace pg8 {
#define PG8_LAS __attribute__((address_space(3)))
typedef unsigned short bf16_t;
typedef short bf16x8 __attribute__((ext_vector_type(8)));
typedef float f32x4 __attribute__((ext_vector_type(4)));
typedef unsigned u32x4 __attribute__((ext_vector_type(4)));
constexpr int BM = 256, BK = 64, HALF = 128, HTB = HALF * BK * 2  , STAGE_BYTES = 8 * HTB, NXCD = 8, WGM = 8;

__host__ __device__ __forceinline__ int lds_byte(int r, int c) { const int st = (r >> 4) * 2 + (c >> 5), rr = r & 15, cc = c & 31, ob = rr * 64 + cc * 2; return st * 1024 + (ob ^ (((ob >> 9) & 1) << 5)); }
__host__ __device__ __forceinline__ void stage_rc(int b, int& R, int& C) { const int st = b / 1024, sb = b % 1024, swz = sb ^ (((sb >> 9) & 1) << 5); R = (st >> 1) * 16 + swz / 64; C = (st & 1) * 32 + (swz % 64) / 2; }
__host__ __device__ __forceinline__ int perm32(int rho) { const int n = rho >> 4, i = rho & 15; return 8 * (i >> 2) + 4 * n + (i & 3); }

struct Unit { int pm, pn; };
struct Gemm { const bf16_t* A; const bf16_t* Bt; int M, N, K, lda; };

struct StaticOrder {
    int nM, nN, nwg, G, c;
    __host__ __device__ void init(int M, int N, int G_, int c_) { nM = M / BM; nN = N / BM; nwg = nM * nN; G = G_; c = c_; }
    __host__ __device__ bool next(int i, Unit& u) const {
        const long L = (long)i * G + c; if (L >= nwg) return false;
        int wgid = (int)L; { const int q = nwg / NXCD, r = nwg % NXCD, xcd = wgid % NXCD, off = wgid / NXCD; wgid = (xcd < r ? xcd * (q + 1) : r * (q + 1) + (xcd - r) * q) + off; }
        const int nig = WGM * nN, gid = wgid / nig, fm = gid * WGM, gsz = (nM - fm) < WGM ? (nM - fm) : WGM;
        u.pm = fm + ((wgid % nig) % gsz); u.pn = (wgid % nig) / gsz; return true;
    }
    __device__ __forceinline__ void a_ready(const Unit&) const {}
    __device__ __forceinline__ void done(const Unit&) const {}
};

__device__ __forceinline__ unsigned cvt_pk_bf16(float lo, float hi) { unsigned r; asm volatile("v_cvt_pk_bf16_f32 %0, %1, %2" : "=v"(r) : "v"(lo), "v"(hi)); return r; }
typedef float f32x2 __attribute__((ext_vector_type(2)));
template <int XM> __device__ __forceinline__ float swz_xor(float v) { return __builtin_bit_cast(float, __builtin_amdgcn_ds_swizzle(__builtin_bit_cast(int, v), (XM << 10) | 0x1f)); }
__device__ __forceinline__ float add_xor32(float v) {
    auto r = __builtin_amdgcn_permlane32_swap(__float_as_uint(v), __float_as_uint(v), false, false); const unsigned r0 = r[0], r1 = r[1]; return __uint_as_float(r0) + __uint_as_float(r1); }
__device__ __forceinline__ float add_xor16_32(float s) { s += swz_xor<16>(s); return add_xor32(s); }
__device__ __forceinline__ float row_rs(const float* ssq, int stride, int nslots, float inv_n, int row, int fq) {
    const f32x4* p = (const f32x4*)(ssq + (size_t)row * stride); float s = 0.f;
    for (int i = 4 * fq; i < nslots; i += 16) { const f32x4 v = p[i >> 2]; s += (v[0] + v[1]) + (v[2] + v[3]); }
    s = add_xor16_32(s);
    return __builtin_amdgcn_rsqf(s * inv_n + 1e-6f);
}
__device__ __forceinline__ float sig_mul(float g, float u) {
    const float e = __builtin_amdgcn_exp2f(-1.4426950408889634f * g); return g * __builtin_amdgcn_rcpf(1.0f + e) * u;
}
struct EpiSwiglu {
    static constexpr bool PERM = true, AFTER_DRAIN = false;
    bf16_t* O; int ldc; const float* ssq;
    __device__ __forceinline__ void operator()(const f32x4 (&acc)[2][2][4][2], const Unit& u, int wr, int wc, int fr, int fq) const {
        const int row0 = u.pm * BM + wr * 64 + fr, col0 = u.pn * HALF + wc * 32 + 8 * fq;
        float rs[2][4];
#pragma unroll
        for (int ai = 0; ai < 2; ++ai)
#pragma unroll
            for (int m = 0; m < 4; ++m) rs[ai][m] = row_rs(ssq, 16, 16, 1.0f / 1024.0f, row0 + ai * HALF + m * 16, fq);
#pragma unroll
        for (int ai = 0; ai < 2; ++ai)
#pragma unroll
            for (int m = 0; m < 4; ++m) { const int row = row0 + ai * HALF + m * 16; const float r_ = rs[ai][m];
                const f32x4 g0 = acc[ai][0][m][0] * r_, g1 = acc[ai][0][m][1] * r_, u0 = acc[ai][1][m][0] * r_, u1 = acc[ai][1][m][1] * r_;
                u32x4 w; w.x = cvt_pk_bf16(sig_mul(g0[0], u0[0]), sig_mul(g0[1], u0[1])); w.y = cvt_pk_bf16(sig_mul(g0[2], u0[2]), sig_mul(g0[3], u0[3]));
                w.z = cvt_pk_bf16(sig_mul(g1[0], u1[0]), sig_mul(g1[1], u1[1])); w.w = cvt_pk_bf16(sig_mul(g1[2], u1[2]), sig_mul(g1[3], u1[3]));
                *(u32x4*)(O + (size_t)row * ldc + col0) = w; }
    }
};
typedef _Float16 h16x8 __attribute__((ext_vector_type(8)));
template <bool F16> __device__ __forceinline__ f32x4 mma16(bf16x8 a, bf16x8 b, f32x4 c) {
    if constexpr (F16) return __builtin_amdgcn_mfma_f32_16x16x32_f16(__builtin_bit_cast(h16x8, a), __builtin_bit_cast(h16x8, b), c, 0, 0, 0);
    else return __builtin_amdgcn_mfma_f32_16x16x32_bf16(a, b, c, 0, 0, 0);
}
__device__ __forceinline__ float bf_lo(unsigned w) { return __builtin_bit_cast(float, w << 16); }
__device__ __forceinline__ float bf_hi(unsigned w) { return __builtin_bit_cast(float, w & 0xffff0000u); }
struct EpiResid {
    static constexpr bool PERM = true, AFTER_DRAIN = false;
    float* fout; _Float16* XH; float* ssq; float alpha;
    __device__ __forceinline__ void operator()(const f32x4 (&acc)[2][2][4][2], const Unit& u, int wr, int wc, int fr, int fq) const {
        const int row0 = u.pm * BM + wr * 64 + fr, col0 = u.pn * BM + wc * 32 + 8 * fq;
#pragma unroll
        for (int ai = 0; ai < 2; ++ai) {
            h16x8 pre[4][2];
#pragma unroll
            for (int m = 0; m < 4; ++m)
#pragma unroll
                for (int bj = 0; bj < 2; ++bj) pre[m][bj] = *(const h16x8*)(XH + (size_t)(row0 + ai * HALF + m * 16) * 1024 + col0 + bj * HALF);
#pragma unroll
            for (int m = 0; m < 4; ++m) { const int row = row0 + ai * HALF + m * 16; _Float16* bp = XH + (size_t)row * 1024 + col0; float s = 0.f;
#pragma unroll
                for (int bj = 0; bj < 2; ++bj) { const h16x8 o = pre[m][bj];
                    const f32x4 o0 = {(float)o[0], (float)o[1], (float)o[2], (float)o[3]}, o1 = {(float)o[4], (float)o[5], (float)o[6], (float)o[7]};
                    const f32x4 v0 = o0 + acc[ai][bj][m][0] * alpha, v1 = o1 + acc[ai][bj][m][1] * alpha;
                    if (fout) { float* xp = fout + (size_t)row * 1024 + col0 + bj * HALF; *(f32x4*)xp = v0; *(f32x4*)(xp + 4) = v1; }
                    const h16x8 w = {(_Float16)v0[0], (_Float16)v0[1], (_Float16)v0[2], (_Float16)v0[3], (_Float16)v1[0], (_Float16)v1[1], (_Float16)v1[2], (_Float16)v1[3]};
                    *(h16x8*)(bp + bj * HALF) = w;
                    s += (v0[0] * v0[0] + v0[1] * v0[1]) + (v0[2] * v0[2] + v0[3] * v0[3]) + (v1[0] * v1[0] + v1[1] * v1[1]) + (v1[2] * v1[2] + v1[3] * v1[3]); }
                s = add_xor16_32(s);
                if (fq == 0) ssq[(size_t)row * 16 + u.pn * 4 + wc] = s; }
            asm volatile("" ::: "memory"); }
    }
};
struct EpiGen {
    static constexpr bool PERM = true, AFTER_DRAIN = false;
    bf16_t* O; int ldc; const float* ssq; int ssq_stride, ssq_n; float ssq_inv; int npair, col_shift; float* osq; int osq_stride;
    __device__ __forceinline__ void operator()(const f32x4 (&acc)[2][2][4][2], const Unit& u, int wr, int wc, int fr, int fq) const {
        const int row0 = u.pm * BM + wr * 64 + fr; const bool pair = u.pn < npair;
        const int col0 = (pair ? u.pn * HALF : u.pn * BM - col_shift) + wc * 32 + 8 * fq;
        float rsv[2][4];
#pragma unroll
        for (int ai = 0; ai < 2; ++ai)
#pragma unroll
            for (int m = 0; m < 4; ++m) rsv[ai][m] = ssq ? row_rs(ssq, ssq_stride, ssq_n, ssq_inv, row0 + ai * HALF + m * 16, fq) : 1.0f;
#pragma unroll
        for (int ai = 0; ai < 2; ++ai)
#pragma unroll
            for (int m = 0; m < 4; ++m) { const int row = row0 + ai * HALF + m * 16; const float rs = rsv[ai][m];
                bf16_t* rowp = O + (size_t)row * ldc + col0;
                if (pair) { const f32x4 v0 = (acc[ai][0][m][0] * rs) * (acc[ai][1][m][0] * rs), v1 = (acc[ai][0][m][1] * rs) * (acc[ai][1][m][1] * rs);
                    u32x4 w; w.x = cvt_pk_bf16(v0[0], v0[1]); w.y = cvt_pk_bf16(v0[2], v0[3]); w.z = cvt_pk_bf16(v1[0], v1[1]); w.w = cvt_pk_bf16(v1[2], v1[3]);
                    *(u32x4*)rowp = w; }
                else {
#pragma unroll
                    for (int bj = 0; bj < 2; ++bj) { const f32x4 v0 = acc[ai][bj][m][0] * rs, v1 = acc[ai][bj][m][1] * rs;
                        u32x4 w; w.x = cvt_pk_bf16(v0[0], v0[1]); w.y = cvt_pk_bf16(v0[2], v0[3]); w.z = cvt_pk_bf16(v1[0], v1[1]); w.w = cvt_pk_bf16(v1[2], v1[3]);
                        *(u32x4*)(rowp + bj * HALF) = w;
                        if (osq) { float s = (v0[0] * v0[0] + v0[1] * v0[1]) + (v0[2] * v0[2] + v0[3] * v0[3]) + (v1[0] * v1[0] + v1[1] * v1[1]) + (v1[2] * v1[2] + v1[3] * v1[3]);
                            s = add_xor16_32(s);
                            if (fq == 0) osq[(size_t)row * osq_stride + u.pn * 8 + bj * 4 + wc] = s; } } } }
    }
};
template <class Epi, class Sched, bool ALIGN_EPI = false, bool SP2 = false, bool F16 = false>
__device__ __forceinline__ void gemm_phase(PG8_LAS unsigned char* lds, const Gemm g, const Sched& S, const Epi& E, const int tid) {
    const int wid = __builtin_amdgcn_readfirstlane(tid >> 6), lane = tid & 63, wr = wid >> 2, wc = wid & 3, fr = lane & 15, fq = lane >> 4;
    const int K = g.K, nt = K / BK;
    unsigned voffA[2], voffB[2];
#pragma unroll
    for (int i = 0; i < 2; ++i) { int R, C; stage_rc(tid * 16 + i * 8192, R, C); const int Rb = Epi::PERM ? ((R & ~31) + perm32(R & 31)) : R;
        voffA[i] = (unsigned)(R * g.lda + C) * 2u; voffB[i] = (unsigned)(Rb * K + C) * 2u; }
    const size_t kstep = (size_t)(BK * 2);
    const size_t hstep = (size_t)HALF * K * 2;
    const size_t tstep = 2 * hstep; const size_t hstepA = (size_t)HALF * g.lda * 2, tstepA = 2 * hstepA;
    const unsigned ldsw = (unsigned)wid * 1024u;
    const int aoff = lds_byte(wr * 64 + fr, fq * 8), boff = lds_byte(wc * 32 + fr, fq * 8);
#define PG8_SA(b, h) (((b) * 2 + (h)) * HTB)
#define PG8_SB(b, h) ((4 + (b) * 2 + (h)) * HTB)
#define PG8_STAGE(bufoff, gbase, voff) do { _Pragma("unroll") for (int _i = 0; _i < 2; ++_i) \
        __builtin_amdgcn_global_load_lds((const unsigned*)((const char*)(gbase) + (voff)[_i]), (PG8_LAS unsigned*)(lds + (bufoff) + ldsw + _i * 8192), 16, 0, 0); } while (0)
#define PG8_LDA(dst, b, h) do { _Pragma("unroll") for (int m = 0; m < 4; ++m) _Pragma("unroll") for (int k = 0; k < 2; ++k) dst[m][k] = *(const PG8_LAS bf16x8*)(lds + PG8_SA(b, h) + aoff + m * 2048 + k * 1024); } while (0)
#define PG8_LDB(dst, b, h) do { _Pragma("unroll") for (int n = 0; n < 2; ++n) _Pragma("unroll") for (int k = 0; k < 2; ++k) dst[n][k] = *(const PG8_LAS bf16x8*)(lds + PG8_SB(b, h) + boff + n * 2048 + k * 1024); } while (0)
#define PG8_MMA(ai, bj, At, Bt) do { __builtin_amdgcn_s_setprio(1); _Pragma("unroll") for (int m = 0; m < 4; ++m) _Pragma("unroll") for (int n = 0; n < 2; ++n) _Pragma("unroll") for (int k = 0; k < 2; ++k) \
        acc[ai][bj][m][n] = mma16<F16>(Bt[n][k], At[m][k], acc[ai][bj][m][n]); __builtin_amdgcn_s_setprio(0); } while (0)
#define PG8_WAIT_V(n) asm volatile("s_waitcnt vmcnt(" #n ")" ::: "memory")
#define PG8_WAIT_L(n) asm volatile("s_waitcnt lgkmcnt(" #n ")" ::: "memory")
#define PG8_BAR __builtin_amdgcn_s_barrier()
#define PG8_SCHED __builtin_amdgcn_sched_barrier(0)
    Unit cur, nxt; int ui = 0;
    if (!S.next(0, cur)) return;
    f32x4 acc[2][2][4][2];
#pragma unroll
    for (int a = 0; a < 2; ++a)
#pragma unroll
        for (int b = 0; b < 2; ++b)
#pragma unroll
            for (int m = 0; m < 4; ++m)
#pragma unroll
                for (int n = 0; n < 2; ++n) acc[a][b][m][n] = (f32x4){0.f, 0.f, 0.f, 0.f};
    bf16x8 At[4][2], B0[2][2], B1[2][2];
    const char* cA = (const char*)g.A + (size_t)cur.pm * tstepA; const char* cB = (const char*)g.Bt + (size_t)cur.pn * tstep;
    S.a_ready(cur);
    if constexpr (SP2) {
        PG8_STAGE(PG8_SB(0, 0), cB, voffB); PG8_STAGE(PG8_SB(0, 1), cB + hstep, voffB); PG8_STAGE(PG8_SA(0, 0), cA, voffA); PG8_STAGE(PG8_SA(0, 1), cA + hstepA, voffA);
        if (wr == 1) PG8_BAR;
        PG8_WAIT_V(2); PG8_BAR;
        PG8_STAGE(PG8_SB(1, 0), cB + kstep, voffB); PG8_STAGE(PG8_SA(1, 0), cA + kstep, voffA); PG8_STAGE(PG8_SB(1, 1), cB + hstep + kstep, voffB);
        PG8_WAIT_V(6); PG8_BAR;
    } else {
        PG8_STAGE(PG8_SB(0, 0), cB, voffB); PG8_STAGE(PG8_SA(0, 0), cA, voffA); PG8_STAGE(PG8_SB(0, 1), cB + hstep, voffB); PG8_STAGE(PG8_SA(0, 1), cA + hstepA, voffA);
        if (wr == 1) PG8_BAR;
        PG8_WAIT_V(4); PG8_BAR;
        PG8_STAGE(PG8_SB(1, 0), cB + kstep, voffB); PG8_STAGE(PG8_SA(1, 0), cA + kstep, voffA); PG8_STAGE(PG8_SB(1, 1), cB + hstep + kstep, voffB);
        PG8_WAIT_V(6); PG8_BAR;
    }
    for (;;) {
        const bool has_next = S.next(ui + 1, nxt);
        const char* nA = has_next ? (const char*)g.A + (size_t)nxt.pm * tstepA : cA; const char* nB = has_next ? (const char*)g.Bt + (size_t)nxt.pn * tstep : cB;
        for (int t = 0; t < nt; t += 2) {
            const bool last = (t == nt - 2);
            const char* a1 = cA + (size_t)(t + 1) * kstep;
            const char* a2 = last ? nA : cA + (size_t)(t + 2) * kstep; const char* b2 = last ? nB : cB + (size_t)(t + 2) * kstep;
            const char* a3 = a2 + kstep; const char* b3 = b2 + kstep;
            if (last && has_next) S.a_ready(nxt);
            if constexpr (SP2) {
            PG8_LDB(B0, 0, 0); PG8_LDB(B1, 0, 1); PG8_SCHED; PG8_LDA(At, 0, 0); PG8_STAGE(PG8_SA(1, 1), a1 + hstepA, voffA);
            PG8_WAIT_V(8); PG8_WAIT_L(0); PG8_BAR; PG8_MMA(0, 0, At, B0); PG8_MMA(0, 1, At, B1); PG8_BAR; PG8_SCHED;
            PG8_LDA(At, 0, 1); PG8_STAGE(PG8_SB(0, 0), b2, voffB); PG8_STAGE(PG8_SB(0, 1), b2 + hstep, voffB); PG8_STAGE(PG8_SA(0, 0), a2, voffA);
            PG8_WAIT_V(8); PG8_WAIT_L(0); PG8_BAR; PG8_MMA(1, 0, At, B0); PG8_MMA(1, 1, At, B1); PG8_BAR; PG8_SCHED;
            PG8_LDB(B0, 1, 0); PG8_LDB(B1, 1, 1); PG8_SCHED; PG8_LDA(At, 1, 0); PG8_STAGE(PG8_SA(0, 1), a2 + hstepA, voffA);
            PG8_WAIT_V(8); PG8_WAIT_L(0); PG8_BAR; PG8_MMA(0, 0, At, B0); PG8_MMA(0, 1, At, B1); PG8_BAR; PG8_SCHED;
            PG8_LDA(At, 1, 1); PG8_STAGE(PG8_SB(1, 0), b3, voffB); PG8_STAGE(PG8_SB(1, 1), b3 + hstep, voffB); PG8_STAGE(PG8_SA(1, 0), a3, voffA);
            PG8_WAIT_V(8); PG8_WAIT_L(0); PG8_BAR; PG8_MMA(1, 0, At, B0); PG8_MMA(1, 1, At, B1); PG8_BAR; PG8_SCHED;
            } else {
            PG8_LDB(B0, 0, 0); PG8_SCHED; PG8_LDA(At, 0, 0); PG8_STAGE(PG8_SA(1, 1), a1 + hstepA, voffA);
            PG8_WAIT_L(8); PG8_BAR; PG8_WAIT_L(0); PG8_MMA(0, 0, At, B0); PG8_BAR; PG8_SCHED;
            PG8_LDB(B1, 0, 1); PG8_STAGE(PG8_SB(0, 0), b2, voffB);
            PG8_BAR; PG8_WAIT_L(0); PG8_MMA(0, 1, At, B1); PG8_BAR;
            PG8_LDA(At, 0, 1); PG8_STAGE(PG8_SA(0, 0), a2, voffA);
            PG8_BAR; PG8_WAIT_L(0); PG8_MMA(1, 0, At, B0); PG8_BAR; PG8_SCHED;
            PG8_STAGE(PG8_SB(0, 1), b2 + hstep, voffB);
            PG8_WAIT_V(6); PG8_BAR; PG8_MMA(1, 1, At, B1); PG8_BAR;
            PG8_LDB(B0, 1, 0); PG8_SCHED; PG8_LDA(At, 1, 0); PG8_STAGE(PG8_SA(0, 1), a2 + hstepA, voffA);
            PG8_WAIT_L(8); PG8_BAR; PG8_WAIT_L(0); PG8_MMA(0, 0, At, B0); PG8_BAR; PG8_SCHED;
            PG8_LDB(B1, 1, 1); PG8_STAGE(PG8_SB(1, 0), b3, voffB);
            PG8_BAR; PG8_WAIT_L(0); PG8_MMA(0, 1, At, B1); PG8_BAR;
            PG8_LDA(At, 1, 1); PG8_STAGE(PG8_SA(1, 0), a3, voffA);
            PG8_BAR; PG8_WAIT_L(0); PG8_MMA(1, 0, At, B0); PG8_BAR; PG8_SCHED;
            PG8_STAGE(PG8_SB(1, 1), b3 + hstep, voffB);
            PG8_WAIT_V(6); PG8_BAR; PG8_MMA(1, 1, At, B1); PG8_BAR;
            }
        }
        if constexpr (ALIGN_EPI) { if (wr == 0) PG8_BAR; }
        if constexpr (!Epi::AFTER_DRAIN) { E(acc, cur, wr, wc, fr, fq); S.done(cur); }
        if (!has_next) break;
#pragma unroll
        for (int a = 0; a < 2; ++a)
#pragma unroll
            for (int b = 0; b < 2; ++b)
#pragma unroll
                for (int m = 0; m < 4; ++m)
#pragma unroll
                    for (int n = 0; n < 2; ++n) acc[a][b][m][n] = (f32x4){0.f, 0.f, 0.f, 0.f};
        cur = nxt; cA = nA; cB = nB; ++ui;
        if constexpr (ALIGN_EPI) { if (wr == 1) PG8_BAR; }
    }
    PG8_WAIT_V(0);
    if constexpr (!ALIGN_EPI) { if (wr == 0) PG8_BAR; }
    PG8_BAR;
    if constexpr (Epi::AFTER_DRAIN) { E.fused(acc, cur, wr, wc, fr, fq, lds, wid, lane); S.done(cur); }
#undef PG8_SA
#undef PG8_SB
#undef PG8_STAGE
#undef PG8_LDA
#undef PG8_LDB
#undef PG8_MMA
#undef PG8_WAIT_V
#undef PG8_WAIT_L
#undef PG8_BAR
#undef PG8_SCHED
}
}
namespace att {
typedef unsigned short bf16_t;
typedef short bf16x8 __attribute__((ext_vector_type(8)));
typedef short s16x4 __attribute__((ext_vector_type(4)));
typedef float f32x16 __attribute__((ext_vector_type(16)));
typedef float f32x4 __attribute__((ext_vector_type(4)));
typedef unsigned u32x4 __attribute__((ext_vector_type(4)));
constexpr int NW = 8, QBLK = 32, KVBLK = 64, QB = NW * QBLK;
constexpr int SHM_V = KVBLK * 128 * 2, SHM_K = KVBLK * 128 * 2, SHM_KR = KVBLK * 64 * 2;
constexpr int NVB = 3;
constexpr int ATT_WS_OFF = NVB * SHM_V + 2 * SHM_K + 2 * SHM_KR;
constexpr int ATT_LDS_BYTES = ATT_WS_OFF + NW * 64 * 4;
constexpr float THR = 8.f;
template <int MODE> struct Cfg;
template <> struct Cfg<0> { static constexpr int NQF = 12, NQT = 8, NQK = 8, NPV = 4, KS = 1536, VS = 1536, OS = 1024; static constexpr bool ROPE = true; };
template <> struct Cfg<1> { static constexpr int NQF = 4, NQT = 4, NQK = 4, NPV = 2, KS = 128, VS = 128, OS = 1024; static constexpr bool ROPE = false; };

#define KSWZ(row, colB) ((row) * 256 + ((colB) ^ (((row) & 7) << 4)))
#define KRSWZ(row, colB) ((row) * 128 + ((colB) ^ ((((row) >> 1) & 7) << 4)))
#define SBAR() __builtin_amdgcn_sched_barrier(0)
__device__ __forceinline__ int v_st(int k, int c) { const int kk = (k & ~0xC) | ((k & 4) << 1) | ((k & 8) >> 1); return ((kk >> 3) * 4 + (c >> 5)) * 512 + ((kk & 7) * 32 + (c & 31)) * 2; }
__device__ __forceinline__ int v_rd_base(int lane) { return ((lane & 3) << 3) | (((lane >> 2) & 3) << 6) | (((lane >> 4) & 1) << 5) | (((lane >> 5) & 1) << 8); }
constexpr int v_rd_off(int d0, int ks, int half) { return d0 * 512 + ks * 4096 + half * 2048; }
__device__ __forceinline__ int crow(int r, int hi) { return (r & 3) + 8 * (r >> 2) + 4 * hi; }
__device__ __forceinline__ unsigned cvtpk(float lo, float hi) {
    unsigned r; asm volatile("v_cvt_pk_bf16_f32 %0, %1, %2" : "=v"(r) : "v"(lo), "v"(hi)); return r;
}
__device__ __forceinline__ bf16x8 load8(const bf16_t* p) { return *reinterpret_cast<const bf16x8*>(p); }
__device__ __forceinline__ void mask_tile(f32x16& p0, f32x16& p1, int dq, unsigned W) {
    const float NEG = -__builtin_inff();
#pragma unroll
    for (int r = 0; r < 16; ++r) {
        const int c = (r & 3) + 8 * (r >> 2);
        if ((unsigned)(dq - c) >= W) p0[r] = NEG;
        if ((unsigned)(dq - c - 32) >= W) p1[r] = NEG;
    }
}
__device__ __forceinline__ void partialSM(f32x16& p0, f32x16& p1, float& m_reg, float& mn, float& alpha) {
    float pmax = p0[0]; for (int r = 1; r < 16; ++r) pmax = fmaxf(pmax, p0[r]); for (int r = 0; r < 16; ++r) pmax = fmaxf(pmax, p1[r]);
    { auto rr = __builtin_amdgcn_permlane32_swap(__float_as_uint(pmax), __float_as_uint(pmax), false, false);
      pmax = fmaxf(__uint_as_float(rr[0]), __uint_as_float(rr[1])); }
    constexpr float C2 = 1.4426950408889634f;
    if (__builtin_expect(__all((pmax - m_reg) <= THR), 1)) { mn = m_reg; alpha = 1.f; }
    else { mn = fmaxf(m_reg, pmax); alpha = __builtin_amdgcn_exp2f((m_reg - mn) * C2); m_reg = mn; }
    const float mnL = -mn * C2;
    for (int r = 0; r < 16; ++r) p0[r] = fmaf(p0[r], C2, mnL); for (int r = 0; r < 16; ++r) p1[r] = fmaf(p1[r], C2, mnL);
    for (int r = 0; r < 16; ++r) p0[r] = __builtin_amdgcn_exp2f(p0[r]);
}
__device__ __forceinline__ void finishSM(f32x16& p0, f32x16& p1, float alpha, float& l_reg, bf16x8& pa0, bf16x8& pa1, bf16x8& pa2, bf16x8& pa3) {
    for (int r = 0; r < 16; ++r) p1[r] = __builtin_amdgcn_exp2f(p1[r]);
    float ps = 0; for (int r = 0; r < 16; ++r) ps += p0[r]; for (int r = 0; r < 16; ++r) ps += p1[r];
    { auto rr = __builtin_amdgcn_permlane32_swap(__float_as_uint(ps), __float_as_uint(ps), false, false);
      ps = __uint_as_float(rr[0]) + __uint_as_float(rr[1]); }
    l_reg = l_reg * alpha + ps;
#define PK4(P, B_, OUT) do { unsigned a0 = cvtpk(P[B_+0], P[B_+1]), a1 = cvtpk(P[B_+2], P[B_+3]);                          \
        unsigned b0 = cvtpk(P[B_+4], P[B_+5]), b1 = cvtpk(P[B_+6], P[B_+7]);                                             \
        auto r0 = __builtin_amdgcn_permlane32_swap(a0, b0, false, false); auto r1 = __builtin_amdgcn_permlane32_swap(a1, b1, false, false); \
        u32x4 w = {r0[0], r1[0], r0[1], r1[1]}; OUT = *reinterpret_cast<bf16x8*>(&w); } while (0)
    PK4(p0, 0, pa0); PK4(p0, 8, pa1); PK4(p1, 0, pa2); PK4(p1, 8, pa3);
#undef PK4
}
template <int MODE, int KB>
__device__ __forceinline__ void qkt(f32x16& p0, f32x16& p1, const char* K_lds, const char* KR_lds, int r32, int hi, const bf16x8* qr) {
    typedef Cfg<MODE> C;
    p0 = f32x16{}; p1 = f32x16{};
    const char* kb[4];
#pragma unroll
    for (int dd = 0; dd < 4; ++dd) kb[dd] = K_lds + KB * SHM_K + KSWZ(r32, (dd * 16 + hi * 8) * 2);
#pragma unroll
    for (int d0 = 0; d0 < C::NQK; ++d0) { const char* a = kb[d0 & 3] + (d0 >> 2) * 128;
        bf16x8 b0 = *reinterpret_cast<const bf16x8*>(a);
        bf16x8 b1 = *reinterpret_cast<const bf16x8*>(a + 32 * 256);
        p0 = __builtin_amdgcn_mfma_f32_32x32x16_bf16(b0, qr[d0], p0, 0, 0, 0);
        p1 = __builtin_amdgcn_mfma_f32_32x32x16_bf16(b1, qr[d0], p1, 0, 0, 0); }
    if constexpr (C::ROPE) {
#pragma unroll
        for (int dd = 0; dd < 4; ++dd) { const char* a = KR_lds + KB * SHM_KR + KRSWZ(r32, (dd * 16 + hi * 8) * 2);
            bf16x8 b0 = *reinterpret_cast<const bf16x8*>(a);
            bf16x8 b1 = *reinterpret_cast<const bf16x8*>(a + 32 * 128);
            p0 = __builtin_amdgcn_mfma_f32_32x32x16_bf16(b0, qr[8 + dd], p0, 0, 0, 0);
            p1 = __builtin_amdgcn_mfma_f32_32x32x16_bf16(b1, qr[8 + dd], p1, 0, 0, 0); }
    }
}
template <int MODE, int VB>
__device__ __forceinline__ void pv_tile(f32x16* o, int vb0, bf16x8 pa0, bf16x8 pa1, bf16x8 pa2, bf16x8 pa3) {
#define TRRD(dst, off) asm volatile("ds_read_b64_tr_b16 %0, %1 offset:%2" : "=&v"(dst) : "v"(vb0), "i"(off) : "memory")
#define PV_D0(d0) do { s16x4 l0, l1, l2, l3, h0, h1, h2, h3; constexpr int b_ = VB * SHM_V + v_rd_off(d0, 0, 0);     \
        TRRD(l0, b_); TRRD(h0, b_ + 2048); TRRD(l1, b_ + 4096); TRRD(h1, b_ + 6144); TRRD(l2, b_ + 8192); TRRD(h2, b_ + 10240); TRRD(l3, b_ + 12288); TRRD(h3, b_ + 14336); \
        asm volatile("s_waitcnt lgkmcnt(0)" ::: "memory"); SBAR();             \
        o[d0] = __builtin_amdgcn_mfma_f32_32x32x16_bf16(pa0, (bf16x8){l0[0], l0[1], l0[2], l0[3], h0[0], h0[1], h0[2], h0[3]}, o[d0], 0, 0, 0);   \
        o[d0] = __builtin_amdgcn_mfma_f32_32x32x16_bf16(pa1, (bf16x8){l1[0], l1[1], l1[2], l1[3], h1[0], h1[1], h1[2], h1[3]}, o[d0], 0, 0, 0);   \
        o[d0] = __builtin_amdgcn_mfma_f32_32x32x16_bf16(pa2, (bf16x8){l2[0], l2[1], l2[2], l2[3], h2[0], h2[1], h2[2], h2[3]}, o[d0], 0, 0, 0);   \
        o[d0] = __builtin_amdgcn_mfma_f32_32x32x16_bf16(pa3, (bf16x8){l3[0], l3[1], l3[2], l3[3], h3[0], h3[1], h3[2], h3[3]}, o[d0], 0, 0, 0); } while (0)
    PV_D0(0); PV_D0(1);
    if constexpr (Cfg<MODE>::NPV == 4) { PV_D0(2); PV_D0(3); }
#undef PV_D0
#undef TRRD
}

struct BlockRef { const bf16_t* Q; const bf16_t* K; const bf16_t* V; const bf16_t* KR; bf16_t* O; int P0; int qs; int tok; int pad; };
__device__ __forceinline__ int swa_jlo(int P0, int W) { const int lowk = P0 - W + 1; return lowk > 0 ? lowk / KVBLK : 0; }
template <int MODE>
__device__ __forceinline__ void attn_run(const BlockRef& cur, const bf16x8* qr, int skv, int W, char* lds, const int tid) {
    typedef Cfg<MODE> C;
    const int wid = __builtin_amdgcn_readfirstlane(tid >> 6), lane = tid & 63, r32 = lane & 31, hi = lane >> 5;
    const bool grpB = wid >= 4;
    const int j_lo = swa_jlo(cur.P0, W);
    int j_hi = (cur.P0 + QB - 1) / KVBLK + 1; if (j_hi > skv / KVBLK) j_hi = skv / KVBLK;
    const int NT = j_hi - j_lo;
    const int qlo = cur.P0 + wid * QBLK, qm = qlo + r32 - 4 * hi;
    char* V_lds = lds; char* K_lds = lds + NVB * SHM_V; char* KR_lds = lds + NVB * SHM_V + 2 * SHM_K;
    float* ws = (float*)(lds + ATT_WS_OFF) + wid * 64; float* li_l = ws, * al_l = ws + 32;
    float m_reg = -1e30f, l_reg = 0; f32x16 o[4] = {};
    const int sr = tid >> 4, sc = (tid & 15) * 8, vst0 = v_st(sr, sc), vst1 = v_st(32 + sr, sc), kws = KSWZ(sr, sc * 2);
    const int krr = tid >> 3, krc = (tid & 7) * 8, krw = KRSWZ(krr, krc * 2);
    const int vb0 = (int)(uintptr_t)V_lds + v_rd_base(lane);
    const bf16_t* Kh = cur.K; const bf16_t* Vh = cur.V; const bf16_t* KRh = cur.KR;
    bf16x8 st_v0, st_v1, st_k0, st_k1, st_kr;
#define ROWK(p, k0, rr) ((p) + (size_t)((k0) + (rr)) * C::KS + sc)
#define ROWV(p, k0, rr) ((p) + (size_t)((k0) + (rr)) * C::VS + sc)
#define VMW() asm volatile("s_waitcnt vmcnt(0)" ::: "memory")
#define SLOAD_H(k0) do { st_v0 = load8(ROWV(Vh, k0, sr)); st_v1 = load8(ROWV(Vh, k0, 32 + sr)); st_k0 = load8(ROWK(Kh, k0, sr)); st_k1 = load8(ROWK(Kh, k0, 32 + sr)); \
                         if constexpr (C::ROPE) st_kr = load8(KRh + (size_t)((k0) + krr) * 64 + krc); } while (0)
#define SWRITE_H(kb, vb) do { *(bf16x8*)(V_lds + (vb) * SHM_V + vst0) = st_v0; *(bf16x8*)(V_lds + (vb) * SHM_V + vst1) = st_v1;                           \
                          *(bf16x8*)(K_lds + (kb) * SHM_K + kws) = st_k0; *(bf16x8*)(K_lds + (kb) * SHM_K + kws + 32 * 256) = st_k1;                 \
                          if constexpr (C::ROPE) *(bf16x8*)(KR_lds + (kb) * SHM_KR + krw) = st_kr; } while (0)
#define RESC(a) do { if (__any((a) < 1.f)) { if (hi == 0) al_l[r32] = (a); asm volatile("s_waitcnt lgkmcnt(0)" ::: "memory");              \
                     for (int d_ = 0; d_ < C::NPV; ++d_) for (int r = 0; r < 16; ++r) o[d_][r] *= al_l[crow(r, hi)]; } } while (0)
#define KBASE(t) ((j_lo + (t)) * KVBLK)
#define MASKT(P0_, P1_, t) do { const int kb_ = KBASE(t); if (kb_ + KVBLK - 1 > qlo || kb_ <= qlo + QBLK - 1 - W) mask_tile(P0_, P1_, qm - kb_, (unsigned)W); } while (0)
    f32x16 p0, p1; float mn, al; bf16x8 pa0 = {}, pa1 = {}, pa2 = {}, pa3 = {};
    SLOAD_H(KBASE(0)); VMW(); SWRITE_H(0, 0); SBAR();
    if (NT > 1) { SLOAD_H(KBASE(1)); SBAR(); }
    __syncthreads();
    int vcur = 0, vprev = 0;
    for (int t = 0; t < NT; ++t) {
        const int kb = t & 1; const int vnext = vcur == NVB - 1 ? 0 : vcur + 1;
        SBAR();
        if (grpB && t > 0) { pv_tile<MODE, 0>(o, vb0 + vprev * SHM_V, pa0, pa1, pa2, pa3); SBAR(); }
        qkt<MODE, 0>(p0, p1, K_lds + kb * SHM_K, KR_lds + kb * SHM_KR, r32, hi, qr); SBAR();
        MASKT(p0, p1, t); partialSM(p0, p1, m_reg, mn, al); RESC(al);
        finishSM(p0, p1, al, l_reg, pa0, pa1, pa2, pa3); SBAR();
        if (!grpB) { pv_tile<MODE, 0>(o, vb0 + vcur * SHM_V, pa0, pa1, pa2, pa3); SBAR(); }
        if (t + 1 < NT) { VMW(); SWRITE_H(kb ^ 1, vnext); SBAR(); if (t + 2 < NT) { SLOAD_H(KBASE(t + 2)); SBAR(); } }
        __syncthreads();
        vprev = vcur; vcur = vnext;
    }
    if (grpB) { SBAR(); pv_tile<MODE, 0>(o, vb0 + vprev * SHM_V, pa0, pa1, pa2, pa3); SBAR(); }
    if (hi == 0) li_l[r32] = l_reg; asm volatile("s_waitcnt lgkmcnt(0)" ::: "memory");
    float rli[16];
#pragma unroll
    for (int r = 0; r < 16; ++r) rli[r] = __builtin_amdgcn_rcpf(li_l[crow(r, hi)]);
    bf16_t* Ow = cur.O + (size_t)(wid * QBLK) * C::OS;
#pragma unroll
    for (int r = 0; r < 16; ++r) { const int orow = crow(r, hi);
#pragma unroll
        for (int d0 = 0; d0 < C::NPV; ++d0) { const float v = o[d0][r] * rli[r];
            const float vn = pg8::swz_xor<1>(v);
            if ((r32 & 1) == 0) *(unsigned*)(Ow + (size_t)orow * C::OS + d0 * 32 + r32) = cvtpk(v, vn); } }
    __syncthreads();
#undef RESC
#undef KBASE
#undef MASKT
#undef ROWK
#undef ROWV
#undef VMW
#undef SLOAD_H
#undef SWRITE_H
}
}
#ifndef MK_N_LAUNCHES
#define MK_N_LAUNCHES 1
#endif
#define LAS __attribute__((address_space(3)))
typedef unsigned short bf16;
typedef float f32x4 __attribute__((ext_vector_type(4)));
typedef unsigned v4u __attribute__((ext_vector_type(4)));
typedef unsigned v2u __attribute__((ext_vector_type(2)));
typedef short bf16x8 __attribute__((ext_vector_type(8)));
constexpr int NWAVES = 8;
constexpr int T = 65536, DM = 1024, FF = 2816, NBATCH = 8, SEQ = 8192;
constexpr float EPS = 1e-6f;
constexpr int N13 = 2 * FF;
constexpr int NCONV = 2560, NMLA = 768, NUQ = 1280, NKV1 = 512, NKV2 = 1536, NMEMKV = 2048, MEMROWS = 2048;
constexpr int PSTRIDE = 1792;
constexpr size_t MiB = 1u << 20;
constexpr size_t WS_W13 = 0;
constexpr size_t WS_W2 = WS_W13 + 88 * MiB;
constexpr size_t WS_WOUT = WS_W2 + 44 * MiB;
constexpr size_t WS_CONVIN = WS_WOUT + 8 * MiB;
constexpr size_t WS_MLAIN = WS_CONVIN + 10 * MiB;
constexpr size_t WS_WUQ = WS_MLAIN + 3 * MiB;
constexpr size_t WS_WKV1 = WS_WUQ + 2 * MiB;
constexpr size_t WS_WKV2 = WS_WKV1 + 1 * MiB;
constexpr size_t WS_WMEMKV = WS_WKV2 + 1 * MiB;
constexpr size_t WS_SSQ = WS_WMEMKV + 4 * MiB;
constexpr size_t WS_CSSQ = WS_SSQ + 4 * MiB;
constexpr size_t WS_MEMB = WS_CSSQ + 6 * MiB;
constexpr size_t WS_MEMSSQ = WS_MEMB + 4 * MiB;
constexpr size_t WS_MEMKVRAW = WS_MEMSSQ + 1 * MiB;
constexpr size_t WS_KMEM = WS_MEMKVRAW + 8 * MiB;
constexpr size_t WS_VMEM = WS_KMEM + 8 * MiB;
constexpr size_t WS_XB = WS_VMEM + 8 * MiB;
constexpr size_t WS_ACT = WS_XB + 128 * MiB;
constexpr size_t WS_MIX = WS_ACT + 352 * MiB;
constexpr size_t WS_KVB = WS_MIX + 128 * MiB;
constexpr size_t WS_KR = WS_KVB + 192 * MiB;
constexpr size_t WS_CTL = WS_KR + 8 * MiB;
constexpr size_t CTL_BYTES = 65536;
constexpr size_t WS_END = WS_CTL + 1 * MiB;
static_assert(WS_END <= 1024 * MiB, "d_ws map must fit 1 GiB");
constexpr size_t ACT_QRAW = 96 * MiB;
constexpr int MISC_OFF = 143360;
constexpr int LDS_BYTES = 147456;
static_assert(att::ATT_LDS_BYTES <= LDS_BYTES, "attention LDS");

__constant__ float INVF[32] = {1.000000000e+00f, 7.498942614e-01f, 5.623413324e-01f, 4.216965139e-01f, 3.162277639e-01f, 2.371373773e-01f, 1.778279394e-01f, 1.333521307e-01f, 1.000000015e-01f, 7.498941571e-02f, 5.623413250e-02f, 4.216965288e-02f, 3.162277490e-02f, 2.371373773e-02f, 1.778279431e-02f, 1.333521493e-02f, 9.999999776e-03f, 7.498941850e-03f, 5.623413250e-03f, 4.216964822e-03f, 3.162277630e-03f, 2.371373586e-03f, 1.778279431e-03f, 1.333521446e-03f, 1.000000047e-03f, 7.498942432e-04f, 5.623413017e-04f, 4.216965172e-04f, 3.162277571e-04f, 2.371373703e-04f, 1.778279402e-04f, 1.333521504e-04f};

#define LDS_WAIT() asm volatile("s_waitcnt lgkmcnt(0)" ::: "memory")
__device__ __forceinline__ unsigned f2bf(float f) { unsigned u = __builtin_bit_cast(unsigned, f); return (u + 0x7fffu + ((u >> 16) & 1u)) >> 16; }
__device__ __forceinline__ unsigned pk2(float lo, float hi) { return f2bf(lo) | (f2bf(hi) << 16); }
__device__ __forceinline__ float bf2f(unsigned short h) { return __builtin_bit_cast(float, (unsigned)h << 16); }
__device__ __forceinline__ float wave_sum(float v) {
    v += pg8::swz_xor<1>(v); v += pg8::swz_xor<2>(v); v += pg8::swz_xor<4>(v); v += pg8::swz_xor<8>(v); v += pg8::swz_xor<16>(v);
    return pg8::add_xor32(v);
}
__device__ __forceinline__ void rope_cs(int pos, int i, float& c, float& s) {
    const float ang = (float)pos * INVF[i];
    double t = (double)ang * 0.15915494309189535; t -= __builtin_rint(t);
    const float fr = (float)t; c = __builtin_amdgcn_cosf(fr); s = __builtin_amdgcn_sinf(fr);
}

struct Args { const void* in[25]; float* out; unsigned char* ws; int lo, hi; };

enum { MAP_PLAIN = 0, MAP_GATEUP = 1, MAP_CONVIN = 2 };
__device__ __forceinline__ int map_col(int mode, int n0, int Nsrc) {
    if (mode == MAP_GATEUP) { const int tile = n0 >> 8, q = n0 & 255; return (q < 128 ? 0 : FF) + tile * 128 + (q & 127); }
    if (mode == MAP_CONVIN) { const int tile = n0 >> 8, q = n0 & 255; if (tile < 6) return (q < 128 ? 768 : 1536) + tile * 128 + (q & 127); if (tile < 9) return (tile - 6) * 256 + q; return 2304 + q; }
    return n0 < Nsrc ? n0 : -1;
}
#ifndef WMANT
#define WMANT 7
#endif
__device__ __forceinline__ float rmant(float f) {
    unsigned u = __builtin_bit_cast(unsigned, f); u += 1u << (22 - WMANT); u &= ~((1u << (23 - WMANT)) - 1u); return __builtin_bit_cast(float, u);
}
__device__ __forceinline__ unsigned pk2h(float lo, float hi) { typedef _Float16 h2 __attribute__((ext_vector_type(2))); const h2 v = {(_Float16)lo, (_Float16)hi}; return __builtin_bit_cast(unsigned, v); }
__device__ __forceinline__ void prep_weight(const float* W, const float* g, int K, int Nsrc, bf16* WT, int Ndst, int mode, bool f16, LAS float* scr, int gw, int NGW, int lane) {
    const int nblk = Ndst / 64, nitems = (K / 64) * nblk; const int kr = lane >> 4, c4 = (lane & 15) * 4;
    for (int item = gw; item < nitems; item += NGW) {
        const int kb = item / nblk, nb = item % nblk, k0 = 64 * kb, n0 = 64 * nb; const int s0 = map_col(mode, n0, Nsrc);
        if (s0 >= 0) {
            f32x4 v[16];
#pragma unroll
            for (int i = 0; i < 16; ++i) v[i] = *(const f32x4*)(W + (size_t)(k0 + 4 * i + kr) * Nsrc + s0 + c4);
#pragma unroll
            for (int i = 0; i < 16; ++i) { const int kk = 4 * i + kr; const float gv = g ? g[k0 + kk] : 1.0f; LAS float* d = scr + kk * 65 + c4;
                d[0] = v[i].x * gv; d[1] = v[i].y * gv; d[2] = v[i].z * gv; d[3] = v[i].w * gv; }
        }
        LDS_WAIT(); asm volatile("" ::: "memory");
        const int c = lane & 7;
#pragma unroll
        for (int j = 0; j < 8; ++j) { const int n = (lane >> 3) + 8 * j; const LAS float* s = scr + (8 * c) * 65 + n;
            v4u o = {0u, 0u, 0u, 0u};
            if (s0 >= 0) { float e[8];
#pragma unroll
                for (int q = 0; q < 8; ++q) e[q] = rmant(s[q * 65]);
                if (f16) { o.x = pk2h(e[0], e[1]); o.y = pk2h(e[2], e[3]); o.z = pk2h(e[4], e[5]); o.w = pk2h(e[6], e[7]); }
                else { o.x = pk2(e[0], e[1]); o.y = pk2(e[2], e[3]); o.z = pk2(e[4], e[5]); o.w = pk2(e[6], e[7]); } }
            *(v4u*)(WT + (size_t)(n0 + n) * K + k0 + 8 * c) = o; }
        LDS_WAIT(); asm volatile("" ::: "memory");
    }
}
__device__ __forceinline__ void row_to_bf16(const float* xrow, bool f16, bf16* orow, float* ssq, int nslot, int lane) {
    const f32x4* xr = (const f32x4*)xrow + lane; f32x4 v[4]; float s = 0.f;
#pragma unroll
    for (int j = 0; j < 4; ++j) { v[j] = xr[64 * j]; s += (v[j].x * v[j].x + v[j].y * v[j].y) + (v[j].z * v[j].z + v[j].w * v[j].w); }
    s = wave_sum(s);
    v2u* o8 = (v2u*)orow + lane;
#pragma unroll
    for (int j = 0; j < 4; ++j) { v2u w; if (f16) { w.x = pk2h(v[j].x, v[j].y); w.y = pk2h(v[j].z, v[j].w); } else { w.x = pk2(v[j].x, v[j].y); w.y = pk2(v[j].z, v[j].w); } o8[64 * j] = w; }
    if (lane < nslot) ssq[lane] = lane == 0 ? s : 0.f;
}

__device__ __forceinline__ const void* argp(int i) {
    const char __attribute__((address_space(4)))* ka = (const char __attribute__((address_space(4)))*)__builtin_amdgcn_kernarg_segment_ptr();
    int off = i * 8; asm volatile("" : "+s"(off));
    return *(const void* const __attribute__((address_space(4)))*)(ka + off);
}
#define XB_TMO      128
#define XB_XCNT(j)  (256  + 64 * (j))
#define XB_XSUB(j)  (1280 + 64 * (j))
#define XB_XGEN(j)  (2304 + 64 * (j))
#define XB_TOP      3328
#define XB_TOPGEN   3392
#define XCD_BAR_WORDS 3456
#define XB_SPIN_CAP (1u << 18)
__device__ __forceinline__ unsigned xb_ld(unsigned* p)              { return __hip_atomic_load(p, __ATOMIC_RELAXED, __HIP_MEMORY_SCOPE_AGENT); }
__device__ __forceinline__ unsigned xb_add(unsigned* p, unsigned v) { return __hip_atomic_fetch_add(p, v, __ATOMIC_RELAXED, __HIP_MEMORY_SCOPE_AGENT); }
__device__ __forceinline__ unsigned xb_xcc_id() { return (unsigned)__builtin_amdgcn_s_getreg((3 << 11) | 20) & 0xFu; }
#define XB_SPIN(cond, bar) do { unsigned _sp = 0; while (cond) { __builtin_amdgcn_s_sleep(1); \
    if ((++_sp & 255u) == 0u) { if (xb_ld(&(bar)[XB_TMO])) break; if (_sp > XB_SPIN_CAP) { atomicAdd(&(bar)[XB_TMO], 1u); break; } } } } while (0)
struct XcdBarrier { unsigned* bar; unsigned x; volatile LAS unsigned* st; };
__device__ __forceinline__ XcdBarrier xcd_barrier_post(unsigned* bar, volatile LAS unsigned* st) {
    XcdBarrier b; b.bar = bar; b.x = xb_xcc_id(); b.st = st;
    if (threadIdx.x == 0) (void)xb_add(&bar[XB_XCNT(b.x)], 1u);
    return b;
}
__device__ __forceinline__ void xcd_barrier_complete(unsigned* bar, unsigned x, unsigned& nloc, unsigned& nx) {
    const unsigned G = gridDim.x * gridDim.y * gridDim.z;
    unsigned sum, cnt, mine, sp = 0u;
    for (;;) {
        sum = 0u; cnt = 0u; mine = 0u;
#pragma unroll
        for (unsigned j = 0; j < 16; ++j) { const unsigned c = xb_ld(&bar[XB_XCNT(j)]); sum += c; cnt += (c > 0u) ? 1u : 0u; mine = (j == x) ? c : mine; }
        if (sum == G) break;
        __builtin_amdgcn_s_sleep(1);
        if ((++sp & 255u) == 0u) { if (xb_ld(&bar[XB_TMO])) break; if (sp > XB_SPIN_CAP) { atomicAdd(&bar[XB_TMO], 1u); break; } }
    }
    nloc = mine > 0u ? mine : 1u; nx = cnt > 0u ? cnt : 1u;
}
__device__ __forceinline__ void xcd_barrier(const XcdBarrier& b, const int tid) {
    asm volatile("s_waitcnt vmcnt(0)" ::: "memory");
    __syncthreads();
    if (tid == 0) {
        unsigned* bar = b.bar;
        __builtin_amdgcn_s_waitcnt(0);
        unsigned nloc = b.st[0], nx = b.st[1];
        if (nloc == 0u) { xcd_barrier_complete(bar, b.x, nloc, nx); b.st[0] = nloc; b.st[1] = nx; }
        const unsigned old = xb_add(&bar[XB_XSUB(b.x)], 1u);
        const unsigned gen = old / nloc;
        if (old + 1u == (gen + 1u) * nloc) {
            __builtin_amdgcn_fence(__ATOMIC_RELEASE, "agent");
            asm volatile("s_waitcnt vmcnt(0)" ::: "memory");
            const unsigned og = xb_add(&bar[XB_TOP], 1u);
            const unsigned tg = og / nx;
            if (og + 1u == (tg + 1u) * nx) xb_add(&bar[XB_TOPGEN], 1u);
            else XB_SPIN(xb_ld(&bar[XB_TOPGEN]) == tg, bar);
            __builtin_amdgcn_fence(__ATOMIC_ACQUIRE, "agent");
            xb_add(&bar[XB_XGEN(b.x)], 1u);
            asm volatile("s_waitcnt vmcnt(0)" ::: "memory");
        } else {
            XB_SPIN(xb_ld(&bar[XB_XGEN(b.x)]) == gen, bar);
            __builtin_amdgcn_fence(__ATOMIC_ACQUIRE, "agent");
            asm volatile("s_waitcnt vmcnt(0)" ::: "memory");
        }
    }
    __syncthreads();
}
__global__ void __launch_bounds__(NWAVES * 64, 2) yoco_fwd(Args args) {
    extern __shared__ __attribute__((aligned(16))) unsigned char lds[];
    cg::grid_group grid = cg::this_grid();
    const int wave0 = __builtin_amdgcn_readfirstlane((int)threadIdx.x >> 6);
    const int G = gridDim.x, bx0 = blockIdx.x;
#define ARGP(i) argp(i)
#define x_in ((const float*)ARGP(0))
#define mem_in ((const float*)ARGP(1))
#define positions ((const int*)ARGP(2))
#define norm_g ((const float*)ARGP(3))
#define ffn_w13 ((const float*)ARGP(4))
#define ffn_w2 ((const float*)ARGP(5))
#define w_out ((const float*)ARGP(6))
#define mem_norm_g ((const float*)ARGP(7))
#define w_mem_kv ((const float*)ARGP(8))
#define g_mem_q ((const float*)ARGP(9))
#define g_mem_k ((const float*)ARGP(10))
#define conv_w_in ((const float*)ARGP(11))
#define conv_w ((const float*)ARGP(12))
#define mla_w_in ((const float*)ARGP(13))
#define g_q_lora ((const float*)ARGP(14))
#define w_uq ((const float*)ARGP(15))
#define g_q_nope ((const float*)ARGP(16))
#define g_q_rope ((const float*)ARGP(17))
#define kv_norm_g ((const float*)ARGP(18))
#define w_dkv ((const float*)ARGP(19))
#define g_ckv ((const float*)ARGP(20))
#define w_ukv ((const float*)ARGP(21))
#define w_kr ((const float*)ARGP(22))
#define g_k_nope ((const float*)ARGP(23))
#define g_k_rope ((const float*)ARGP(24))
#define X ((float*)ARGP(25))
#define WSB ((unsigned char*)ARGP(26))
#define W13T ((bf16*)(WSB + WS_W13))
#define W2T ((bf16*)(WSB + WS_W2))
#define WOUTT ((bf16*)(WSB + WS_WOUT))
#define CONVINT ((bf16*)(WSB + WS_CONVIN))
#define MLAINT ((bf16*)(WSB + WS_MLAIN))
#define WUQT ((bf16*)(WSB + WS_WUQ))
#define WKV1T ((bf16*)(WSB + WS_WKV1))
#define WKV2T ((bf16*)(WSB + WS_WKV2))
#define WMEMKVT ((bf16*)(WSB + WS_WMEMKV))
#define SSQ ((float*)(WSB + WS_SSQ))
#define CSSQ ((float*)(WSB + WS_CSSQ))
#define MEMB ((bf16*)(WSB + WS_MEMB))
#define MEMSSQ ((float*)(WSB + WS_MEMSSQ))
#define MEMKVRAW ((bf16*)(WSB + WS_MEMKVRAW))
#define KMEM ((bf16*)(WSB + WS_KMEM))
#define VMEM ((bf16*)(WSB + WS_VMEM))
#define XB ((bf16*)(WSB + WS_XB))
#define ACT ((bf16*)(WSB + WS_ACT))
#define MIX ((bf16*)(WSB + WS_MIX))
#define KVB ((bf16*)(WSB + WS_KVB))
#define KRB ((bf16*)(WSB + WS_KR))
#define PCONV ACT
#define CQRAW ACT
#define QRAW ((bf16*)(WSB + WS_ACT + ACT_QRAW))
#define CKVRAW ACT
    LAS unsigned char* ldsl = (LAS unsigned char*)lds;

    bool probe_done = false; (void)probe_done;
    volatile LAS unsigned* MISC = (volatile LAS unsigned*)(ldsl + MISC_OFF);
    if (threadIdx.x < 4) MISC[threadIdx.x] = 0u;
    __syncthreads();
    XcdBarrier xbar; xbar.bar = nullptr; xbar.x = 0; xbar.st = MISC;
    if (args.hi - args.lo > 1) xbar = xcd_barrier_post((unsigned*)(WSB + WS_CTL), MISC);
    for (int ph = args.lo; ph < args.hi; ++ph) {
        int wave = wave0, bx = bx0; asm volatile("" : "+s"(wave)); asm volatile("" : "+s"(bx));
        int lane = (int)__builtin_amdgcn_mbcnt_hi(~0u, __builtin_amdgcn_mbcnt_lo(~0u, 0u)); asm volatile("" : "+v"(lane)); const int tid = wave * 64 + lane; const int vcu = (G % 8 == 0) ? (bx % 8) * (G / 8) + bx / 8 : bx; const int gw = vcu * NWAVES + wave, NGW = G * NWAVES;
        int type, layer = 0, sub = 0;
        enum { PH_PREP, PH_MEMKV, PH_GLUE_MEM, PH_G1, PH_G2, PH_CONVIN, PH_CONVMIX, PH_WOUT, PH_KV1, PH_KV2, PH_GLUE_KV, PH_MLAIN, PH_UQ, PH_MLAATT };
        if (ph < 3) type = ph == 0 ? PH_PREP : (ph == 1 ? PH_MEMKV : PH_GLUE_MEM);
        else if (ph < 17) { const int q = ph - 3; layer = q / 7; const int st = q % 7;
            type = st == 0 ? PH_G1 : st == 1 ? PH_G2 : st == 2 ? PH_CONVIN : st == 3 ? PH_CONVMIX : st == 4 ? PH_WOUT : st == 5 ? PH_G1 : PH_G2; sub = st >= 5 ? 1 : 0; }
        else if (ph < 20) type = ph == 17 ? PH_KV1 : (ph == 18 ? PH_KV2 : PH_GLUE_KV);
        else { const int q = ph - 20; layer = 2 + q / 8; const int st = q % 8;
            type = st == 0 ? PH_G1 : st == 1 ? PH_G2 : st == 2 ? PH_MLAIN : st == 3 ? PH_UQ : st == 4 ? PH_MLAATT : st == 5 ? PH_WOUT : st == 6 ? PH_G1 : PH_G2; sub = st >= 6 ? 1 : 0; }

        if (type == PH_PREP) {
            LAS float* scr = (LAS float*)(ldsl + wave * 16640);
            for (int job = 0; job < 33; ++job) {
                const float* W; const float* g = nullptr; int K, Nsrc, Ndst, mode = MAP_PLAIN; bf16* dst;
                if (job < 8) { const int l = job >> 1, s = job & 1; W = ffn_w13 + (size_t)job * DM * N13; g = norm_g + (size_t)(l * 3 + (s ? 2 : 0)) * DM; K = DM; Nsrc = N13; Ndst = N13; mode = MAP_GATEUP; dst = W13T + (size_t)job * N13 * DM; }
                else if (job < 16) { const int j = job - 8; W = ffn_w2 + (size_t)j * FF * DM; K = FF; Nsrc = DM; Ndst = DM; dst = W2T + (size_t)j * DM * FF; }
                else if (job < 20) { const int l = job - 16; W = w_out + (size_t)l * DM * DM; K = DM; Nsrc = DM; Ndst = DM; dst = WOUTT + (size_t)l * DM * DM; }
                else if (job < 22) { const int l = job - 20; W = conv_w_in + (size_t)l * DM * NCONV; g = norm_g + (size_t)(l * 3 + 1) * DM; K = DM; Nsrc = NCONV; Ndst = NCONV; mode = MAP_CONVIN; dst = CONVINT + (size_t)l * NCONV * DM; }
                else if (job < 24) { const int j = job - 22; W = mla_w_in + (size_t)j * DM * 640; g = norm_g + (size_t)((2 + j) * 3 + 1) * DM; K = DM; Nsrc = 640; Ndst = NMLA; dst = MLAINT + (size_t)j * NMLA * DM; }
                else if (job < 26) { const int j = job - 24; W = w_uq + (size_t)j * 384 * 1152; g = g_q_lora + j * 384; K = 384; Nsrc = 1152; Ndst = NUQ; dst = WUQT + (size_t)j * (MiB / 2); }
                else if (job == 26) { W = w_dkv; g = kv_norm_g; K = DM; Nsrc = 256; Ndst = 256; dst = WKV1T; }
                else if (job == 27) { W = w_kr; g = kv_norm_g; K = DM; Nsrc = 64; Ndst = 256; dst = WKV1T + (size_t)256 * DM; }
                else if (job == 28) { W = w_ukv; g = g_ckv; K = 256; Nsrc = NKV2; Ndst = NKV2; dst = WKV2T; }
                else { const int l = job - 29; W = w_mem_kv + (size_t)l * DM * 512; g = mem_norm_g + l * DM; K = DM; Nsrc = 512; Ndst = 512; dst = WMEMKVT + (size_t)l * 512 * DM; }
                const bool f16w = job < 8 || (job >= 20 && job < 24) || job == 26 || job == 27;
                prep_weight(W, g, K, Nsrc, dst, Ndst, mode, f16w, scr, gw, NGW, lane);
            }
            for (int m = gw; m < T; m += NGW) row_to_bf16(x_in + (size_t)m * DM, true, XB + (size_t)m * DM, SSQ + (size_t)m * 16, 16, lane);
            for (int m = gw; m < MEMROWS; m += NGW) row_to_bf16(mem_in + (size_t)m * DM, false, MEMB + (size_t)m * DM, MEMSSQ + (size_t)m * 4, 4, lane);
        }
        else if (type == PH_GLUE_MEM) {
            for (int it = gw; it < 4 * MEMROWS * 4; it += NGW) { const int h = it & 3, row = (it >> 2) % MEMROWS, l = it / (4 * MEMROWS); const int b = row >> 8, m = row & 255;
                const float kv = bf2f(MEMKVRAW[(size_t)row * NMEMKV + l * 512 + h * 64 + lane]); const unsigned short vv = MEMKVRAW[(size_t)row * NMEMKV + l * 512 + 256 + h * 64 + lane];
                const float ss = wave_sum(kv * kv); const float kn = kv * __builtin_amdgcn_rsqf(ss * (1.0f / 64.0f) + EPS) * g_mem_k[l * 64 + lane];
                const size_t o = ((((size_t)l * NBATCH + b) * 4 + h) * 256 + m) * 128;
                KMEM[o + lane] = (bf16)f2bf(kn); KMEM[o + 64 + lane] = 0; VMEM[o + lane] = vv; VMEM[o + 64 + lane] = 0; }
        }
        else if (type == PH_GLUE_KV) {
            const int j16 = lane & 15;
            const f32x4 gn0 = *(const f32x4*)(g_k_nope + 8 * j16), gn1 = *(const f32x4*)(g_k_nope + 8 * j16 + 4), gr = *(const f32x4*)(g_k_rope + 4 * j16);
            for (int t4 = gw; t4 < T / 4; t4 += NGW) {
                const int t = t4 * 4 + (lane >> 4); const int pos = positions[t];
                bf16* kvp = KVB + (size_t)t * NKV2 + 8 * j16;
                bf16x8 kv[6];
#pragma unroll
                for (int h = 0; h < 6; ++h) kv[h] = *(const bf16x8*)(kvp + h * 256);
                const v2u krw = *(const v2u*)(CKVRAW + (size_t)t * NKV1 + 256 + 4 * j16);
#pragma unroll
                for (int h = 0; h < 6; ++h) { float f[8]; float ss = 0.f;
#pragma unroll
                    for (int e = 0; e < 8; ++e) { f[e] = bf2f((unsigned short)kv[h][e]); ss += f[e] * f[e]; }
                    ss += pg8::swz_xor<1>(ss); ss += pg8::swz_xor<2>(ss); ss += pg8::swz_xor<4>(ss); ss += pg8::swz_xor<8>(ss);
                    const float rs = __builtin_amdgcn_rsqf(ss * (1.0f / 128.0f) + EPS);
                    v4u w; w.x = pk2(f[0] * rs * gn0[0], f[1] * rs * gn0[1]); w.y = pk2(f[2] * rs * gn0[2], f[3] * rs * gn0[3]); w.z = pk2(f[4] * rs * gn1[0], f[5] * rs * gn1[1]); w.w = pk2(f[6] * rs * gn1[2], f[7] * rs * gn1[3]);
                    *(v4u*)(kvp + h * 256) = w; }
                { float x[4] = {pg8::bf_lo(krw.x), pg8::bf_hi(krw.x), pg8::bf_lo(krw.y), pg8::bf_hi(krw.y)};
                  float ss = (x[0] * x[0] + x[1] * x[1]) + (x[2] * x[2] + x[3] * x[3]);
                  ss += pg8::swz_xor<1>(ss); ss += pg8::swz_xor<2>(ss); ss += pg8::swz_xor<4>(ss); ss += pg8::swz_xor<8>(ss);
                  const float rs = __builtin_amdgcn_rsqf(ss * (1.0f / 64.0f) + EPS); float y[4];
#pragma unroll
                  for (int e = 0; e < 4; ++e) { const float mine = x[e] * rs * gr[e], other = pg8::swz_xor<8>(mine); float c, sn; rope_cs(pos, 4 * (j16 & 7) + e, c, sn);
                      y[e] = j16 < 8 ? mine * c - other * sn : mine * c + other * sn; }
                  v2u w; w.x = pk2(y[0], y[1]); w.y = pk2(y[2], y[3]); *(v2u*)(KRB + (size_t)t * 64 + 4 * j16) = w; }
            }
        }
#ifndef NO_GEMM
        else if (type == PH_G1) {
            pg8::Gemm g{XB, W13T + (size_t)(layer * 2 + sub) * N13 * DM, T, N13, DM, DM}; pg8::StaticOrder S; S.init(T, N13, G, bx);
            pg8::EpiSwiglu E{ACT, FF, SSQ};
#ifndef NO_G1
            pg8::gemm_phase<pg8::EpiSwiglu, pg8::StaticOrder, true, true, true>(ldsl, g, S, E, tid);
#endif
        }
        else if (type == PH_G2 || type == PH_WOUT) {
            const bool isw = type == PH_WOUT;
            pg8::Gemm g{isw ? MIX : ACT, isw ? WOUTT + (size_t)layer * DM * DM : W2T + (size_t)(layer * 2 + sub) * DM * FF, T, DM, isw ? DM : FF, isw ? DM : FF}; pg8::StaticOrder S; S.init(T, DM, G, bx);
            float alpha_ = isw ? 1.0f : 0.5f;
#ifdef PROBE_TYPE
            if (type == PROBE_TYPE) alpha_ *= 0.5f;
#endif
            pg8::EpiResid E{ph == 35 ? X : nullptr, (_Float16*)XB, SSQ, alpha_};
#ifndef NO_G2
            pg8::gemm_phase<pg8::EpiResid, pg8::StaticOrder, true, true>(ldsl, g, S, E, tid);
#endif
        }
        else if (type == PH_MEMKV || type == PH_CONVIN || type == PH_MLAIN || type == PH_UQ || type == PH_KV1 || type == PH_KV2) {
            pg8::Gemm g; pg8::EpiGen E; int M_ = T;
            if (type == PH_MEMKV) { g = pg8::Gemm{MEMB, WMEMKVT, MEMROWS, NMEMKV, DM, DM}; M_ = MEMROWS; E = pg8::EpiGen{MEMKVRAW, NMEMKV, MEMSSQ, 4, 4, 1.0f / 1024.0f, 0, 0, nullptr, 0}; }
            else if (type == PH_CONVIN) { g = pg8::Gemm{XB, CONVINT + (size_t)layer * NCONV * DM, T, NCONV, DM, DM}; E = pg8::EpiGen{PCONV, PSTRIDE, SSQ, 16, 16, 1.0f / 1024.0f, 6, 768, nullptr, 0}; }
            else if (type == PH_MLAIN) { g = pg8::Gemm{XB, MLAINT + (size_t)(layer - 2) * NMLA * DM, T, NMLA, DM, DM}; E = pg8::EpiGen{CQRAW, NMLA, SSQ, 16, 16, 1.0f / 1024.0f, 0, 0, CSSQ, 24}; }
            else if (type == PH_UQ) { g = pg8::Gemm{CQRAW, WUQT + (size_t)(layer - 2) * (MiB / 2), T, NUQ, 384, NMLA}; E = pg8::EpiGen{QRAW, NUQ, CSSQ, 24, 12, 1.0f / 384.0f, 0, 0, nullptr, 0}; }
            else if (type == PH_KV1) { g = pg8::Gemm{XB, WKV1T, T, NKV1, DM, DM}; E = pg8::EpiGen{CKVRAW, NKV1, SSQ, 16, 16, 1.0f / 1024.0f, 0, 0, CSSQ, 16}; }
            else { g = pg8::Gemm{CKVRAW, WKV2T, T, NKV2, 256, NKV1}; E = pg8::EpiGen{KVB, NKV2, CSSQ, 16, 8, 1.0f / 256.0f, 0, 0, nullptr, 0}; }
            pg8::StaticOrder S; S.init(M_, g.N, G, bx);
#ifndef NO_GEN
            if (type == PH_CONVIN || type == PH_MLAIN || type == PH_KV1) pg8::gemm_phase<pg8::EpiGen, pg8::StaticOrder, true, true, true>(ldsl, g, S, E, tid);
            else pg8::gemm_phase<pg8::EpiGen, pg8::StaticOrder, true, true, false>(ldsl, g, S, E, tid);
#endif
        }
#endif
        else if (type == PH_CONVMIX || type == PH_MLAATT) {
            const int W = 1 << 20;
            if (type == PH_CONVMIX) {
                const float* cw = conv_w + (size_t)layer * 3 * 768;
                for (int idx = bx * (NWAVES * 64) + tid; idx < T * 96; idx += G * NWAVES * 64) { const int t = idx / 96, c8 = (idx % 96) * 8, s = t & (SEQ - 1);
                    const bf16* up = PCONV + (size_t)t * PSTRIDE + c8; const bf16x8 u0 = *(const bf16x8*)up; const bf16x8 gb = *(const bf16x8*)(up + 768);
                    bf16x8 u1 = {0, 0, 0, 0, 0, 0, 0, 0}, u2 = {0, 0, 0, 0, 0, 0, 0, 0};
                    if (s >= 1) u1 = *(const bf16x8*)(up - PSTRIDE); if (s >= 2) u2 = *(const bf16x8*)(up - 2 * PSTRIDE);
                    float y[8];
#pragma unroll
                    for (int j = 0; j < 8; ++j) { const float acc = cw[c8 + j] * bf2f((unsigned short)u2[j]) + cw[768 + c8 + j] * bf2f((unsigned short)u1[j]) + cw[1536 + c8 + j] * bf2f((unsigned short)u0[j]);
                        y[j] = bf2f((unsigned short)gb[j]) * acc; }
                    v4u o; o.x = pk2(y[0], y[1]); o.y = pk2(y[2], y[3]); o.z = pk2(y[4], y[5]); o.w = pk2(y[6], y[7]);
                    *(v4u*)(MIX + (size_t)t * DM + c8) = o; }
            } else {
#ifndef NO_MLA
                const int j = layer - 2; const float* gqn = g_q_nope + j * 128; const float* gqr = g_q_rope + j * 64;
                for (int L = vcu; L < 768; L += G)
                    for (int pass = 0; pass < 2; ++pass) {
                        att::BlockRef cur;
                        { const int bh_ = L >> 4, x_ = L & 15, b_ = bh_ / 6, h_ = bh_ % 6, qb_ = pass ? 31 - x_ : x_; const size_t t0_ = (size_t)b_ * SEQ + (size_t)qb_ * 256;
                          cur.Q = QRAW + t0_ * NUQ + h_ * 192; cur.K = KVB + (size_t)b_ * SEQ * NKV2 + h_ * 256; cur.V = cur.K + 128; cur.KR = KRB + (size_t)b_ * SEQ * 64;
                          cur.O = MIX + t0_ * DM + h_ * 128; cur.P0 = qb_ * 256; cur.qs = NUQ; cur.tok = (int)t0_; cur.pad = 0; }
                        bf16x8 qr[12];
                        const int r32 = lane & 31, hi = lane >> 5; const int pos = positions[cur.tok + wave * 32 + r32];
#pragma unroll
                        for (int d0 = 0; d0 < 12; ++d0) qr[d0] = att::load8(cur.Q + (size_t)(wave * 32 + r32) * NUQ + d0 * 16 + hi * 8);
                        { float ss = 0.f;
#pragma unroll
                          for (int d0 = 0; d0 < 8; ++d0)
#pragma unroll
                              for (int e = 0; e < 8; ++e) { const float v = bf2f((unsigned short)qr[d0][e]); ss += v * v; }
                          ss = pg8::add_xor32(ss); const float rn = __builtin_amdgcn_rsqf(ss * (1.0f / 128.0f) + EPS) * 0.07216878364870322f;
#pragma unroll
                          for (int d0 = 0; d0 < 8; ++d0) { const f32x4 g0 = *(const f32x4*)(gqn + d0 * 16 + hi * 8), g1 = *(const f32x4*)(gqn + d0 * 16 + hi * 8 + 4); v4u w;
                              w.x = pk2(bf2f((unsigned short)qr[d0][0]) * rn * g0[0], bf2f((unsigned short)qr[d0][1]) * rn * g0[1]); w.y = pk2(bf2f((unsigned short)qr[d0][2]) * rn * g0[2], bf2f((unsigned short)qr[d0][3]) * rn * g0[3]);
                              w.z = pk2(bf2f((unsigned short)qr[d0][4]) * rn * g1[0], bf2f((unsigned short)qr[d0][5]) * rn * g1[1]); w.w = pk2(bf2f((unsigned short)qr[d0][6]) * rn * g1[2], bf2f((unsigned short)qr[d0][7]) * rn * g1[3]);
                              qr[d0] = *reinterpret_cast<bf16x8*>(&w); __builtin_amdgcn_sched_barrier(0); }
                          float s2 = 0.f;
#pragma unroll
                          for (int d0 = 8; d0 < 12; ++d0)
#pragma unroll
                              for (int e = 0; e < 8; ++e) { const float v = bf2f((unsigned short)qr[d0][e]); s2 += v * v; }
                          s2 = pg8::add_xor32(s2); const float rr = __builtin_amdgcn_rsqf(s2 * (1.0f / 64.0f) + EPS) * 0.07216878364870322f;
#pragma unroll
                          for (int d0 = 0; d0 < 2; ++d0) { float y1[8], y2[8];
#pragma unroll
                              for (int e = 0; e < 8; ++e) { const int i = d0 * 16 + hi * 8 + e; const float a = bf2f((unsigned short)qr[8 + d0][e]) * rr * gqr[i], b2 = bf2f((unsigned short)qr[10 + d0][e]) * rr * gqr[32 + i];
                                  float c, s; rope_cs(pos, i, c, s); y1[e] = a * c - b2 * s; y2[e] = b2 * c + a * s; __builtin_amdgcn_sched_barrier(0); }
                              v4u w1, w2; w1.x = pk2(y1[0], y1[1]); w1.y = pk2(y1[2], y1[3]); w1.z = pk2(y1[4], y1[5]); w1.w = pk2(y1[6], y1[7]);
                              w2.x = pk2(y2[0], y2[1]); w2.y = pk2(y2[2], y2[3]); w2.z = pk2(y2[4], y2[5]); w2.w = pk2(y2[6], y2[7]);
                              qr[8 + d0] = *reinterpret_cast<bf16x8*>(&w1); qr[10 + d0] = *reinterpret_cast<bf16x8*>(&w2); } }
                        att::attn_run<0>(cur, qr, SEQ, W, (char*)lds, tid);
                    }
#endif
            }
#ifndef NO_MEM
            {
                const bf16* QM = type == PH_CONVMIX ? PCONV + 1536 : CQRAW + 384; const int qs = type == PH_CONVMIX ? PSTRIDE : NMLA;
                const float* gq = g_mem_q + layer * 64;
                for (int L = vcu; L < 1024; L += G) {
                    att::BlockRef cur;
                    { const int tt_ = L >> 2, h_ = L & 3, b_ = tt_ >> 5; const size_t t0_ = (size_t)tt_ * 256; const size_t kvo_ = (((size_t)layer * NBATCH + b_) * 4 + h_) * 256 * 128;
                      cur.Q = QM + t0_ * qs + h_ * 64; cur.K = KMEM + kvo_; cur.V = VMEM + kvo_; cur.KR = nullptr; cur.O = MIX + t0_ * DM + 768 + h_ * 64; cur.P0 = 256; cur.qs = qs; cur.tok = (int)t0_; cur.pad = 0; }
                    bf16x8 qr[4]; const int r32 = lane & 31, hi = lane >> 5;
#pragma unroll
                    for (int d0 = 0; d0 < 4; ++d0) qr[d0] = att::load8(cur.Q + (size_t)(wave * 32 + r32) * qs + d0 * 16 + hi * 8);
                    { float ss = 0.f;
#pragma unroll
                      for (int d0 = 0; d0 < 4; ++d0)
#pragma unroll
                          for (int e = 0; e < 8; ++e) { const float v = bf2f((unsigned short)qr[d0][e]); ss += v * v; }
                      ss = pg8::add_xor32(ss); const float rn = __builtin_amdgcn_rsqf(ss * (1.0f / 64.0f) + EPS) * 0.125f;
#pragma unroll
                      for (int d0 = 0; d0 < 4; ++d0) { const f32x4 g0 = *(const f32x4*)(gq + d0 * 16 + hi * 8), g1 = *(const f32x4*)(gq + d0 * 16 + hi * 8 + 4); v4u w;
                          w.x = pk2(bf2f((unsigned short)qr[d0][0]) * rn * g0[0], bf2f((unsigned short)qr[d0][1]) * rn * g0[1]); w.y = pk2(bf2f((unsigned short)qr[d0][2]) * rn * g0[2], bf2f((unsigned short)qr[d0][3]) * rn * g0[3]);
                          w.z = pk2(bf2f((unsigned short)qr[d0][4]) * rn * g1[0], bf2f((unsigned short)qr[d0][5]) * rn * g1[1]); w.w = pk2(bf2f((unsigned short)qr[d0][6]) * rn * g1[2], bf2f((unsigned short)qr[d0][7]) * rn * g1[3]);
                          qr[d0] = *reinterpret_cast<bf16x8*>(&w); } }
                    att::attn_run<1>(cur, qr, 256, W, (char*)lds, tid);
                }
            }
#endif
        }
        bool again = false;
#ifdef PROBE_TYPE
        if (type == PROBE_TYPE && !probe_done) { probe_done = true; again = true; } else probe_done = false;
#endif
        if (again || ph + 1 < args.hi) { if (ph == 0 && !again) grid.sync(); else xcd_barrier(xbar, tid); }
#ifdef PROBE_SYNC
        if (again || ph + 1 < args.hi) xcd_barrier(xbar, tid);
#endif
        if (again) --ph;
    }
}

extern "C" void kernel_launch(void* const* d_in, const int* in_sizes, int n_in, void* d_out, int out_size, void* d_ws, size_t ws_size, hipStream_t stream) {
    static int grid = 0;
    constexpr int NPHASE = 36;
    if (grid == 0) {
        if (n_in != 25 || in_sizes[0] != T * DM || out_size != T * DM || ws_size < WS_END) { fprintf(stderr, "kernel_launch: unexpected shapes (n_in %d, in0 %d, out %d, ws %zu, need %zu)\n", n_in, n_in > 0 ? in_sizes[0] : -1, out_size, ws_size, (size_t)WS_END); grid = -1; return; }
        int dev = 0, cus = 0, per_cu = 0;
        if (hipGetDevice(&dev) != hipSuccess || hipDeviceGetAttribute(&cus, hipDeviceAttributeMultiprocessorCount, dev) != hipSuccess) { grid = -1; return; }
        if (hipFuncSetAttribute((const void*)yoco_fwd, hipFuncAttributeMaxDynamicSharedMemorySize, LDS_BYTES) != hipSuccess) { fprintf(stderr, "kernel_launch: hipFuncSetAttribute failed\n"); grid = -1; return; }
        if (hipOccupancyMaxActiveBlocksPerMultiprocessor(&per_cu, (const void*)yoco_fwd, NWAVES * 64, LDS_BYTES) != hipSuccess || per_cu < 1) { fprintf(stderr, "kernel_launch: occupancy query says %d\n", per_cu); per_cu = 1; }
        (void)hipGetLastError();
        grid = cus;
    }
    if (grid < 0) return;
    Args a{};
    for (int i = 0; i < 25; ++i) a.in[i] = d_in[i];
    a.out = (float*)d_out; a.ws = (unsigned char*)d_ws;
#if MK_N_LAUNCHES == 1
    if (hipMemsetAsync((char*)d_ws + WS_CTL, 0, CTL_BYTES, stream) != hipSuccess) { fprintf(stderr, "kernel_launch: memset of the barrier words failed\n"); return; }
    a.lo = 0; a.hi = NPHASE;
    void* kargs[] = {&a};
    hipError_t e = hipLaunchCooperativeKernel((const void*)yoco_fwd, dim3(grid), dim3(NWAVES * 64), kargs, LDS_BYTES, stream);
    if (e != hipSuccess) fprintf(stderr, "kernel_launch: cooperative launch failed: %s (grid %d)\n", hipGetErrorString(e), grid);
#else
    for (int p = 0; p < NPHASE; ++p) { a.lo = p; a.hi = p + 1; hipLaunchKernelGGL(yoco_fwd, dim3(grid), dim3(NWAVES * 64), LDS_BYTES, stream, a); }
#endif
}
```

```cpp
#include <hip/hip_runtime.h>
#include <hip/hip_cooperative_groups.h>
#include <cstdio>
#include <cstdint>
namespace cg = cooperative_groups;
namespace pg8 {
#define PG8_LAS __attribute__((address_space(3)))
typedef unsigned short bf16_t;
typedef short bf16x8 __attribute__((ext_vector_type(8)));
typedef float f32x4 __attribute__((ext_vector_type(4)));
typedef unsigned u32x4 __attribute__((ext_vector_type(4)));
constexpr int BM = 256, BK = 64, HALF = 128, HTB = HALF * BK * 2  , STAGE_BYTES = 8 * HTB, NXCD = 8, WGM = 8;

__host__ __device__ __forceinline__ int lds_byte(int r, int c) { const int st = (r >> 4) * 2 + (c >> 5), rr = r & 15, cc = c & 31, ob = rr * 64 + cc * 2; return st * 1024 + (ob ^ (((ob >> 9) & 1) << 5)); }
__host__ __device__ __forceinline__ void stage_rc(int b, int& R, int& C) { const int st = b / 1024, sb = b % 1024, swz = sb ^ (((sb >> 9) & 1) << 5); R = (st >> 1) * 16 + swz / 64; C = (st & 1) * 32 + (swz % 64) / 2; }
__host__ __device__ __forceinline__ int perm32(int rho) { const int n = rho >> 4, i = rho & 15; return 8 * (i >> 2) + 4 * n + (i & 3); }

struct Unit { int pm, pn; };
struct Gemm { const bf16_t* A; const bf16_t* Bt; int M, N, K, lda; };

struct StaticOrder {
    int nM, nN, nwg, G, c;
    __host__ __device__ void init(int M, int N, int G_, int c_) { nM = M / BM; nN = N / BM; nwg = nM * nN; G = G_; c = c_; }
    __host__ __device__ bool next(int i, Unit& u) const {
        const long L = (long)i * G + c; if (L >= nwg) return false;
        int wgid = (int)L; { const int q = nwg / NXCD, r = nwg % NXCD, xcd = wgid % NXCD, off = wgid / NXCD; wgid = (xcd < r ? xcd * (q + 1) : r * (q + 1) + (xcd - r) * q) + off; }
        const int nig = WGM * nN, gid = wgid / nig, fm = gid * WGM, gsz = (nM - fm) < WGM ? (nM - fm) : WGM;
        u.pm = fm + ((wgid % nig) % gsz); u.pn = (wgid % nig) / gsz; return true;
    }
    __device__ __forceinline__ void a_ready(const Unit&) const {}
    __device__ __forceinline__ void done(const Unit&) const {}
};

__device__ __forceinline__ unsigned cvt_pk_bf16(float lo, float hi) { unsigned r; asm volatile("v_cvt_pk_bf16_f32 %0, %1, %2" : "=v"(r) : "v"(lo), "v"(hi)); return r; }
typedef float f32x2 __attribute__((ext_vector_type(2)));
template <int XM> __device__ __forceinline__ float swz_xor(float v) { return __builtin_bit_cast(float, __builtin_amdgcn_ds_swizzle(__builtin_bit_cast(int, v), (XM << 10) | 0x1f)); }
__device__ __forceinline__ float add_xor32(float v) {
    auto r = __builtin_amdgcn_permlane32_swap(__float_as_uint(v), __float_as_uint(v), false, false); const unsigned r0 = r[0], r1 = r[1]; return __uint_as_float(r0) + __uint_as_float(r1); }
__device__ __forceinline__ float add_xor16_32(float s) { s += swz_xor<16>(s); return add_xor32(s); }
__device__ __forceinline__ float row_rs(const float* ssq, int stride, int nslots, float inv_n, int row, int fq) {
    const f32x4* p = (const f32x4*)(ssq + (size_t)row * stride); float s = 0.f;
    for (int i = 4 * fq; i < nslots; i += 16) { const f32x4 v = p[i >> 2]; s += (v[0] + v[1]) + (v[2] + v[3]); }
    s = add_xor16_32(s);
    return __builtin_amdgcn_rsqf(s * inv_n + 1e-6f);
}
__device__ __forceinline__ float sig_mul(float g, float u) {
    const float e = __builtin_amdgcn_exp2f(-1.4426950408889634f * g); return g * __builtin_amdgcn_rcpf(1.0f + e) * u;
}
struct EpiSwiglu {
    static constexpr bool PERM = true, AFTER_DRAIN = false;
    bf16_t* O; int ldc; const float* ssq; PG8_LAS unsigned char* lds;
    __device__ __forceinline__ void operator()(const f32x4 (&acc)[2][2][4][2], const Unit& u, int wr, int wc, int fr, int fq) const {
        const int row0 = u.pm * BM + wr * 64 + fr, col0 = u.pn * HALF + wc * 32 + 8 * fq;
        const int wid = wr * 4 + wc;
        PG8_LAS float* rc = (PG8_LAS float*)(lds + 131072) + wid * 128 + fr;
        PG8_LAS int* tg = (PG8_LAS int*)(lds + 131072 + 4096) + wid;
        const bool hit = __builtin_amdgcn_readfirstlane(*tg) == u.pm;
        float rs[2][4];
        if (hit) {
#pragma unroll
            for (int ai = 0; ai < 2; ++ai)
#pragma unroll
                for (int m = 0; m < 4; ++m) rs[ai][m] = rc[ai * 64 + m * 16];
        } else {
#pragma unroll
            for (int ai = 0; ai < 2; ++ai)
#pragma unroll
                for (int m = 0; m < 4; ++m) rs[ai][m] = row_rs(ssq, 16, 16, 1.0f / 1024.0f, row0 + ai * HALF + m * 16, fq);
            if (fq == 0) {
#pragma unroll
                for (int ai = 0; ai < 2; ++ai)
#pragma unroll
                    for (int m = 0; m < 4; ++m) rc[ai * 64 + m * 16] = rs[ai][m];
                if (fr == 0) *tg = u.pm; }
        }
#pragma unroll
        for (int ai = 0; ai < 2; ++ai)
#pragma unroll
            for (int m = 0; m < 4; ++m) { const int row = row0 + ai * HALF + m * 16; const float r_ = rs[ai][m];
                const f32x4 g0 = acc[ai][0][m][0] * r_, g1 = acc[ai][0][m][1] * r_, u0 = acc[ai][1][m][0] * r_, u1 = acc[ai][1][m][1] * r_;
                u32x4 w; w.x = cvt_pk_bf16(sig_mul(g0[0], u0[0]), sig_mul(g0[1], u0[1])); w.y = cvt_pk_bf16(sig_mul(g0[2], u0[2]), sig_mul(g0[3], u0[3]));
                w.z = cvt_pk_bf16(sig_mul(g1[0], u1[0]), sig_mul(g1[1], u1[1])); w.w = cvt_pk_bf16(sig_mul(g1[2], u1[2]), sig_mul(g1[3], u1[3]));
                *(u32x4*)(O + (size_t)row * ldc + col0) = w; }
    }
};
typedef _Float16 h16x8 __attribute__((ext_vector_type(8)));
template <bool F16> __device__ __forceinline__ f32x4 mma16(bf16x8 a, bf16x8 b, f32x4 c) {
    if constexpr (F16) return __builtin_amdgcn_mfma_f32_16x16x32_f16(__builtin_bit_cast(h16x8, a), __builtin_bit_cast(h16x8, b), c, 0, 0, 0);
    else return __builtin_amdgcn_mfma_f32_16x16x32_bf16(a, b, c, 0, 0, 0);
}
__device__ __forceinline__ float bf_lo(unsigned w) { return __builtin_bit_cast(float, w << 16); }
__device__ __forceinline__ float bf_hi(unsigned w) { return __builtin_bit_cast(float, w & 0xffff0000u); }
struct EpiResid {
    static constexpr bool PERM = true, AFTER_DRAIN = false;
    float* fout; _Float16* XH; float* ssq; float alpha;
    __device__ __forceinline__ void operator()(const f32x4 (&acc)[2][2][4][2], const Unit& u, int wr, int wc, int fr, int fq) const {
        const int row0 = u.pm * BM + wr * 64 + fr, col0 = u.pn * BM + wc * 32 + 8 * fq;
#pragma unroll
        for (int ai = 0; ai < 2; ++ai) {
            h16x8 pre[4][2];
#pragma unroll
            for (int m = 0; m < 4; ++m)
#pragma unroll
                for (int bj = 0; bj < 2; ++bj) pre[m][bj] = *(const h16x8*)(XH + (size_t)(row0 + ai * HALF + m * 16) * 1024 + col0 + bj * HALF);
#pragma unroll
            for (int m = 0; m < 4; ++m) { const int row = row0 + ai * HALF + m * 16; _Float16* bp = XH + (size_t)row * 1024 + col0; float s = 0.f;
#pragma unroll
                for (int bj = 0; bj < 2; ++bj) { const h16x8 o = pre[m][bj];
                    const f32x4 o0 = {(float)o[0], (float)o[1], (float)o[2], (float)o[3]}, o1 = {(float)o[4], (float)o[5], (float)o[6], (float)o[7]};
                    const f32x4 v0 = o0 + acc[ai][bj][m][0] * alpha, v1 = o1 + acc[ai][bj][m][1] * alpha;
                    if (fout) { float* xp = fout + (size_t)row * 1024 + col0 + bj * HALF; *(f32x4*)xp = v0; *(f32x4*)(xp + 4) = v1; }
                    const h16x8 w = {(_Float16)v0[0], (_Float16)v0[1], (_Float16)v0[2], (_Float16)v0[3], (_Float16)v1[0], (_Float16)v1[1], (_Float16)v1[2], (_Float16)v1[3]};
                    *(h16x8*)(bp + bj * HALF) = w;
                    s += (v0[0] * v0[0] + v0[1] * v0[1]) + (v0[2] * v0[2] + v0[3] * v0[3]) + (v1[0] * v1[0] + v1[1] * v1[1]) + (v1[2] * v1[2] + v1[3] * v1[3]); }
                s = add_xor16_32(s);
                if (fq == 0) ssq[(size_t)row * 16 + u.pn * 4 + wc] = s; }
            asm volatile("" ::: "memory"); }
    }
};
struct EpiGen {
    static constexpr bool PERM = true, AFTER_DRAIN = false;
    bf16_t* O; int ldc; const float* ssq; int ssq_stride, ssq_n; float ssq_inv; int npair, col_shift; float* osq; int osq_stride;
    __device__ __forceinline__ void operator()(const f32x4 (&acc)[2][2][4][2], const Unit& u, int wr, int wc, int fr, int fq) const {
        const int row0 = u.pm * BM + wr * 64 + fr; const bool pair = u.pn < npair;
        const int col0 = (pair ? u.pn * HALF : u.pn * BM - col_shift) + wc * 32 + 8 * fq;
        float rsv[2][4];
#pragma unroll
        for (int ai = 0; ai < 2; ++ai)
#pragma unroll
            for (int m = 0; m < 4; ++m) rsv[ai][m] = ssq ? row_rs(ssq, ssq_stride, ssq_n, ssq_inv, row0 + ai * HALF + m * 16, fq) : 1.0f;
#pragma unroll
        for (int ai = 0; ai < 2; ++ai)
#pragma unroll
            for (int m = 0; m < 4; ++m) { const int row = row0 + ai * HALF + m * 16; const float rs = rsv[ai][m];
                bf16_t* rowp = O + (size_t)row * ldc + col0;
                if (pair) { const f32x4 v0 = (acc[ai][0][m][0] * rs) * (acc[ai][1][m][0] * rs), v1 = (acc[ai][0][m][1] * rs) * (acc[ai][1][m][1] * rs);
                    u32x4 w; w.x = cvt_pk_bf16(v0[0], v0[1]); w.y = cvt_pk_bf16(v0[2], v0[3]); w.z = cvt_pk_bf16(v1[0], v1[1]); w.w = cvt_pk_bf16(v1[2], v1[3]);
                    *(u32x4*)rowp = w; }
                else {
#pragma unroll
                    for (int bj = 0; bj < 2; ++bj) { const f32x4 v0 = acc[ai][bj][m][0] * rs, v1 = acc[ai][bj][m][1] * rs;
                        u32x4 w; w.x = cvt_pk_bf16(v0[0], v0[1]); w.y = cvt_pk_bf16(v0[2], v0[3]); w.z = cvt_pk_bf16(v1[0], v1[1]); w.w = cvt_pk_bf16(v1[2], v1[3]);
                        *(u32x4*)(rowp + bj * HALF) = w;
                        if (osq) { float s = (v0[0] * v0[0] + v0[1] * v0[1]) + (v0[2] * v0[2] + v0[3] * v0[3]) + (v1[0] * v1[0] + v1[1] * v1[1]) + (v1[2] * v1[2] + v1[3] * v1[3]);
                            s = add_xor16_32(s);
                            if (fq == 0) osq[(size_t)row * osq_stride + u.pn * 8 + bj * 4 + wc] = s; } } } }
    }
};
template <class Epi, class Sched, bool ALIGN_EPI = false, bool SP2 = false, bool F16 = false>
__device__ __forceinline__ void gemm_phase(PG8_LAS unsigned char* lds, const Gemm g, const Sched& S, const Epi& E, const int tid) {
    const int wid = __builtin_amdgcn_readfirstlane(tid >> 6), lane = tid & 63, wr = wid >> 2, wc = wid & 3, fr = lane & 15, fq = lane >> 4;
    const int K = g.K, nt = K / BK;
    unsigned voffA[2], voffB[2];
#pragma unroll
    for (int i = 0; i < 2; ++i) { int R, C; stage_rc(tid * 16 + i * 8192, R, C); const int Rb = Epi::PERM ? ((R & ~31) + perm32(R & 31)) : R;
        voffA[i] = (unsigned)(R * g.lda + C) * 2u; voffB[i] = (unsigned)(Rb * K + C) * 2u; }
    const size_t kstep = (size_t)(BK * 2);
    const size_t hstep = (size_t)HALF * K * 2;
    const size_t tstep = 2 * hstep; const size_t hstepA = (size_t)HALF * g.lda * 2, tstepA = 2 * hstepA;
    const unsigned ldsw = (unsigned)wid * 1024u;
    const int aoff = lds_byte(wr * 64 + fr, fq * 8), boff = lds_byte(wc * 32 + fr, fq * 8);
#define PG8_SA(b, h) (((b) * 2 + (h)) * HTB)
#define PG8_SB(b, h) ((4 + (b) * 2 + (h)) * HTB)
#define PG8_STAGE(bufoff, gbase, voff) do { _Pragma("unroll") for (int _i = 0; _i < 2; ++_i) \
        __builtin_amdgcn_global_load_lds((const unsigned*)((const char*)(gbase) + (voff)[_i]), (PG8_LAS unsigned*)(lds + (bufoff) + ldsw + _i * 8192), 16, 0, 0); } while (0)
#define PG8_LDA(dst, b, h) do { _Pragma("unroll") for (int m = 0; m < 4; ++m) _Pragma("unroll") for (int k = 0; k < 2; ++k) dst[m][k] = *(const PG8_LAS bf16x8*)(lds + PG8_SA(b, h) + aoff + m * 2048 + k * 1024); } while (0)
#define PG8_LDB(dst, b, h) do { _Pragma("unroll") for (int n = 0; n < 2; ++n) _Pragma("unroll") for (int k = 0; k < 2; ++k) dst[n][k] = *(const PG8_LAS bf16x8*)(lds + PG8_SB(b, h) + boff + n * 2048 + k * 1024); } while (0)
#define PG8_MMA(ai, bj, At, Bt) do { __builtin_amdgcn_s_setprio(1); _Pragma("unroll") for (int m = 0; m < 4; ++m) _Pragma("unroll") for (int n = 0; n < 2; ++n) _Pragma("unroll") for (int k = 0; k < 2; ++k) \
        acc[ai][bj][m][n] = mma16<F16>(Bt[n][k], At[m][k], acc[ai][bj][m][n]); __builtin_amdgcn_s_setprio(0); } while (0)
#define PG8_WAIT_V(n) asm volatile("s_waitcnt vmcnt(" #n ")" ::: "memory")
#define PG8_WAIT_L(n) asm volatile("s_waitcnt lgkmcnt(" #n ")" ::: "memory")
#define PG8_BAR __builtin_amdgcn_s_barrier()
#define PG8_SCHED __builtin_amdgcn_sched_barrier(0)
    Unit cur, nxt; int ui = 0;
    if (!S.next(0, cur)) return;
    f32x4 acc[2][2][4][2];
#pragma unroll
    for (int a = 0; a < 2; ++a)
#pragma unroll
        for (int b = 0; b < 2; ++b)
#pragma unroll
            for (int m = 0; m < 4; ++m)
#pragma unroll
                for (int n = 0; n < 2; ++n) acc[a][b][m][n] = (f32x4){0.f, 0.f, 0.f, 0.f};
    bf16x8 At[4][2], B0[2][2], B1[2][2];
    const char* cA = (const char*)g.A + (size_t)cur.pm * tstepA; const char* cB = (const char*)g.Bt + (size_t)cur.pn * tstep;
    S.a_ready(cur);
    if constexpr (SP2) {
        PG8_STAGE(PG8_SB(0, 0), cB, voffB); PG8_STAGE(PG8_SB(0, 1), cB + hstep, voffB); PG8_STAGE(PG8_SA(0, 0), cA, voffA); PG8_STAGE(PG8_SA(0, 1), cA + hstepA, voffA);
        if (wr == 1) PG8_BAR;
        PG8_WAIT_V(2); PG8_BAR;
        PG8_STAGE(PG8_SB(1, 0), cB + kstep, voffB); PG8_STAGE(PG8_SA(1, 0), cA + kstep, voffA); PG8_STAGE(PG8_SB(1, 1), cB + hstep + kstep, voffB);
        PG8_WAIT_V(6); PG8_BAR;
    } else {
        PG8_STAGE(PG8_SB(0, 0), cB, voffB); PG8_STAGE(PG8_SA(0, 0), cA, voffA); PG8_STAGE(PG8_SB(0, 1), cB + hstep, voffB); PG8_STAGE(PG8_SA(0, 1), cA + hstepA, voffA);
        if (wr == 1) PG8_BAR;
        PG8_WAIT_V(4); PG8_BAR;
        PG8_STAGE(PG8_SB(1, 0), cB + kstep, voffB); PG8_STAGE(PG8_SA(1, 0), cA + kstep, voffA); PG8_STAGE(PG8_SB(1, 1), cB + hstep + kstep, voffB);
        PG8_WAIT_V(6); PG8_BAR;
    }
    for (;;) {
        const bool has_next = S.next(ui + 1, nxt);
        const char* nA = has_next ? (const char*)g.A + (size_t)nxt.pm * tstepA : cA; const char* nB = has_next ? (const char*)g.Bt + (size_t)nxt.pn * tstep : cB;
        for (int t = 0; t < nt; t += 2) {
            const bool last = (t == nt - 2);
            const char* a1 = cA + (size_t)(t + 1) * kstep;
            const char* a2 = last ? nA : cA + (size_t)(t + 2) * kstep; const char* b2 = last ? nB : cB + (size_t)(t + 2) * kstep;
            const char* a3 = a2 + kstep; const char* b3 = b2 + kstep;
            if (last && has_next) S.a_ready(nxt);
            if constexpr (SP2) {
            PG8_LDB(B0, 0, 0); PG8_LDB(B1, 0, 1); PG8_SCHED; PG8_LDA(At, 0, 0); PG8_STAGE(PG8_SA(1, 1), a1 + hstepA, voffA);
            PG8_WAIT_V(8); PG8_WAIT_L(0); PG8_BAR; PG8_MMA(0, 0, At, B0); PG8_MMA(0, 1, At, B1); PG8_BAR; PG8_SCHED;
            PG8_LDA(At, 0, 1); PG8_STAGE(PG8_SB(0, 0), b2, voffB); PG8_STAGE(PG8_SB(0, 1), b2 + hstep, voffB); PG8_STAGE(PG8_SA(0, 0), a2, voffA);
            PG8_WAIT_V(8); PG8_WAIT_L(0); PG8_BAR; PG8_MMA(1, 0, At, B0); PG8_MMA(1, 1, At, B1); PG8_BAR; PG8_SCHED;
            PG8_LDB(B0, 1, 0); PG8_LDB(B1, 1, 1); PG8_SCHED; PG8_LDA(At, 1, 0); PG8_STAGE(PG8_SA(0, 1), a2 + hstepA, voffA);
            PG8_WAIT_V(8); PG8_WAIT_L(0); PG8_BAR; PG8_MMA(0, 0, At, B0); PG8_MMA(0, 1, At, B1); PG8_BAR; PG8_SCHED;
            PG8_LDA(At, 1, 1); PG8_STAGE(PG8_SB(1, 0), b3, voffB); PG8_STAGE(PG8_SB(1, 1), b3 + hstep, voffB); PG8_STAGE(PG8_SA(1, 0), a3, voffA);
            PG8_WAIT_V(8); PG8_WAIT_L(0); PG8_BAR; PG8_MMA(1, 0, At, B0); PG8_MMA(1, 1, At, B1); PG8_BAR; PG8_SCHED;
            } else {
            PG8_LDB(B0, 0, 0); PG8_SCHED; PG8_LDA(At, 0, 0); PG8_STAGE(PG8_SA(1, 1), a1 + hstepA, voffA);
            PG8_WAIT_L(8); PG8_BAR; PG8_WAIT_L(0); PG8_MMA(0, 0, At, B0); PG8_BAR; PG8_SCHED;
            PG8_LDB(B1, 0, 1); PG8_STAGE(PG8_SB(0, 0), b2, voffB);
            PG8_BAR; PG8_WAIT_L(0); PG8_MMA(0, 1, At, B1); PG8_BAR;
            PG8_LDA(At, 0, 1); PG8_STAGE(PG8_SA(0, 0), a2, voffA);
            PG8_BAR; PG8_WAIT_L(0); PG8_MMA(1, 0, At, B0); PG8_BAR; PG8_SCHED;
            PG8_STAGE(PG8_SB(0, 1), b2 + hstep, voffB);
            PG8_WAIT_V(6); PG8_BAR; PG8_MMA(1, 1, At, B1); PG8_BAR;
            PG8_LDB(B0, 1, 0); PG8_SCHED; PG8_LDA(At, 1, 0); PG8_STAGE(PG8_SA(0, 1), a2 + hstepA, voffA);
            PG8_WAIT_L(8); PG8_BAR; PG8_WAIT_L(0); PG8_MMA(0, 0, At, B0); PG8_BAR; PG8_SCHED;
            PG8_LDB(B1, 1, 1); PG8_STAGE(PG8_SB(1, 0), b3, voffB);
            PG8_BAR; PG8_WAIT_L(0); PG8_MMA(0, 1, At, B1); PG8_BAR;
            PG8_LDA(At, 1, 1); PG8_STAGE(PG8_SA(1, 0), a3, voffA);
            PG8_BAR; PG8_WAIT_L(0); PG8_MMA(1, 0, At, B0); PG8_BAR; PG8_SCHED;
            PG8_STAGE(PG8_SB(1, 1), b3 + hstep, voffB);
            PG8_WAIT_V(6); PG8_BAR; PG8_MMA(1, 1, At, B1); PG8_BAR;
            }
        }
        if constexpr (ALIGN_EPI) { if (wr == 0) PG8_BAR; }
        if constexpr (!Epi::AFTER_DRAIN) { E(acc, cur, wr, wc, fr, fq); S.done(cur); }
        if (!has_next) break;
#pragma unroll
        for (int a = 0; a < 2; ++a)
#pragma unroll
            for (int b = 0; b < 2; ++b)
#pragma unroll
                for (int m = 0; m < 4; ++m)
#pragma unroll
                    for (int n = 0; n < 2; ++n) acc[a][b][m][n] = (f32x4){0.f, 0.f, 0.f, 0.f};
        cur = nxt; cA = nA; cB = nB; ++ui;
        if constexpr (ALIGN_EPI) { if (wr == 1) PG8_BAR; }
    }
    PG8_WAIT_V(0);
    if constexpr (!ALIGN_EPI) { if (wr == 0) PG8_BAR; }
    PG8_BAR;
    if constexpr (Epi::AFTER_DRAIN) { E.fused(acc, cur, wr, wc, fr, fq, lds, wid, lane); S.done(cur); }
#undef PG8_SA
#undef PG8_SB
#undef PG8_STAGE
#undef PG8_LDA
#undef PG8_LDB
#undef PG8_MMA
#undef PG8_WAIT_V
#undef PG8_WAIT_L
#undef PG8_BAR
#undef PG8_SCHED
}
}
namespace att {
typedef unsigned short bf16_t;
typedef short bf16x8 __attribute__((ext_vector_type(8)));
typedef short s16x4 __attribute__((ext_vector_type(4)));
typedef float f32x16 __attribute__((ext_vector_type(16)));
typedef float f32x4 __attribute__((ext_vector_type(4)));
typedef unsigned u32x4 __attribute__((ext_vector_type(4)));
constexpr int NW = 8, QBLK = 32, KVBLK = 64, QB = NW * QBLK;
constexpr int SHM_V = KVBLK * 128 * 2, SHM_K = KVBLK * 128 * 2, SHM_KR = KVBLK * 64 * 2;
constexpr int NVB = 3;
constexpr int ATT_WS_OFF = NVB * SHM_V + 2 * SHM_K + 2 * SHM_KR;
constexpr int ATT_LDS_BYTES = ATT_WS_OFF + NW * 64 * 4;
constexpr float THR = 8.f;
template <int MODE> struct Cfg;
template <> struct Cfg<0> { static constexpr int NQF = 12, NQT = 8, NQK = 8, NPV = 4, KS = 1536, VS = 1536, OS = 1024; static constexpr bool ROPE = true; };
template <> struct Cfg<1> { static constexpr int NQF = 4, NQT = 4, NQK = 4, NPV = 2, KS = 128, VS = 128, OS = 1024; static constexpr bool ROPE = false; };

#define KSWZ(row, colB) ((row) * 256 + ((colB) ^ (((row) & 7) << 4)))
#define KRSWZ(row, colB) ((row) * 128 + ((colB) ^ ((((row) >> 1) & 7) << 4)))
#define SBAR() __builtin_amdgcn_sched_barrier(0)
__device__ __forceinline__ int v_st(int k, int c) { const int kk = (k & ~0xC) | ((k & 4) << 1) | ((k & 8) >> 1); return ((kk >> 3) * 4 + (c >> 5)) * 512 + ((kk & 7) * 32 + (c & 31)) * 2; }
__device__ __forceinline__ int v_rd_base(int lane) { return ((lane & 3) << 3) | (((lane >> 2) & 3) << 6) | (((lane >> 4) & 1) << 5) | (((lane >> 5) & 1) << 8); }
constexpr int v_rd_off(int d0, int ks, int half) { return d0 * 512 + ks * 4096 + half * 2048; }
__device__ __forceinline__ int crow(int r, int hi) { return (r & 3) + 8 * (r >> 2) + 4 * hi; }
__device__ __forceinline__ unsigned cvtpk(float lo, float hi) {
    unsigned r; asm volatile("v_cvt_pk_bf16_f32 %0, %1, %2" : "=v"(r) : "v"(lo), "v"(hi)); return r;
}
__device__ __forceinline__ bf16x8 load8(const bf16_t* p) { return *reinterpret_cast<const bf16x8*>(p); }
__device__ __forceinline__ void mask_tile(f32x16& p0, f32x16& p1, int dq, unsigned W) {
    const float NEG = -__builtin_inff();
#pragma unroll
    for (int r = 0; r < 16; ++r) {
        const int c = (r & 3) + 8 * (r >> 2);
        if ((unsigned)(dq - c) >= W) p0[r] = NEG;
        if ((unsigned)(dq - c - 32) >= W) p1[r] = NEG;
    }
}
__device__ __forceinline__ void partialSM(f32x16& p0, f32x16& p1, float& m_reg, float& mn, float& alpha) {
    float pmax = p0[0]; for (int r = 1; r < 16; ++r) pmax = fmaxf(pmax, p0[r]); for (int r = 0; r < 16; ++r) pmax = fmaxf(pmax, p1[r]);
    { auto rr = __builtin_amdgcn_permlane32_swap(__float_as_uint(pmax), __float_as_uint(pmax), false, false);
      pmax = fmaxf(__uint_as_float(rr[0]), __uint_as_float(rr[1])); }
    constexpr float C2 = 1.4426950408889634f;
    if (__builtin_expect(__all((pmax - m_reg) <= THR), 1)) { mn = m_reg; alpha = 1.f; }
    else { mn = fmaxf(m_reg, pmax); alpha = __builtin_amdgcn_exp2f((m_reg - mn) * C2); m_reg = mn; }
    const float mnL = -mn * C2;
    for (int r = 0; r < 16; ++r) p0[r] = fmaf(p0[r], C2, mnL); for (int r = 0; r < 16; ++r) p1[r] = fmaf(p1[r], C2, mnL);
    for (int r = 0; r < 16; ++r) p0[r] = __builtin_amdgcn_exp2f(p0[r]);
}
__device__ __forceinline__ void finishSM(f32x16& p0, f32x16& p1, float alpha, float& l_reg, bf16x8& pa0, bf16x8& pa1, bf16x8& pa2, bf16x8& pa3) {
    for (int r = 0; r < 16; ++r) p1[r] = __builtin_amdgcn_exp2f(p1[r]);
    float ps = 0; for (int r = 0; r < 16; ++r) ps += p0[r]; for (int r = 0; r < 16; ++r) ps += p1[r];
    { auto rr = __builtin_amdgcn_permlane32_swap(__float_as_uint(ps), __float_as_uint(ps), false, false);
      ps = __uint_as_float(rr[0]) + __uint_as_float(rr[1]); }
    l_reg = l_reg * alpha + ps;
#define PK4(P, B_, OUT) do { unsigned a0 = cvtpk(P[B_+0], P[B_+1]), a1 = cvtpk(P[B_+2], P[B_+3]);                          \
        unsigned b0 = cvtpk(P[B_+4], P[B_+5]), b1 = cvtpk(P[B_+6], P[B_+7]);                                             \
        auto r0 = __builtin_amdgcn_permlane32_swap(a0, b0, false, false); auto r1 = __builtin_amdgcn_permlane32_swap(a1, b1, false, false); \
        u32x4 w = {r0[0], r1[0], r0[1], r1[1]}; OUT = *reinterpret_cast<bf16x8*>(&w); } while (0)
    PK4(p0, 0, pa0); PK4(p0, 8, pa1); PK4(p1, 0, pa2); PK4(p1, 8, pa3);
#undef PK4
}
template <int MODE, int KB>
__device__ __forceinline__ void qkt(f32x16& p0, f32x16& p1, const char* K_lds, const char* KR_lds, int r32, int hi, const bf16x8* qr) {
    typedef Cfg<MODE> C;
    p0 = f32x16{}; p1 = f32x16{};
    const char* kb[4];
#pragma unroll
    for (int dd = 0; dd < 4; ++dd) kb[dd] = K_lds + KB * SHM_K + KSWZ(r32, (dd * 16 + hi * 8) * 2);
#pragma unroll
    for (int d0 = 0; d0 < C::NQK; ++d0) { const char* a = kb[d0 & 3] + (d0 >> 2) * 128;
        bf16x8 b0 = *reinterpret_cast<const bf16x8*>(a);
        bf16x8 b1 = *reinterpret_cast<const bf16x8*>(a + 32 * 256);
        p0 = __builtin_amdgcn_mfma_f32_32x32x16_bf16(b0, qr[d0], p0, 0, 0, 0);
        p1 = __builtin_amdgcn_mfma_f32_32x32x16_bf16(b1, qr[d0], p1, 0, 0, 0); }
    if constexpr (C::ROPE) {
#pragma unroll
        for (int dd = 0; dd < 4; ++dd) { const char* a = KR_lds + KB * SHM_KR + KRSWZ(r32, (dd * 16 + hi * 8) * 2);
            bf16x8 b0 = *reinterpret_cast<const bf16x8*>(a);
            bf16x8 b1 = *reinterpret_cast<const bf16x8*>(a + 32 * 128);
            p0 = __builtin_amdgcn_mfma_f32_32x32x16_bf16(b0, qr[8 + dd], p0, 0, 0, 0);
            p1 = __builtin_amdgcn_mfma_f32_32x32x16_bf16(b1, qr[8 + dd], p1, 0, 0, 0); }
    }
}
template <int MODE, int VB>
__device__ __forceinline__ void pv_tile(f32x16* o, int vb0, bf16x8 pa0, bf16x8 pa1, bf16x8 pa2, bf16x8 pa3) {
#define TRRD(dst, off) asm volatile("ds_read_b64_tr_b16 %0, %1 offset:%2" : "=&v"(dst) : "v"(vb0), "i"(off) : "memory")
#define PV_D0(d0) do { s16x4 l0, l1, l2, l3, h0, h1, h2, h3; constexpr int b_ = VB * SHM_V + v_rd_off(d0, 0, 0);     \
        TRRD(l0, b_); TRRD(h0, b_ + 2048); TRRD(l1, b_ + 4096); TRRD(h1, b_ + 6144); TRRD(l2, b_ + 8192); TRRD(h2, b_ + 10240); TRRD(l3, b_ + 12288); TRRD(h3, b_ + 14336); \
        asm volatile("s_waitcnt lgkmcnt(0)" ::: "memory"); SBAR();             \
        o[d0] = __builtin_amdgcn_mfma_f32_32x32x16_bf16(pa0, (bf16x8){l0[0], l0[1], l0[2], l0[3], h0[0], h0[1], h0[2], h0[3]}, o[d0], 0, 0, 0);   \
        o[d0] = __builtin_amdgcn_mfma_f32_32x32x16_bf16(pa1, (bf16x8){l1[0], l1[1], l1[2], l1[3], h1[0], h1[1], h1[2], h1[3]}, o[d0], 0, 0, 0);   \
        o[d0] = __builtin_amdgcn_mfma_f32_32x32x16_bf16(pa2, (bf16x8){l2[0], l2[1], l2[2], l2[3], h2[0], h2[1], h2[2], h2[3]}, o[d0], 0, 0, 0);   \
        o[d0] = __builtin_amdgcn_mfma_f32_32x32x16_bf16(pa3, (bf16x8){l3[0], l3[1], l3[2], l3[3], h3[0], h3[1], h3[2], h3[3]}, o[d0], 0, 0, 0); } while (0)
    PV_D0(0); PV_D0(1);
    if constexpr (Cfg<MODE>::NPV == 4) { PV_D0(2); PV_D0(3); }
#undef PV_D0
#undef TRRD
}

struct BlockRef { const bf16_t* Q; const bf16_t* K; const bf16_t* V; const bf16_t* KR; bf16_t* O; int P0; int qs; int tok; int pad; };
__device__ __forceinline__ int swa_jlo(int P0, int W) { const int lowk = P0 - W + 1; return lowk > 0 ? lowk / KVBLK : 0; }
template <int MODE>
__device__ __forceinline__ void attn_run(const BlockRef& cur, const bf16x8* qr, int skv, int W, char* lds, const int tid) {
    typedef Cfg<MODE> C;
    const int wid = __builtin_amdgcn_readfirstlane(tid >> 6), lane = tid & 63, r32 = lane & 31, hi = lane >> 5;
    const bool grpB = wid >= 4;
    const int j_lo = swa_jlo(cur.P0, W);
    int j_hi = (cur.P0 + QB - 1) / KVBLK + 1; if (j_hi > skv / KVBLK) j_hi = skv / KVBLK;
    const int NT = j_hi - j_lo;
    const int qlo = cur.P0 + wid * QBLK, qm = qlo + r32 - 4 * hi;
    char* V_lds = lds; char* K_lds = lds + NVB * SHM_V; char* KR_lds = lds + NVB * SHM_V + 2 * SHM_K;
    float* ws = (float*)(lds + ATT_WS_OFF) + wid * 64; float* li_l = ws, * al_l = ws + 32;
    float m_reg = -1e30f, l_reg = 0; f32x16 o[4] = {};
    const int sr = tid >> 4, sc = (tid & 15) * 8, vst0 = v_st(sr, sc), vst1 = v_st(32 + sr, sc), kws = KSWZ(sr, sc * 2);
    const int krr = tid >> 3, krc = (tid & 7) * 8, krw = KRSWZ(krr, krc * 2);
    const int vb0 = (int)(uintptr_t)V_lds + v_rd_base(lane);
    const bf16_t* Kh = cur.K; const bf16_t* Vh = cur.V; const bf16_t* KRh = cur.KR;
    bf16x8 st_v0, st_v1, st_k0, st_k1, st_kr;
#define ROWK(p, k0, rr) ((p) + (size_t)((k0) + (rr)) * C::KS + sc)
#define ROWV(p, k0, rr) ((p) + (size_t)((k0) + (rr)) * C::VS + sc)
#define VMW() asm volatile("s_waitcnt vmcnt(0)" ::: "memory")
#define SLOAD_H(k0) do { st_v0 = load8(ROWV(Vh, k0, sr)); st_v1 = load8(ROWV(Vh, k0, 32 + sr)); st_k0 = load8(ROWK(Kh, k0, sr)); st_k1 = load8(ROWK(Kh, k0, 32 + sr)); \
                         if constexpr (C::ROPE) st_kr = load8(KRh + (size_t)((k0) + krr) * 64 + krc); } while (0)
#define SWRITE_H(kb, vb) do { *(bf16x8*)(V_lds + (vb) * SHM_V + vst0) = st_v0; *(bf16x8*)(V_lds + (vb) * SHM_V + vst1) = st_v1;                           \
                          *(bf16x8*)(K_lds + (kb) * SHM_K + kws) = st_k0; *(bf16x8*)(K_lds + (kb) * SHM_K + kws + 32 * 256) = st_k1;                 \
                          if constexpr (C::ROPE) *(bf16x8*)(KR_lds + (kb) * SHM_KR + krw) = st_kr; } while (0)
#define RESC(a) do { if (__any((a) < 1.f)) { if (hi == 0) al_l[r32] = (a); asm volatile("s_waitcnt lgkmcnt(0)" ::: "memory");              \
                     for (int d_ = 0; d_ < C::NPV; ++d_) for (int r = 0; r < 16; ++r) o[d_][r] *= al_l[crow(r, hi)]; } } while (0)
#define KBASE(t) ((j_lo + (t)) * KVBLK)
#define MASKT(P0_, P1_, t) do { const int kb_ = KBASE(t); if (kb_ + KVBLK - 1 > qlo || kb_ <= qlo + QBLK - 1 - W) mask_tile(P0_, P1_, qm - kb_, (unsigned)W); } while (0)
    f32x16 p0, p1; float mn, al; bf16x8 pa0 = {}, pa1 = {}, pa2 = {}, pa3 = {};
    SLOAD_H(KBASE(0)); VMW(); SWRITE_H(0, 0); SBAR();
    if (NT > 1) { SLOAD_H(KBASE(1)); SBAR(); }
    __syncthreads();
    int vcur = 0, vprev = 0;
    for (int t = 0; t < NT; ++t) {
        const int kb = t & 1; const int vnext = vcur == NVB - 1 ? 0 : vcur + 1;
        SBAR();
        if (grpB && t > 0) { pv_tile<MODE, 0>(o, vb0 + vprev * SHM_V, pa0, pa1, pa2, pa3); SBAR(); }
        qkt<MODE, 0>(p0, p1, K_lds + kb * SHM_K, KR_lds + kb * SHM_KR, r32, hi, qr); SBAR();
        MASKT(p0, p1, t); partialSM(p0, p1, m_reg, mn, al); RESC(al);
        finishSM(p0, p1, al, l_reg, pa0, pa1, pa2, pa3); SBAR();
        if (!grpB) { pv_tile<MODE, 0>(o, vb0 + vcur * SHM_V, pa0, pa1, pa2, pa3); SBAR(); }
        if (t + 1 < NT) { VMW(); SWRITE_H(kb ^ 1, vnext); SBAR(); if (t + 2 < NT) { SLOAD_H(KBASE(t + 2)); SBAR(); } }
        __syncthreads();
        vprev = vcur; vcur = vnext;
    }
    if (grpB) { SBAR(); pv_tile<MODE, 0>(o, vb0 + vprev * SHM_V, pa0, pa1, pa2, pa3); SBAR(); }
    if (hi == 0) li_l[r32] = l_reg; asm volatile("s_waitcnt lgkmcnt(0)" ::: "memory");
    float rli[16];
#pragma unroll
    for (int r = 0; r < 16; ++r) rli[r] = __builtin_amdgcn_rcpf(li_l[crow(r, hi)]);
    bf16_t* Ow = cur.O + (size_t)(wid * QBLK) * C::OS;
#pragma unroll
    for (int r = 0; r < 16; ++r) { const int orow = crow(r, hi);
#pragma unroll
        for (int d0 = 0; d0 < C::NPV; ++d0) { const float v = o[d0][r] * rli[r];
            const float vn = pg8::swz_xor<1>(v);
            if ((r32 & 1) == 0) *(unsigned*)(Ow + (size_t)orow * C::OS + d0 * 32 + r32) = cvtpk(v, vn); } }
    __syncthreads();
#undef RESC
#undef KBASE
#undef MASKT
#undef ROWK
#undef ROWV
#undef VMW
#undef SLOAD_H
#undef SWRITE_H
}
}
#ifndef MK_N_LAUNCHES
#define MK_N_LAUNCHES 1
#endif
#define LAS __attribute__((address_space(3)))
typedef unsigned short bf16;
typedef float f32x4 __attribute__((ext_vector_type(4)));
typedef unsigned v4u __attribute__((ext_vector_type(4)));
typedef unsigned v2u __attribute__((ext_vector_type(2)));
typedef short bf16x8 __attribute__((ext_vector_type(8)));
constexpr int NWAVES = 8;
constexpr int T = 65536, DM = 1024, FF = 2816, NBATCH = 8, SEQ = 8192;
constexpr float EPS = 1e-6f;
constexpr int N13 = 2 * FF;
constexpr int NCONV = 2560, NMLA = 768, NUQ = 1280, NKV1 = 512, NKV2 = 1536, NMEMKV = 2048, MEMROWS = 2048;
constexpr int PSTRIDE = 1792;
constexpr size_t MiB = 1u << 20;
constexpr size_t WS_W13 = 0;
constexpr size_t WS_W2 = WS_W13 + 88 * MiB;
constexpr size_t WS_WOUT = WS_W2 + 44 * MiB;
constexpr size_t WS_CONVIN = WS_WOUT + 8 * MiB;
constexpr size_t WS_MLAIN = WS_CONVIN + 10 * MiB;
constexpr size_t WS_WUQ = WS_MLAIN + 3 * MiB;
constexpr size_t WS_WKV1 = WS_WUQ + 2 * MiB;
constexpr size_t WS_WKV2 = WS_WKV1 + 1 * MiB;
constexpr size_t WS_WMEMKV = WS_WKV2 + 1 * MiB;
constexpr size_t WS_SSQ = WS_WMEMKV + 4 * MiB;
constexpr size_t WS_CSSQ = WS_SSQ + 4 * MiB;
constexpr size_t WS_MEMB = WS_CSSQ + 6 * MiB;
constexpr size_t WS_MEMSSQ = WS_MEMB + 4 * MiB;
constexpr size_t WS_MEMKVRAW = WS_MEMSSQ + 1 * MiB;
constexpr size_t WS_KMEM = WS_MEMKVRAW + 8 * MiB;
constexpr size_t WS_VMEM = WS_KMEM + 8 * MiB;
constexpr size_t WS_XB = WS_VMEM + 8 * MiB;
constexpr size_t WS_ACT = WS_XB + 128 * MiB;
constexpr size_t WS_MIX = WS_ACT + 352 * MiB;
constexpr size_t WS_KVB = WS_MIX + 128 * MiB;
constexpr size_t WS_KR = WS_KVB + 192 * MiB;
constexpr size_t WS_CTL = WS_KR + 8 * MiB;
constexpr size_t CTL_BYTES = 65536;
constexpr size_t WS_END = WS_CTL + 1 * MiB;
static_assert(WS_END <= 1024 * MiB, "d_ws map must fit 1 GiB");
constexpr size_t ACT_QRAW = 96 * MiB;
constexpr int MISC_OFF = 143360;
constexpr int LDS_BYTES = 147456;
static_assert(att::ATT_LDS_BYTES <= LDS_BYTES, "attention LDS");

__constant__ float INVF[32] = {1.000000000e+00f, 7.498942614e-01f, 5.623413324e-01f, 4.216965139e-01f, 3.162277639e-01f, 2.371373773e-01f, 1.778279394e-01f, 1.333521307e-01f, 1.000000015e-01f, 7.498941571e-02f, 5.623413250e-02f, 4.216965288e-02f, 3.162277490e-02f, 2.371373773e-02f, 1.778279431e-02f, 1.333521493e-02f, 9.999999776e-03f, 7.498941850e-03f, 5.623413250e-03f, 4.216964822e-03f, 3.162277630e-03f, 2.371373586e-03f, 1.778279431e-03f, 1.333521446e-03f, 1.000000047e-03f, 7.498942432e-04f, 5.623413017e-04f, 4.216965172e-04f, 3.162277571e-04f, 2.371373703e-04f, 1.778279402e-04f, 1.333521504e-04f};

#define LDS_WAIT() asm volatile("s_waitcnt lgkmcnt(0)" ::: "memory")
__device__ __forceinline__ unsigned f2bf(float f) { unsigned u = __builtin_bit_cast(unsigned, f); return (u + 0x7fffu + ((u >> 16) & 1u)) >> 16; }
__device__ __forceinline__ unsigned pk2(float lo, float hi) { return f2bf(lo) | (f2bf(hi) << 16); }
__device__ __forceinline__ float bf2f(unsigned short h) { return __builtin_bit_cast(float, (unsigned)h << 16); }
__device__ __forceinline__ float wave_sum(float v) {
    v += pg8::swz_xor<1>(v); v += pg8::swz_xor<2>(v); v += pg8::swz_xor<4>(v); v += pg8::swz_xor<8>(v); v += pg8::swz_xor<16>(v);
    return pg8::add_xor32(v);
}
__device__ __forceinline__ void rope_cs(int pos, int i, float& c, float& s) {
    const float ang = (float)pos * INVF[i];
    double t = (double)ang * 0.15915494309189535; t -= __builtin_rint(t);
    const float fr = (float)t; c = __builtin_amdgcn_cosf(fr); s = __builtin_amdgcn_sinf(fr);
}

struct Args { const void* in[25]; float* out; unsigned char* ws; int lo, hi; };

enum { MAP_PLAIN = 0, MAP_GATEUP = 1, MAP_CONVIN = 2 };
__device__ __forceinline__ int map_col(int mode, int n0, int Nsrc) {
    if (mode == MAP_GATEUP) { const int tile = n0 >> 8, q = n0 & 255; return (q < 128 ? 0 : FF) + tile * 128 + (q & 127); }
    if (mode == MAP_CONVIN) { const int tile = n0 >> 8, q = n0 & 255; if (tile < 6) return (q < 128 ? 768 : 1536) + tile * 128 + (q & 127); if (tile < 9) return (tile - 6) * 256 + q; return 2304 + q; }
    return n0 < Nsrc ? n0 : -1;
}
#ifndef WMANT
#define WMANT 7
#endif
__device__ __forceinline__ float rmant(float f) {
    unsigned u = __builtin_bit_cast(unsigned, f); u += 1u << (22 - WMANT); u &= ~((1u << (23 - WMANT)) - 1u); return __builtin_bit_cast(float, u);
}
__device__ __forceinline__ unsigned pk2h(float lo, float hi) { typedef _Float16 h2 __attribute__((ext_vector_type(2))); const h2 v = {(_Float16)lo, (_Float16)hi}; return __builtin_bit_cast(unsigned, v); }
__device__ __forceinline__ void prep_weight(const float* W, const float* g, int K, int Nsrc, bf16* WT, int Ndst, int mode, bool f16, LAS float* scr, int gw, int NGW, int lane) {
    const int nblk = Ndst / 64, nitems = (K / 64) * nblk; const int kr = lane >> 4, c4 = (lane & 15) * 4;
    for (int item = gw; item < nitems; item += NGW) {
        const int kb = item / nblk, nb = item % nblk, k0 = 64 * kb, n0 = 64 * nb; const int s0 = map_col(mode, n0, Nsrc);
        if (s0 >= 0) {
            f32x4 v[16];
#pragma unroll
            for (int i = 0; i < 16; ++i) v[i] = *(const f32x4*)(W + (size_t)(k0 + 4 * i + kr) * Nsrc + s0 + c4);
#pragma unroll
            for (int i = 0; i < 16; ++i) { const int kk = 4 * i + kr; const float gv = g ? g[k0 + kk] : 1.0f; LAS float* d = scr + kk * 65 + c4;
                d[0] = v[i].x * gv; d[1] = v[i].y * gv; d[2] = v[i].z * gv; d[3] = v[i].w * gv; }
        }
        LDS_WAIT(); asm volatile("" ::: "memory");
        const int c = lane & 7;
#pragma unroll
        for (int j = 0; j < 8; ++j) { const int n = (lane >> 3) + 8 * j; const LAS float* s = scr + (8 * c) * 65 + n;
            v4u o = {0u, 0u, 0u, 0u};
            if (s0 >= 0) { float e[8];
#pragma unroll
                for (int q = 0; q < 8; ++q) e[q] = rmant(s[q * 65]);
                if (f16) { o.x = pk2h(e[0], e[1]); o.y = pk2h(e[2], e[3]); o.z = pk2h(e[4], e[5]); o.w = pk2h(e[6], e[7]); }
                else { o.x = pk2(e[0], e[1]); o.y = pk2(e[2], e[3]); o.z = pk2(e[4], e[5]); o.w = pk2(e[6], e[7]); } }
            *(v4u*)(WT + (size_t)(n0 + n) * K + k0 + 8 * c) = o; }
        LDS_WAIT(); asm volatile("" ::: "memory");
    }
}
__device__ __forceinline__ void row_to_bf16(const float* xrow, bool f16, bf16* orow, float* ssq, int nslot, int lane) {
    const f32x4* xr = (const f32x4*)xrow + lane; f32x4 v[4]; float s = 0.f;
#pragma unroll
    for (int j = 0; j < 4; ++j) { v[j] = xr[64 * j]; s += (v[j].x * v[j].x + v[j].y * v[j].y) + (v[j].z * v[j].z + v[j].w * v[j].w); }
    s = wave_sum(s);
    v2u* o8 = (v2u*)orow + lane;
#pragma unroll
    for (int j = 0; j < 4; ++j) { v2u w; if (f16) { w.x = pk2h(v[j].x, v[j].y); w.y = pk2h(v[j].z, v[j].w); } else { w.x = pk2(v[j].x, v[j].y); w.y = pk2(v[j].z, v[j].w); } o8[64 * j] = w; }
    if (lane < nslot) ssq[lane] = lane == 0 ? s : 0.f;
}

__device__ __forceinline__ const void* argp(int i) {
    const char __attribute__((address_space(4)))* ka = (const char __attribute__((address_space(4)))*)__builtin_amdgcn_kernarg_segment_ptr();
    int off = i * 8; asm volatile("" : "+s"(off));
    return *(const void* const __attribute__((address_space(4)))*)(ka + off);
}
#define XB_TMO      128
#define XB_XCNT(j)  (256  + 64 * (j))
#define XB_XSUB(j)  (1280 + 64 * (j))
#define XB_XGEN(j)  (2304 + 64 * (j))
#define XB_TOP      3328
#define XB_TOPGEN   3392
#define XCD_BAR_WORDS 3456
#define XB_SPIN_CAP (1u << 18)
__device__ __forceinline__ unsigned xb_ld(unsigned* p)              { return __hip_atomic_load(p, __ATOMIC_RELAXED, __HIP_MEMORY_SCOPE_AGENT); }
__device__ __forceinline__ unsigned xb_add(unsigned* p, unsigned v) { return __hip_atomic_fetch_add(p, v, __ATOMIC_RELAXED, __HIP_MEMORY_SCOPE_AGENT); }
__device__ __forceinline__ unsigned xb_xcc_id() { return (unsigned)__builtin_amdgcn_s_getreg((3 << 11) | 20) & 0xFu; }
#define XB_SPIN(cond, bar) do { unsigned _sp = 0; while (cond) { __builtin_amdgcn_s_sleep(1); \
    if ((++_sp & 255u) == 0u) { if (xb_ld(&(bar)[XB_TMO])) break; if (_sp > XB_SPIN_CAP) { atomicAdd(&(bar)[XB_TMO], 1u); break; } } } } while (0)
struct XcdBarrier { unsigned* bar; unsigned x; volatile LAS unsigned* st; };
__device__ __forceinline__ XcdBarrier xcd_barrier_post(unsigned* bar, volatile LAS unsigned* st) {
    XcdBarrier b; b.bar = bar; b.x = xb_xcc_id(); b.st = st;
    if (threadIdx.x == 0) (void)xb_add(&bar[XB_XCNT(b.x)], 1u);
    return b;
}
__device__ __forceinline__ void xcd_barrier_complete(unsigned* bar, unsigned x, unsigned& nloc, unsigned& nx) {
    const unsigned G = gridDim.x * gridDim.y * gridDim.z;
    unsigned sum, cnt, mine, sp = 0u;
    for (;;) {
        sum = 0u; cnt = 0u; mine = 0u;
#pragma unroll
        for (unsigned j = 0; j < 16; ++j) { const unsigned c = xb_ld(&bar[XB_XCNT(j)]); sum += c; cnt += (c > 0u) ? 1u : 0u; mine = (j == x) ? c : mine; }
        if (sum == G) break;
        __builtin_amdgcn_s_sleep(1);
        if ((++sp & 255u) == 0u) { if (xb_ld(&bar[XB_TMO])) break; if (sp > XB_SPIN_CAP) { atomicAdd(&bar[XB_TMO], 1u); break; } }
    }
    nloc = mine > 0u ? mine : 1u; nx = cnt > 0u ? cnt : 1u;
}
__device__ __forceinline__ void xcd_barrier(const XcdBarrier& b, const int tid) {
    asm volatile("s_waitcnt vmcnt(0)" ::: "memory");
    __syncthreads();
    if (tid == 0) {
        unsigned* bar = b.bar;
        __builtin_amdgcn_s_waitcnt(0);
        unsigned nloc = b.st[0], nx = b.st[1];
        if (nloc == 0u) { xcd_barrier_complete(bar, b.x, nloc, nx); b.st[0] = nloc; b.st[1] = nx; }
        const unsigned old = xb_add(&bar[XB_XSUB(b.x)], 1u);
        const unsigned gen = old / nloc;
        if (old + 1u == (gen + 1u) * nloc) {
            __builtin_amdgcn_fence(__ATOMIC_RELEASE, "agent");
            asm volatile("s_waitcnt vmcnt(0)" ::: "memory");
            const unsigned og = xb_add(&bar[XB_TOP], 1u);
            const unsigned tg = og / nx;
            if (og + 1u == (tg + 1u) * nx) xb_add(&bar[XB_TOPGEN], 1u);
            else XB_SPIN(xb_ld(&bar[XB_TOPGEN]) == tg, bar);
            __builtin_amdgcn_fence(__ATOMIC_ACQUIRE, "agent");
            xb_add(&bar[XB_XGEN(b.x)], 1u);
            asm volatile("s_waitcnt vmcnt(0)" ::: "memory");
        } else {
            XB_SPIN(xb_ld(&bar[XB_XGEN(b.x)]) == gen, bar);
            __builtin_amdgcn_fence(__ATOMIC_ACQUIRE, "agent");
            asm volatile("s_waitcnt vmcnt(0)" ::: "memory");
        }
    }
    __syncthreads();
}
__global__ void __launch_bounds__(NWAVES * 64, 2) yoco_fwd(Args args) {
    extern __shared__ __attribute__((aligned(16))) unsigned char lds[];
    cg::grid_group grid = cg::this_grid();
    const int wave0 = __builtin_amdgcn_readfirstlane((int)threadIdx.x >> 6);
    const int G = gridDim.x, bx0 = blockIdx.x;
#define ARGP(i) argp(i)
#define x_in ((const float*)ARGP(0))
#define mem_in ((const float*)ARGP(1))
#define positions ((const int*)ARGP(2))
#define norm_g ((const float*)ARGP(3))
#define ffn_w13 ((const float*)ARGP(4))
#define ffn_w2 ((const float*)ARGP(5))
#define w_out ((const float*)ARGP(6))
#define mem_norm_g ((const float*)ARGP(7))
#define w_mem_kv ((const float*)ARGP(8))
#define g_mem_q ((const float*)ARGP(9))
#define g_mem_k ((const float*)ARGP(10))
#define conv_w_in ((const float*)ARGP(11))
#define conv_w ((const float*)ARGP(12))
#define mla_w_in ((const float*)ARGP(13))
#define g_q_lora ((const float*)ARGP(14))
#define w_uq ((const float*)ARGP(15))
#define g_q_nope ((const float*)ARGP(16))
#define g_q_rope ((const float*)ARGP(17))
#define kv_norm_g ((const float*)ARGP(18))
#define w_dkv ((const float*)ARGP(19))
#define g_ckv ((const float*)ARGP(20))
#define w_ukv ((const float*)ARGP(21))
#define w_kr ((const float*)ARGP(22))
#define g_k_nope ((const float*)ARGP(23))
#define g_k_rope ((const float*)ARGP(24))
#define X ((float*)ARGP(25))
#define WSB ((unsigned char*)ARGP(26))
#define W13T ((bf16*)(WSB + WS_W13))
#define W2T ((bf16*)(WSB + WS_W2))
#define WOUTT ((bf16*)(WSB + WS_WOUT))
#define CONVINT ((bf16*)(WSB + WS_CONVIN))
#define MLAINT ((bf16*)(WSB + WS_MLAIN))
#define WUQT ((bf16*)(WSB + WS_WUQ))
#define WKV1T ((bf16*)(WSB + WS_WKV1))
#define WKV2T ((bf16*)(WSB + WS_WKV2))
#define WMEMKVT ((bf16*)(WSB + WS_WMEMKV))
#define SSQ ((float*)(WSB + WS_SSQ))
#define CSSQ ((float*)(WSB + WS_CSSQ))
#define MEMB ((bf16*)(WSB + WS_MEMB))
#define MEMSSQ ((float*)(WSB + WS_MEMSSQ))
#define MEMKVRAW ((bf16*)(WSB + WS_MEMKVRAW))
#define KMEM ((bf16*)(WSB + WS_KMEM))
#define VMEM ((bf16*)(WSB + WS_VMEM))
#define XB ((bf16*)(WSB + WS_XB))
#define ACT ((bf16*)(WSB + WS_ACT))
#define MIX ((bf16*)(WSB + WS_MIX))
#define KVB ((bf16*)(WSB + WS_KVB))
#define KRB ((bf16*)(WSB + WS_KR))
#define PCONV ACT
#define CQRAW ACT
#define QRAW ((bf16*)(WSB + WS_ACT + ACT_QRAW))
#define CKVRAW ACT
    LAS unsigned char* ldsl = (LAS unsigned char*)lds;

    bool probe_done = false; (void)probe_done;
    volatile LAS unsigned* MISC = (volatile LAS unsigned*)(ldsl + MISC_OFF);
    if (threadIdx.x < 4) MISC[threadIdx.x] = 0u;
    __syncthreads();
    XcdBarrier xbar; xbar.bar = nullptr; xbar.x = 0; xbar.st = MISC;
    if (args.hi - args.lo > 1) xbar = xcd_barrier_post((unsigned*)(WSB + WS_CTL), MISC);
    for (int ph = args.lo; ph < args.hi; ++ph) {
        int wave = wave0, bx = bx0; asm volatile("" : "+s"(wave)); asm volatile("" : "+s"(bx));
        int lane = (int)__builtin_amdgcn_mbcnt_hi(~0u, __builtin_amdgcn_mbcnt_lo(~0u, 0u)); asm volatile("" : "+v"(lane)); const int tid = wave * 64 + lane; const int vcu = (G % 8 == 0) ? (bx % 8) * (G / 8) + bx / 8 : bx; const int gw = vcu * NWAVES + wave, NGW = G * NWAVES;
        int type, layer = 0, sub = 0;
        enum { PH_PREP, PH_MEMKV, PH_GLUE_MEM, PH_G1, PH_G2, PH_CONVIN, PH_CONVMIX, PH_WOUT, PH_KV1, PH_KV2, PH_GLUE_KV, PH_MLAIN, PH_UQ, PH_MLAATT };
        if (ph < 3) type = ph == 0 ? PH_PREP : (ph == 1 ? PH_MEMKV : PH_GLUE_MEM);
        else if (ph < 17) { const int q = ph - 3; layer = q / 7; const int st = q % 7;
            type = st == 0 ? PH_G1 : st == 1 ? PH_G2 : st == 2 ? PH_CONVIN : st == 3 ? PH_CONVMIX : st == 4 ? PH_WOUT : st == 5 ? PH_G1 : PH_G2; sub = st >= 5 ? 1 : 0; }
        else if (ph < 20) type = ph == 17 ? PH_KV1 : (ph == 18 ? PH_KV2 : PH_GLUE_KV);
        else { const int q = ph - 20; layer = 2 + q / 8; const int st = q % 8;
            type = st == 0 ? PH_G1 : st == 1 ? PH_G2 : st == 2 ? PH_MLAIN : st == 3 ? PH_UQ : st == 4 ? PH_MLAATT : st == 5 ? PH_WOUT : st == 6 ? PH_G1 : PH_G2; sub = st >= 6 ? 1 : 0; }

        if (type == PH_PREP) {
            LAS float* scr = (LAS float*)(ldsl + wave * 16640);
            for (int job = 0; job < 33; ++job) {
                const float* W; const float* g = nullptr; int K, Nsrc, Ndst, mode = MAP_PLAIN; bf16* dst;
                if (job < 8) { const int l = job >> 1, s = job & 1; W = ffn_w13 + (size_t)job * DM * N13; g = norm_g + (size_t)(l * 3 + (s ? 2 : 0)) * DM; K = DM; Nsrc = N13; Ndst = N13; mode = MAP_GATEUP; dst = W13T + (size_t)job * N13 * DM; }
                else if (job < 16) { const int j = job - 8; W = ffn_w2 + (size_t)j * FF * DM; K = FF; Nsrc = DM; Ndst = DM; dst = W2T + (size_t)j * DM * FF; }
                else if (job < 20) { const int l = job - 16; W = w_out + (size_t)l * DM * DM; K = DM; Nsrc = DM; Ndst = DM; dst = WOUTT + (size_t)l * DM * DM; }
                else if (job < 22) { const int l = job - 20; W = conv_w_in + (size_t)l * DM * NCONV; g = norm_g + (size_t)(l * 3 + 1) * DM; K = DM; Nsrc = NCONV; Ndst = NCONV; mode = MAP_CONVIN; dst = CONVINT + (size_t)l * NCONV * DM; }
                else if (job < 24) { const int j = job - 22; W = mla_w_in + (size_t)j * DM * 640; g = norm_g + (size_t)((2 + j) * 3 + 1) * DM; K = DM; Nsrc = 640; Ndst = NMLA; dst = MLAINT + (size_t)j * NMLA * DM; }
                else if (job < 26) { const int j = job - 24; W = w_uq + (size_t)j * 384 * 1152; g = g_q_lora + j * 384; K = 384; Nsrc = 1152; Ndst = NUQ; dst = WUQT + (size_t)j * (MiB / 2); }
                else if (job == 26) { W = w_dkv; g = kv_norm_g; K = DM; Nsrc = 256; Ndst = 256; dst = WKV1T; }
                else if (job == 27) { W = w_kr; g = kv_norm_g; K = DM; Nsrc = 64; Ndst = 256; dst = WKV1T + (size_t)256 * DM; }
                else if (job == 28) { W = w_ukv; g = g_ckv; K = 256; Nsrc = NKV2; Ndst = NKV2; dst = WKV2T; }
                else { const int l = job - 29; W = w_mem_kv + (size_t)l * DM * 512; g = mem_norm_g + l * DM; K = DM; Nsrc = 512; Ndst = 512; dst = WMEMKVT + (size_t)l * 512 * DM; }
                const bool f16w = job < 8 || (job >= 20 && job < 24) || job == 26 || job == 27;
                prep_weight(W, g, K, Nsrc, dst, Ndst, mode, f16w, scr, gw, NGW, lane);
            }
            for (int m = gw; m < T; m += NGW) row_to_bf16(x_in + (size_t)m * DM, true, XB + (size_t)m * DM, SSQ + (size_t)m * 16, 16, lane);
            for (int m = gw; m < MEMROWS; m += NGW) row_to_bf16(mem_in + (size_t)m * DM, false, MEMB + (size_t)m * DM, MEMSSQ + (size_t)m * 4, 4, lane);
        }
        else if (type == PH_GLUE_MEM) {
            for (int it = gw; it < 4 * MEMROWS * 4; it += NGW) { const int h = it & 3, row = (it >> 2) % MEMROWS, l = it / (4 * MEMROWS); const int b = row >> 8, m = row & 255;
                const float kv = bf2f(MEMKVRAW[(size_t)row * NMEMKV + l * 512 + h * 64 + lane]); const unsigned short vv = MEMKVRAW[(size_t)row * NMEMKV + l * 512 + 256 + h * 64 + lane];
                const float ss = wave_sum(kv * kv); const float kn = kv * __builtin_amdgcn_rsqf(ss * (1.0f / 64.0f) + EPS) * g_mem_k[l * 64 + lane];
                const size_t o = ((((size_t)l * NBATCH + b) * 4 + h) * 256 + m) * 128;
                KMEM[o + lane] = (bf16)f2bf(kn); KMEM[o + 64 + lane] = 0; VMEM[o + lane] = vv; VMEM[o + 64 + lane] = 0; }
        }
        else if (type == PH_GLUE_KV) {
            const int j16 = lane & 15;
            const f32x4 gn0 = *(const f32x4*)(g_k_nope + 8 * j16), gn1 = *(const f32x4*)(g_k_nope + 8 * j16 + 4), gr = *(const f32x4*)(g_k_rope + 4 * j16);
            for (int t4 = gw; t4 < T / 4; t4 += NGW) {
                const int t = t4 * 4 + (lane >> 4); const int pos = positions[t];
                bf16* kvp = KVB + (size_t)t * NKV2 + 8 * j16;
                bf16x8 kv[6];
#pragma unroll
                for (int h = 0; h < 6; ++h) kv[h] = *(const bf16x8*)(kvp + h * 256);
                const v2u krw = *(const v2u*)(CKVRAW + (size_t)t * NKV1 + 256 + 4 * j16);
#pragma unroll
                for (int h = 0; h < 6; ++h) { float f[8]; float ss = 0.f;
#pragma unroll
                    for (int e = 0; e < 8; ++e) { f[e] = bf2f((unsigned short)kv[h][e]); ss += f[e] * f[e]; }
                    ss += pg8::swz_xor<1>(ss); ss += pg8::swz_xor<2>(ss); ss += pg8::swz_xor<4>(ss); ss += pg8::swz_xor<8>(ss);
                    const float rs = __builtin_amdgcn_rsqf(ss * (1.0f / 128.0f) + EPS);
                    v4u w; w.x = pk2(f[0] * rs * gn0[0], f[1] * rs * gn0[1]); w.y = pk2(f[2] * rs * gn0[2], f[3] * rs * gn0[3]); w.z = pk2(f[4] * rs * gn1[0], f[5] * rs * gn1[1]); w.w = pk2(f[6] * rs * gn1[2], f[7] * rs * gn1[3]);
                    *(v4u*)(kvp + h * 256) = w; }
                { float x[4] = {pg8::bf_lo(krw.x), pg8::bf_hi(krw.x), pg8::bf_lo(krw.y), pg8::bf_hi(krw.y)};
                  float ss = (x[0] * x[0] + x[1] * x[1]) + (x[2] * x[2] + x[3] * x[3]);
                  ss += pg8::swz_xor<1>(ss); ss += pg8::swz_xor<2>(ss); ss += pg8::swz_xor<4>(ss); ss += pg8::swz_xor<8>(ss);
                  const float rs = __builtin_amdgcn_rsqf(ss * (1.0f / 64.0f) + EPS); float y[4];
#pragma unroll
                  for (int e = 0; e < 4; ++e) { const float mine = x[e] * rs * gr[e], other = pg8::swz_xor<8>(mine); float c, sn; rope_cs(pos, 4 * (j16 & 7) + e, c, sn);
                      y[e] = j16 < 8 ? mine * c - other * sn : mine * c + other * sn; }
                  v2u w; w.x = pk2(y[0], y[1]); w.y = pk2(y[2], y[3]); *(v2u*)(KRB + (size_t)t * 64 + 4 * j16) = w; }
            }
        }
#ifndef NO_GEMM
        else if (type == PH_G1) {
            pg8::Gemm g{XB, W13T + (size_t)(layer * 2 + sub) * N13 * DM, T, N13, DM, DM}; pg8::StaticOrder S; S.init(T, N13, G, bx);
            if (lane == 0) ((LAS int*)(ldsl + 131072 + 4096))[wave] = -1;
            LDS_WAIT();
            pg8::EpiSwiglu E{ACT, FF, SSQ, ldsl};
#ifndef NO_G1
            pg8::gemm_phase<pg8::EpiSwiglu, pg8::StaticOrder, true, true, true>(ldsl, g, S, E, tid);
#endif
        }
        else if (type == PH_G2 || type == PH_WOUT) {
            const bool isw = type == PH_WOUT;
            pg8::Gemm g{isw ? MIX : ACT, isw ? WOUTT + (size_t)layer * DM * DM : W2T + (size_t)(layer * 2 + sub) * DM * FF, T, DM, isw ? DM : FF, isw ? DM : FF}; pg8::StaticOrder S; S.init(T, DM, G, bx);
            float alpha_ = isw ? 1.0f : 0.5f;
#ifdef PROBE_TYPE
            if (type == PROBE_TYPE) alpha_ *= 0.5f;
#endif
            pg8::EpiResid E{ph == 35 ? X : nullptr, (_Float16*)XB, SSQ, alpha_};
#ifndef NO_G2
            pg8::gemm_phase<pg8::EpiResid, pg8::StaticOrder, true, true>(ldsl, g, S, E, tid);
#endif
        }
        else if (type == PH_MEMKV || type == PH_CONVIN || type == PH_MLAIN || type == PH_UQ || type == PH_KV1 || type == PH_KV2) {
            pg8::Gemm g; pg8::EpiGen E; int M_ = T;
            if (type == PH_MEMKV) { g = pg8::Gemm{MEMB, WMEMKVT, MEMROWS, NMEMKV, DM, DM}; M_ = MEMROWS; E = pg8::EpiGen{MEMKVRAW, NMEMKV, MEMSSQ, 4, 4, 1.0f / 1024.0f, 0, 0, nullptr, 0}; }
            else if (type == PH_CONVIN) { g = pg8::Gemm{XB, CONVINT + (size_t)layer * NCONV * DM, T, NCONV, DM, DM}; E = pg8::EpiGen{PCONV, PSTRIDE, SSQ, 16, 16, 1.0f / 1024.0f, 6, 768, nullptr, 0}; }
            else if (type == PH_MLAIN) { g = pg8::Gemm{XB, MLAINT + (size_t)(layer - 2) * NMLA * DM, T, NMLA, DM, DM}; E = pg8::EpiGen{CQRAW, NMLA, SSQ, 16, 16, 1.0f / 1024.0f, 0, 0, CSSQ, 24}; }
            else if (type == PH_UQ) { g = pg8::Gemm{CQRAW, WUQT + (size_t)(layer - 2) * (MiB / 2), T, NUQ, 384, NMLA}; E = pg8::EpiGen{QRAW, NUQ, CSSQ, 24, 12, 1.0f / 384.0f, 0, 0, nullptr, 0}; }
            else if (type == PH_KV1) { g = pg8::Gemm{XB, WKV1T, T, NKV1, DM, DM}; E = pg8::EpiGen{CKVRAW, NKV1, SSQ, 16, 16, 1.0f / 1024.0f, 0, 0, CSSQ, 16}; }
            else { g = pg8::Gemm{CKVRAW, WKV2T, T, NKV2, 256, NKV1}; E = pg8::EpiGen{KVB, NKV2, CSSQ, 16, 8, 1.0f / 256.0f, 0, 0, nullptr, 0}; }
            pg8::StaticOrder S; S.init(M_, g.N, G, bx);
#ifndef NO_GEN
            if (type == PH_CONVIN || type == PH_MLAIN || type == PH_KV1) pg8::gemm_phase<pg8::EpiGen, pg8::StaticOrder, true, true, true>(ldsl, g, S, E, tid);
            else pg8::gemm_phase<pg8::EpiGen, pg8::StaticOrder, true, true, false>(ldsl, g, S, E, tid);
#endif
        }
#endif
        else if (type == PH_CONVMIX || type == PH_MLAATT) {
            const int W = 1 << 20;
            if (type == PH_CONVMIX) {
                const float* cw = conv_w + (size_t)layer * 3 * 768;
                for (int idx = bx * (NWAVES * 64) + tid; idx < T * 96; idx += G * NWAVES * 64) { const int t = idx / 96, c8 = (idx % 96) * 8, s = t & (SEQ - 1);
                    const bf16* up = PCONV + (size_t)t * PSTRIDE + c8; const bf16x8 u0 = *(const bf16x8*)up; const bf16x8 gb = *(const bf16x8*)(up + 768);
                    bf16x8 u1 = {0, 0, 0, 0, 0, 0, 0, 0}, u2 = {0, 0, 0, 0, 0, 0, 0, 0};
                    if (s >= 1) u1 = *(const bf16x8*)(up - PSTRIDE); if (s >= 2) u2 = *(const bf16x8*)(up - 2 * PSTRIDE);
                    float y[8];
#pragma unroll
                    for (int j = 0; j < 8; ++j) { const float acc = cw[c8 + j] * bf2f((unsigned short)u2[j]) + cw[768 + c8 + j] * bf2f((unsigned short)u1[j]) + cw[1536 + c8 + j] * bf2f((unsigned short)u0[j]);
                        y[j] = bf2f((unsigned short)gb[j]) * acc; }
                    v4u o; o.x = pk2(y[0], y[1]); o.y = pk2(y[2], y[3]); o.z = pk2(y[4], y[5]); o.w = pk2(y[6], y[7]);
                    *(v4u*)(MIX + (size_t)t * DM + c8) = o; }
            } else {
#ifndef NO_MLA
                const int j = layer - 2; const float* gqn = g_q_nope + j * 128; const float* gqr = g_q_rope + j * 64;
                for (int L = vcu; L < 768; L += G)
                    for (int pass = 0; pass < 2; ++pass) {
                        att::BlockRef cur;
                        { const int bh_ = L >> 4, x_ = L & 15, b_ = bh_ / 6, h_ = bh_ % 6, qb_ = pass ? 31 - x_ : x_; const size_t t0_ = (size_t)b_ * SEQ + (size_t)qb_ * 256;
                          cur.Q = QRAW + t0_ * NUQ + h_ * 192; cur.K = KVB + (size_t)b_ * SEQ * NKV2 + h_ * 256; cur.V = cur.K + 128; cur.KR = KRB + (size_t)b_ * SEQ * 64;
                          cur.O = MIX + t0_ * DM + h_ * 128; cur.P0 = qb_ * 256; cur.qs = NUQ; cur.tok = (int)t0_; cur.pad = 0; }
                        bf16x8 qr[12];
                        const int r32 = lane & 31, hi = lane >> 5; const int pos = positions[cur.tok + wave * 32 + r32];
#pragma unroll
                        for (int d0 = 0; d0 < 12; ++d0) qr[d0] = att::load8(cur.Q + (size_t)(wave * 32 + r32) * NUQ + d0 * 16 + hi * 8);
                        { float ss = 0.f;
#pragma unroll
                          for (int d0 = 0; d0 < 8; ++d0)
#pragma unroll
                              for (int e = 0; e < 8; ++e) { const float v = bf2f((unsigned short)qr[d0][e]); ss += v * v; }
                          ss = pg8::add_xor32(ss); const float rn = __builtin_amdgcn_rsqf(ss * (1.0f / 128.0f) + EPS) * 0.07216878364870322f;
#pragma unroll
                          for (int d0 = 0; d0 < 8; ++d0) { const f32x4 g0 = *(const f32x4*)(gqn + d0 * 16 + hi * 8), g1 = *(const f32x4*)(gqn + d0 * 16 + hi * 8 + 4); v4u w;
                              w.x = pk2(bf2f((unsigned short)qr[d0][0]) * rn * g0[0], bf2f((unsigned short)qr[d0][1]) * rn * g0[1]); w.y = pk2(bf2f((unsigned short)qr[d0][2]) * rn * g0[2], bf2f((unsigned short)qr[d0][3]) * rn * g0[3]);
                              w.z = pk2(bf2f((unsigned short)qr[d0][4]) * rn * g1[0], bf2f((unsigned short)qr[d0][5]) * rn * g1[1]); w.w = pk2(bf2f((unsigned short)qr[d0][6]) * rn * g1[2], bf2f((unsigned short)qr[d0][7]) * rn * g1[3]);
                              qr[d0] = *reinterpret_cast<bf16x8*>(&w); __builtin_amdgcn_sched_barrier(0); }
                          float s2 = 0.f;
#pragma unroll
                          for (int d0 = 8; d0 < 12; ++d0)
#pragma unroll
                              for (int e = 0; e < 8; ++e) { const float v = bf2f((unsigned short)qr[d0][e]); s2 += v * v; }
                          s2 = pg8::add_xor32(s2); const float rr = __builtin_amdgcn_rsqf(s2 * (1.0f / 64.0f) + EPS) * 0.07216878364870322f;
#pragma unroll
                          for (int d0 = 0; d0 < 2; ++d0) { float y1[8], y2[8];
#pragma unroll
                              for (int e = 0; e < 8; ++e) { const int i = d0 * 16 + hi * 8 + e; const float a = bf2f((unsigned short)qr[8 + d0][e]) * rr * gqr[i], b2 = bf2f((unsigned short)qr[10 + d0][e]) * rr * gqr[32 + i];
                                  float c, s; rope_cs(pos, i, c, s); y1[e] = a * c - b2 * s; y2[e] = b2 * c + a * s; __builtin_amdgcn_sched_barrier(0); }
                              v4u w1, w2; w1.x = pk2(y1[0], y1[1]); w1.y = pk2(y1[2], y1[3]); w1.z = pk2(y1[4], y1[5]); w1.w = pk2(y1[6], y1[7]);
                              w2.x = pk2(y2[0], y2[1]); w2.y = pk2(y2[2], y2[3]); w2.z = pk2(y2[4], y2[5]); w2.w = pk2(y2[6], y2[7]);
                              qr[8 + d0] = *reinterpret_cast<bf16x8*>(&w1); qr[10 + d0] = *reinterpret_cast<bf16x8*>(&w2); } }
                        att::attn_run<0>(cur, qr, SEQ, W, (char*)lds, tid);
                    }
#endif
            }
#ifndef NO_MEM
            {
                const bf16* QM = type == PH_CONVMIX ? PCONV + 1536 : CQRAW + 384; const int qs = type == PH_CONVMIX ? PSTRIDE : NMLA;
                const float* gq = g_mem_q + layer * 64;
                for (int L = vcu; L < 1024; L += G) {
                    att::BlockRef cur;
                    { const int tt_ = L >> 2, h_ = L & 3, b_ = tt_ >> 5; const size_t t0_ = (size_t)tt_ * 256; const size_t kvo_ = (((size_t)layer * NBATCH + b_) * 4 + h_) * 256 * 128;
                      cur.Q = QM + t0_ * qs + h_ * 64; cur.K = KMEM + kvo_; cur.V = VMEM + kvo_; cur.KR = nullptr; cur.O = MIX + t0_ * DM + 768 + h_ * 64; cur.P0 = 256; cur.qs = qs; cur.tok = (int)t0_; cur.pad = 0; }
                    bf16x8 qr[4]; const int r32 = lane & 31, hi = lane >> 5;
#pragma unroll
                    for (int d0 = 0; d0 < 4; ++d0) qr[d0] = att::load8(cur.Q + (size_t)(wave * 32 + r32) * qs + d0 * 16 + hi * 8);
                    { float ss = 0.f;
#pragma unroll
                      for (int d0 = 0; d0 < 4; ++d0)
#pragma unroll
                          for (int e = 0; e < 8; ++e) { const float v = bf2f((unsigned short)qr[d0][e]); ss += v * v; }
                      ss = pg8::add_xor32(ss); const float rn = __builtin_amdgcn_rsqf(ss * (1.0f / 64.0f) + EPS) * 0.125f;
#pragma unroll
                      for (int d0 = 0; d0 < 4; ++d0) { const f32x4 g0 = *(const f32x4*)(gq + d0 * 16 + hi * 8), g1 = *(const f32x4*)(gq + d0 * 16 + hi * 8 + 4); v4u w;
                          w.x = pk2(bf2f((unsigned short)qr[d0][0]) * rn * g0[0], bf2f((unsigned short)qr[d0][1]) * rn * g0[1]); w.y = pk2(bf2f((unsigned short)qr[d0][2]) * rn * g0[2], bf2f((unsigned short)qr[d0][3]) * rn * g0[3]);
                          w.z = pk2(bf2f((unsigned short)qr[d0][4]) * rn * g1[0], bf2f((unsigned short)qr[d0][5]) * rn * g1[1]); w.w = pk2(bf2f((unsigned short)qr[d0][6]) * rn * g1[2], bf2f((unsigned short)qr[d0][7]) * rn * g1[3]);
                          qr[d0] = *reinterpret_cast<bf16x8*>(&w); } }
                    att::attn_run<1>(cur, qr, 256, W, (char*)lds, tid);
                }
            }
#endif
        }
        bool again = false;
#ifdef PROBE_TYPE
        if (type == PROBE_TYPE && !probe_done) { probe_done = true; again = true; } else probe_done = false;
#endif
        if (again || ph + 1 < args.hi) { if (ph == 0 && !again) grid.sync(); else xcd_barrier(xbar, tid); }
#ifdef PROBE_SYNC
        if (again || ph + 1 < args.hi) xcd_barrier(xbar, tid);
#endif
        if (again) --ph;
    }
}

extern "C" void kernel_launch(void* const* d_in, const int* in_sizes, int n_in, void* d_out, int out_size, void* d_ws, size_t ws_size, hipStream_t stream) {
    static int grid = 0;
    constexpr int NPHASE = 36;
    if (grid == 0) {
        if (n_in != 25 || in_sizes[0] != T * DM || out_size != T * DM || ws_size < WS_END) { fprintf(stderr, "kernel_launch: unexpected shapes (n_in %d, in0 %d, out %d, ws %zu, need %zu)\n", n_in, n_in > 0 ? in_sizes[0] : -1, out_size, ws_size, (size_t)WS_END); grid = -1; return; }
        int dev = 0, cus = 0, per_cu = 0;
        if (hipGetDevice(&dev) != hipSuccess || hipDeviceGetAttribute(&cus, hipDeviceAttributeMultiprocessorCount, dev) != hipSuccess) { grid = -1; return; }
        if (hipFuncSetAttribute((const void*)yoco_fwd, hipFuncAttributeMaxDynamicSharedMemorySize, LDS_BYTES) != hipSuccess) { fprintf(stderr, "kernel_launch: hipFuncSetAttribute failed\n"); grid = -1; return; }
        if (hipOccupancyMaxActiveBlocksPerMultiprocessor(&per_cu, (const void*)yoco_fwd, NWAVES * 64, LDS_BYTES) != hipSuccess || per_cu < 1) { fprintf(stderr, "kernel_launch: occupancy query says %d\n", per_cu); per_cu = 1; }
        (void)hipGetLastError();
        grid = cus;
    }
    if (grid < 0) return;
    Args a{};
    for (int i = 0; i < 25; ++i) a.in[i] = d_in[i];
    a.out = (float*)d_out; a.ws = (unsigned char*)d_ws;
#if MK_N_LAUNCHES == 1
    if (hipMemsetAsync((char*)d_ws + WS_CTL, 0, CTL_BYTES, stream) != hipSuccess) { fprintf(stderr, "kernel_launch: memset of the barrier words failed\n"); return; }
    a.lo = 0; a.hi = NPHASE;
    void* kargs[] = {&a};
    hipError_t e = hipLaunchCooperativeKernel((const void*)yoco_fwd, dim3(grid), dim3(NWAVES * 64), kargs, LDS_BYTES, stream);
    if (e != hipSuccess) fprintf(stderr, "kernel_launch: cooperative launch failed: %s (grid %d)\n", hipGetErrorString(e), grid);
#else
    for (int p = 0; p < NPHASE; ++p) { a.lo = p; a.hi = p + 1; hipLaunchKernelGGL(yoco_fwd, dim3(grid), dim3(NWAVES * 64), LDS_BYTES, stream, a); }
#endif
}
```

```cpp
#include <hip/hip_runtime.h>
#include <hip/hip_cooperative_groups.h>
#include <cstdio>
#include <cstdint>
namespace cg = cooperative_groups;
namespace pg8 {
#define PG8_LAS __attribute__((address_space(3)))
typedef unsigned short bf16_t;
typedef short bf16x8 __attribute__((ext_vector_type(8)));
typedef float f32x4 __attribute__((ext_vector_type(4)));
typedef unsigned u32x4 __attribute__((ext_vector_type(4)));
constexpr int BM = 256, BK = 64, HALF = 128, HTB = HALF * BK * 2  , STAGE_BYTES = 8 * HTB, NXCD = 8, WGM = 8;

__host__ __device__ __forceinline__ int lds_byte(int r, int c) { const int st = (r >> 4) * 2 + (c >> 5), rr = r & 15, cc = c & 31, ob = rr * 64 + cc * 2; return st * 1024 + (ob ^ (((ob >> 9) & 1) << 5)); }
__host__ __device__ __forceinline__ void stage_rc(int b, int& R, int& C) { const int st = b / 1024, sb = b % 1024, swz = sb ^ (((sb >> 9) & 1) << 5); R = (st >> 1) * 16 + swz / 64; C = (st & 1) * 32 + (swz % 64) / 2; }
__host__ __device__ __forceinline__ int perm32(int rho) { const int n = rho >> 4, i = rho & 15; return 8 * (i >> 2) + 4 * n + (i & 3); }

struct Unit { int pm, pn; };
struct Gemm { const bf16_t* A; const bf16_t* Bt; int M, N, K, lda; };

struct StaticOrder {
    int nM, nN, nwg, G, c;
    __host__ __device__ void init(int M, int N, int G_, int c_) { nM = M / BM; nN = N / BM; nwg = nM * nN; G = G_; c = c_; }
    __host__ __device__ bool next(int i, Unit& u) const {
        const long L = (long)i * G + c; if (L >= nwg) return false;
        int wgid = (int)L; { const int q = nwg / NXCD, r = nwg % NXCD, xcd = wgid % NXCD, off = wgid / NXCD; wgid = (xcd < r ? xcd * (q + 1) : r * (q + 1) + (xcd - r) * q) + off; }
        const int nig = WGM * nN, gid = wgid / nig, fm = gid * WGM, gsz = (nM - fm) < WGM ? (nM - fm) : WGM;
        u.pm = fm + ((wgid % nig) % gsz); u.pn = (wgid % nig) / gsz; return true;
    }
    __device__ __forceinline__ void a_ready(const Unit&) const {}
    __device__ __forceinline__ void done(const Unit&) const {}
};

__device__ __forceinline__ unsigned cvt_pk_bf16(float lo, float hi) { unsigned r; asm volatile("v_cvt_pk_bf16_f32 %0, %1, %2" : "=v"(r) : "v"(lo), "v"(hi)); return r; }
typedef float f32x2 __attribute__((ext_vector_type(2)));
template <int XM> __device__ __forceinline__ float swz_xor(float v) { return __builtin_bit_cast(float, __builtin_amdgcn_ds_swizzle(__builtin_bit_cast(int, v), (XM << 10) | 0x1f)); }
__device__ __forceinline__ float add_xor32(float v) {
    auto r = __builtin_amdgcn_permlane32_swap(__float_as_uint(v), __float_as_uint(v), false, false); const unsigned r0 = r[0], r1 = r[1]; return __uint_as_float(r0) + __uint_as_float(r1); }
__device__ __forceinline__ float add_xor16_32(float s) { s += swz_xor<16>(s); return add_xor32(s); }
__device__ __forceinline__ float row_rs(const float* ssq, int stride, int nslots, float inv_n, int row, int fq) {
    const f32x4* p = (const f32x4*)(ssq + (size_t)row * stride); float s = 0.f;
    for (int i = 4 * fq; i < nslots; i += 16) { const f32x4 v = p[i >> 2]; s += (v[0] + v[1]) + (v[2] + v[3]); }
    s = add_xor16_32(s);
    return __builtin_amdgcn_rsqf(s * inv_n + 1e-6f);
}
__device__ __forceinline__ float sig_mul(float g, float u) {
    const float e = __builtin_amdgcn_exp2f(-1.4426950408889634f * g); return g * __builtin_amdgcn_rcpf(1.0f + e) * u;
}
struct EpiSwiglu {
    static constexpr bool PERM = true, AFTER_DRAIN = false;
    bf16_t* O; int ldc; const float* ssq; PG8_LAS unsigned char* lds;
    __device__ __forceinline__ void operator()(const f32x4 (&acc)[2][2][4][2], const Unit& u, int wr, int wc, int fr, int fq) const {
        const int row0 = u.pm * BM + wr * 64 + fr, col0 = u.pn * HALF + wc * 32 + 8 * fq;
        const int wid = wr * 4 + wc;
        PG8_LAS float* rc = (PG8_LAS float*)(lds + 131072) + wid * 128 + fr;
        PG8_LAS int* tg = (PG8_LAS int*)(lds + 131072 + 4096) + wid;
        const bool hit = __builtin_amdgcn_readfirstlane(*tg) == u.pm;
        float rs[2][4];
        if (hit) {
#pragma unroll
            for (int ai = 0; ai < 2; ++ai)
#pragma unroll
                for (int m = 0; m < 4; ++m) rs[ai][m] = rc[ai * 64 + m * 16];
        } else {
#pragma unroll
            for (int ai = 0; ai < 2; ++ai)
#pragma unroll
                for (int m = 0; m < 4; ++m) rs[ai][m] = row_rs(ssq, 16, 16, 1.0f / 1024.0f, row0 + ai * HALF + m * 16, fq);
            if (fq == 0) {
#pragma unroll
                for (int ai = 0; ai < 2; ++ai)
#pragma unroll
                    for (int m = 0; m < 4; ++m) rc[ai * 64 + m * 16] = rs[ai][m];
                if (fr == 0) *tg = u.pm; }
        }
#pragma unroll
        for (int ai = 0; ai < 2; ++ai)
#pragma unroll
            for (int m = 0; m < 4; ++m) { const int row = row0 + ai * HALF + m * 16; const float r_ = rs[ai][m];
                const float c_ = -1.4426950408889634f * r_, ir2 = __builtin_amdgcn_rcpf(r_ * r_);
#define SWG(a0_, a1_) ((a0_) * (a1_) * __builtin_amdgcn_rcpf(__builtin_fmaf(__builtin_amdgcn_exp2f((a0_) * c_), ir2, ir2)))
                const f32x4 g0 = acc[ai][0][m][0], g1 = acc[ai][0][m][1], u0 = acc[ai][1][m][0], u1 = acc[ai][1][m][1];
                u32x4 w; w.x = cvt_pk_bf16(SWG(g0[0], u0[0]), SWG(g0[1], u0[1])); w.y = cvt_pk_bf16(SWG(g0[2], u0[2]), SWG(g0[3], u0[3]));
                w.z = cvt_pk_bf16(SWG(g1[0], u1[0]), SWG(g1[1], u1[1])); w.w = cvt_pk_bf16(SWG(g1[2], u1[2]), SWG(g1[3], u1[3]));
#undef SWG
                *(u32x4*)(O + (size_t)row * ldc + col0) = w; }
    }
};
typedef _Float16 h16x8 __attribute__((ext_vector_type(8)));
template <bool F16> __device__ __forceinline__ f32x4 mma16(bf16x8 a, bf16x8 b, f32x4 c) {
    if constexpr (F16) return __builtin_amdgcn_mfma_f32_16x16x32_f16(__builtin_bit_cast(h16x8, a), __builtin_bit_cast(h16x8, b), c, 0, 0, 0);
    else return __builtin_amdgcn_mfma_f32_16x16x32_bf16(a, b, c, 0, 0, 0);
}
__device__ __forceinline__ float bf_lo(unsigned w) { return __builtin_bit_cast(float, w << 16); }
__device__ __forceinline__ float bf_hi(unsigned w) { return __builtin_bit_cast(float, w & 0xffff0000u); }
struct EpiResid {
    static constexpr bool PERM = true, AFTER_DRAIN = false;
    float* fout; _Float16* XH; float* ssq; float alpha;
    __device__ __forceinline__ void operator()(const f32x4 (&acc)[2][2][4][2], const Unit& u, int wr, int wc, int fr, int fq) const {
        const int row0 = u.pm * BM + wr * 64 + fr, col0 = u.pn * BM + wc * 32 + 8 * fq;
#pragma unroll
        for (int ai = 0; ai < 2; ++ai) {
            h16x8 pre[4][2];
#pragma unroll
            for (int m = 0; m < 4; ++m)
#pragma unroll
                for (int bj = 0; bj < 2; ++bj) pre[m][bj] = *(const h16x8*)(XH + (size_t)(row0 + ai * HALF + m * 16) * 1024 + col0 + bj * HALF);
#pragma unroll
            for (int m = 0; m < 4; ++m) { const int row = row0 + ai * HALF + m * 16; _Float16* bp = XH + (size_t)row * 1024 + col0; float s = 0.f;
#pragma unroll
                for (int bj = 0; bj < 2; ++bj) { const h16x8 o = pre[m][bj];
                    const f32x4 o0 = {(float)o[0], (float)o[1], (float)o[2], (float)o[3]}, o1 = {(float)o[4], (float)o[5], (float)o[6], (float)o[7]};
                    const f32x4 v0 = o0 + acc[ai][bj][m][0] * alpha, v1 = o1 + acc[ai][bj][m][1] * alpha;
                    if (fout) { float* xp = fout + (size_t)row * 1024 + col0 + bj * HALF; *(f32x4*)xp = v0; *(f32x4*)(xp + 4) = v1; }
                    const h16x8 w = {(_Float16)v0[0], (_Float16)v0[1], (_Float16)v0[2], (_Float16)v0[3], (_Float16)v1[0], (_Float16)v1[1], (_Float16)v1[2], (_Float16)v1[3]};
                    *(h16x8*)(bp + bj * HALF) = w;
                    s += (v0[0] * v0[0] + v0[1] * v0[1]) + (v0[2] * v0[2] + v0[3] * v0[3]) + (v1[0] * v1[0] + v1[1] * v1[1]) + (v1[2] * v1[2] + v1[3] * v1[3]); }
                s = add_xor16_32(s);
                if (fq == 0) ssq[(size_t)row * 16 + u.pn * 4 + wc] = s; }
            asm volatile("" ::: "memory"); }
    }
};
struct EpiGen {
    static constexpr bool PERM = true, AFTER_DRAIN = false;
    bf16_t* O; int ldc; const float* ssq; int ssq_stride, ssq_n; float ssq_inv; int npair, col_shift; float* osq; int osq_stride;
    __device__ __forceinline__ void operator()(const f32x4 (&acc)[2][2][4][2], const Unit& u, int wr, int wc, int fr, int fq) const {
        const int row0 = u.pm * BM + wr * 64 + fr; const bool pair = u.pn < npair;
        const int col0 = (pair ? u.pn * HALF : u.pn * BM - col_shift) + wc * 32 + 8 * fq;
        float rsv[2][4];
#pragma unroll
        for (int ai = 0; ai < 2; ++ai)
#pragma unroll
            for (int m = 0; m < 4; ++m) rsv[ai][m] = ssq ? row_rs(ssq, ssq_stride, ssq_n, ssq_inv, row0 + ai * HALF + m * 16, fq) : 1.0f;
#pragma unroll
        for (int ai = 0; ai < 2; ++ai)
#pragma unroll
            for (int m = 0; m < 4; ++m) { const int row = row0 + ai * HALF + m * 16; const float rs = rsv[ai][m];
                bf16_t* rowp = O + (size_t)row * ldc + col0;
                if (pair) { const f32x4 v0 = (acc[ai][0][m][0] * rs) * (acc[ai][1][m][0] * rs), v1 = (acc[ai][0][m][1] * rs) * (acc[ai][1][m][1] * rs);
                    u32x4 w; w.x = cvt_pk_bf16(v0[0], v0[1]); w.y = cvt_pk_bf16(v0[2], v0[3]); w.z = cvt_pk_bf16(v1[0], v1[1]); w.w = cvt_pk_bf16(v1[2], v1[3]);
                    *(u32x4*)rowp = w; }
                else {
#pragma unroll
                    for (int bj = 0; bj < 2; ++bj) { const f32x4 v0 = acc[ai][bj][m][0] * rs, v1 = acc[ai][bj][m][1] * rs;
                        u32x4 w; w.x = cvt_pk_bf16(v0[0], v0[1]); w.y = cvt_pk_bf16(v0[2], v0[3]); w.z = cvt_pk_bf16(v1[0], v1[1]); w.w = cvt_pk_bf16(v1[2], v1[3]);
                        *(u32x4*)(rowp + bj * HALF) = w;
                        if (osq) { float s = (v0[0] * v0[0] + v0[1] * v0[1]) + (v0[2] * v0[2] + v0[3] * v0[3]) + (v1[0] * v1[0] + v1[1] * v1[1]) + (v1[2] * v1[2] + v1[3] * v1[3]);
                            s = add_xor16_32(s);
                            if (fq == 0) osq[(size_t)row * osq_stride + u.pn * 8 + bj * 4 + wc] = s; } } } }
    }
};
template <class Epi, class Sched, bool ALIGN_EPI = false, bool SP2 = false, bool F16 = false>
__device__ __forceinline__ void gemm_phase(PG8_LAS unsigned char* lds, const Gemm g, const Sched& S, const Epi& E, const int tid) {
    const int wid = __builtin_amdgcn_readfirstlane(tid >> 6), lane = tid & 63, wr = wid >> 2, wc = wid & 3, fr = lane & 15, fq = lane >> 4;
    const int K = g.K, nt = K / BK;
    unsigned voffA[2], voffB[2];
#pragma unroll
    for (int i = 0; i < 2; ++i) { int R, C; stage_rc(tid * 16 + i * 8192, R, C); const int Rb = Epi::PERM ? ((R & ~31) + perm32(R & 31)) : R;
        voffA[i] = (unsigned)(R * g.lda + C) * 2u; voffB[i] = (unsigned)(Rb * K + C) * 2u; }
    const size_t kstep = (size_t)(BK * 2);
    const size_t hstep = (size_t)HALF * K * 2;
    const size_t tstep = 2 * hstep; const size_t hstepA = (size_t)HALF * g.lda * 2, tstepA = 2 * hstepA;
    const unsigned ldsw = (unsigned)wid * 1024u;
    const int aoff = lds_byte(wr * 64 + fr, fq * 8), boff = lds_byte(wc * 32 + fr, fq * 8);
#define PG8_SA(b, h) (((b) * 2 + (h)) * HTB)
#define PG8_SB(b, h) ((4 + (b) * 2 + (h)) * HTB)
#define PG8_STAGE(bufoff, gbase, voff) do { _Pragma("unroll") for (int _i = 0; _i < 2; ++_i) \
        __builtin_amdgcn_global_load_lds((const unsigned*)((const char*)(gbase) + (voff)[_i]), (PG8_LAS unsigned*)(lds + (bufoff) + ldsw + _i * 8192), 16, 0, 0); } while (0)
#define PG8_LDA(dst, b, h) do { _Pragma("unroll") for (int m = 0; m < 4; ++m) _Pragma("unroll") for (int k = 0; k < 2; ++k) dst[m][k] = *(const PG8_LAS bf16x8*)(lds + PG8_SA(b, h) + aoff + m * 2048 + k * 1024); } while (0)
#define PG8_LDB(dst, b, h) do { _Pragma("unroll") for (int n = 0; n < 2; ++n) _Pragma("unroll") for (int k = 0; k < 2; ++k) dst[n][k] = *(const PG8_LAS bf16x8*)(lds + PG8_SB(b, h) + boff + n * 2048 + k * 1024); } while (0)
#define PG8_MMA(ai, bj, At, Bt) do { __builtin_amdgcn_s_setprio(1); _Pragma("unroll") for (int m = 0; m < 4; ++m) _Pragma("unroll") for (int n = 0; n < 2; ++n) _Pragma("unroll") for (int k = 0; k < 2; ++k) \
        acc[ai][bj][m][n] = mma16<F16>(Bt[n][k], At[m][k], acc[ai][bj][m][n]); __builtin_amdgcn_s_setprio(0); } while (0)
#define PG8_WAIT_V(n) asm volatile("s_waitcnt vmcnt(" #n ")" ::: "memory")
#define PG8_WAIT_L(n) asm volatile("s_waitcnt lgkmcnt(" #n ")" ::: "memory")
#define PG8_BAR __builtin_amdgcn_s_barrier()
#define PG8_SCHED __builtin_amdgcn_sched_barrier(0)
    Unit cur, nxt; int ui = 0;
    if (!S.next(0, cur)) return;
    f32x4 acc[2][2][4][2];
#pragma unroll
    for (int a = 0; a < 2; ++a)
#pragma unroll
        for (int b = 0; b < 2; ++b)
#pragma unroll
            for (int m = 0; m < 4; ++m)
#pragma unroll
                for (int n = 0; n < 2; ++n) acc[a][b][m][n] = (f32x4){0.f, 0.f, 0.f, 0.f};
    bf16x8 At[4][2], B0[2][2], B1[2][2];
    const char* cA = (const char*)g.A + (size_t)cur.pm * tstepA; const char* cB = (const char*)g.Bt + (size_t)cur.pn * tstep;
    S.a_ready(cur);
    if constexpr (SP2) {
        PG8_STAGE(PG8_SB(0, 0), cB, voffB); PG8_STAGE(PG8_SB(0, 1), cB + hstep, voffB); PG8_STAGE(PG8_SA(0, 0), cA, voffA); PG8_STAGE(PG8_SA(0, 1), cA + hstepA, voffA);
        if (wr == 1) PG8_BAR;
        PG8_WAIT_V(2); PG8_BAR;
        PG8_STAGE(PG8_SB(1, 0), cB + kstep, voffB); PG8_STAGE(PG8_SA(1, 0), cA + kstep, voffA); PG8_STAGE(PG8_SB(1, 1), cB + hstep + kstep, voffB);
        PG8_WAIT_V(6); PG8_BAR;
    } else {
        PG8_STAGE(PG8_SB(0, 0), cB, voffB); PG8_STAGE(PG8_SA(0, 0), cA, voffA); PG8_STAGE(PG8_SB(0, 1), cB + hstep, voffB); PG8_STAGE(PG8_SA(0, 1), cA + hstepA, voffA);
        if (wr == 1) PG8_BAR;
        PG8_WAIT_V(4); PG8_BAR;
        PG8_STAGE(PG8_SB(1, 0), cB + kstep, voffB); PG8_STAGE(PG8_SA(1, 0), cA + kstep, voffA); PG8_STAGE(PG8_SB(1, 1), cB + hstep + kstep, voffB);
        PG8_WAIT_V(6); PG8_BAR;
    }
    for (;;) {
        const bool has_next = S.next(ui + 1, nxt);
        const char* nA = has_next ? (const char*)g.A + (size_t)nxt.pm * tstepA : cA; const char* nB = has_next ? (const char*)g.Bt + (size_t)nxt.pn * tstep : cB;
        for (int t = 0; t < nt; t += 2) {
            const bool last = (t == nt - 2);
            const char* a1 = cA + (size_t)(t + 1) * kstep;
            const char* a2 = last ? nA : cA + (size_t)(t + 2) * kstep; const char* b2 = last ? nB : cB + (size_t)(t + 2) * kstep;
            const char* a3 = a2 + kstep; const char* b3 = b2 + kstep;
            if (last && has_next) S.a_ready(nxt);
            if constexpr (SP2) {
            PG8_LDB(B0, 0, 0); PG8_LDB(B1, 0, 1); PG8_SCHED; PG8_LDA(At, 0, 0); PG8_STAGE(PG8_SA(1, 1), a1 + hstepA, voffA);
            PG8_WAIT_V(8); PG8_WAIT_L(0); PG8_BAR; PG8_MMA(0, 0, At, B0); PG8_MMA(0, 1, At, B1); PG8_BAR; PG8_SCHED;
            PG8_LDA(At, 0, 1); PG8_STAGE(PG8_SB(0, 0), b2, voffB); PG8_STAGE(PG8_SB(0, 1), b2 + hstep, voffB); PG8_STAGE(PG8_SA(0, 0), a2, voffA);
            PG8_WAIT_V(8); PG8_WAIT_L(0); PG8_BAR; PG8_MMA(1, 0, At, B0); PG8_MMA(1, 1, At, B1); PG8_BAR; PG8_SCHED;
            PG8_LDB(B0, 1, 0); PG8_LDB(B1, 1, 1); PG8_SCHED; PG8_LDA(At, 1, 0); PG8_STAGE(PG8_SA(0, 1), a2 + hstepA, voffA);
            PG8_WAIT_V(8); PG8_WAIT_L(0); PG8_BAR; PG8_MMA(0, 0, At, B0); PG8_MMA(0, 1, At, B1); PG8_BAR; PG8_SCHED;
            PG8_LDA(At, 1, 1); PG8_STAGE(PG8_SB(1, 0), b3, voffB); PG8_STAGE(PG8_SB(1, 1), b3 + hstep, voffB); PG8_STAGE(PG8_SA(1, 0), a3, voffA);
            PG8_WAIT_V(8); PG8_WAIT_L(0); PG8_BAR; PG8_MMA(1, 0, At, B0); PG8_MMA(1, 1, At, B1); PG8_BAR; PG8_SCHED;
            } else {
            PG8_LDB(B0, 0, 0); PG8_SCHED; PG8_LDA(At, 0, 0); PG8_STAGE(PG8_SA(1, 1), a1 + hstepA, voffA);
            PG8_WAIT_L(8); PG8_BAR; PG8_WAIT_L(0); PG8_MMA(0, 0, At, B0); PG8_BAR; PG8_SCHED;
            PG8_LDB(B1, 0, 1); PG8_STAGE(PG8_SB(0, 0), b2, voffB);
            PG8_BAR; PG8_WAIT_L(0); PG8_MMA(0, 1, At, B1); PG8_BAR;
            PG8_LDA(At, 0, 1); PG8_STAGE(PG8_SA(0, 0), a2, voffA);
            PG8_BAR; PG8_WAIT_L(0); PG8_MMA(1, 0, At, B0); PG8_BAR; PG8_SCHED;
            PG8_STAGE(PG8_SB(0, 1), b2 + hstep, voffB);
            PG8_WAIT_V(6); PG8_BAR; PG8_MMA(1, 1, At, B1); PG8_BAR;
            PG8_LDB(B0, 1, 0); PG8_SCHED; PG8_LDA(At, 1, 0); PG8_STAGE(PG8_SA(0, 1), a2 + hstepA, voffA);
            PG8_WAIT_L(8); PG8_BAR; PG8_WAIT_L(0); PG8_MMA(0, 0, At, B0); PG8_BAR; PG8_SCHED;
            PG8_LDB(B1, 1, 1); PG8_STAGE(PG8_SB(1, 0), b3, voffB);
            PG8_BAR; PG8_WAIT_L(0); PG8_MMA(0, 1, At, B1); PG8_BAR;
            PG8_LDA(At, 1, 1); PG8_STAGE(PG8_SA(1, 0), a3, voffA);
            PG8_BAR; PG8_WAIT_L(0); PG8_MMA(1, 0, At, B0); PG8_BAR; PG8_SCHED;
            PG8_STAGE(PG8_SB(1, 1), b3 + hstep, voffB);
            PG8_WAIT_V(6); PG8_BAR; PG8_MMA(1, 1, At, B1); PG8_BAR;
            }
        }
        if constexpr (ALIGN_EPI) { if (wr == 0) PG8_BAR; }
        if constexpr (!Epi::AFTER_DRAIN) { E(acc, cur, wr, wc, fr, fq); S.done(cur); }
        if (!has_next) break;
#pragma unroll
        for (int a = 0; a < 2; ++a)
#pragma unroll
            for (int b = 0; b < 2; ++b)
#pragma unroll
                for (int m = 0; m < 4; ++m)
#pragma unroll
                    for (int n = 0; n < 2; ++n) acc[a][b][m][n] = (f32x4){0.f, 0.f, 0.f, 0.f};
        cur = nxt; cA = nA; cB = nB; ++ui;
        if constexpr (ALIGN_EPI) { if (wr == 1) PG8_BAR; }
    }
    PG8_WAIT_V(0);
    if constexpr (!ALIGN_EPI) { if (wr == 0) PG8_BAR; }
    PG8_BAR;
    if constexpr (Epi::AFTER_DRAIN) { E.fused(acc, cur, wr, wc, fr, fq, lds, wid, lane); S.done(cur); }
#undef PG8_SA
#undef PG8_SB
#undef PG8_STAGE
#undef PG8_LDA
#undef PG8_LDB
#undef PG8_MMA
#undef PG8_WAIT_V
#undef PG8_WAIT_L
#undef PG8_BAR
#undef PG8_SCHED
}
}
namespace att {
typedef unsigned short bf16_t;
typedef short bf16x8 __attribute__((ext_vector_type(8)));
typedef short s16x4 __attribute__((ext_vector_type(4)));
typedef float f32x16 __attribute__((ext_vector_type(16)));
typedef float f32x4 __attribute__((ext_vector_type(4)));
typedef unsigned u32x4 __attribute__((ext_vector_type(4)));
constexpr int NW = 8, QBLK = 32, KVBLK = 64, QB = NW * QBLK;
constexpr int SHM_V = KVBLK * 128 * 2, SHM_K = KVBLK * 128 * 2, SHM_KR = KVBLK * 64 * 2;
constexpr int NVB = 3;
constexpr int ATT_WS_OFF = NVB * SHM_V + 2 * SHM_K + 2 * SHM_KR;
constexpr int ATT_LDS_BYTES = ATT_WS_OFF + NW * 64 * 4;
constexpr float THR = 8.f;
template <int MODE> struct Cfg;
template <> struct Cfg<0> { static constexpr int NQF = 12, NQT = 8, NQK = 8, NPV = 4, KS = 1536, VS = 1536, OS = 1024; static constexpr bool ROPE = true; };
template <> struct Cfg<1> { static constexpr int NQF = 4, NQT = 4, NQK = 4, NPV = 2, KS = 128, VS = 128, OS = 1024; static constexpr bool ROPE = false; };

#define KSWZ(row, colB) ((row) * 256 + ((colB) ^ (((row) & 7) << 4)))
#define KRSWZ(row, colB) ((row) * 128 + ((colB) ^ ((((row) >> 1) & 7) << 4)))
#define SBAR() __builtin_amdgcn_sched_barrier(0)
__device__ __forceinline__ int v_st(int k, int c) { const int kk = (k & ~0xC) | ((k & 4) << 1) | ((k & 8) >> 1); return ((kk >> 3) * 4 + (c >> 5)) * 512 + ((kk & 7) * 32 + (c & 31)) * 2; }
__device__ __forceinline__ int v_rd_base(int lane) { return ((lane & 3) << 3) | (((lane >> 2) & 3) << 6) | (((lane >> 4) & 1) << 5) | (((lane >> 5) & 1) << 8); }
constexpr int v_rd_off(int d0, int ks, int half) { return d0 * 512 + ks * 4096 + half * 2048; }
__device__ __forceinline__ int crow(int r, int hi) { return (r & 3) + 8 * (r >> 2) + 4 * hi; }
__device__ __forceinline__ unsigned cvtpk(float lo, float hi) {
    unsigned r; asm volatile("v_cvt_pk_bf16_f32 %0, %1, %2" : "=v"(r) : "v"(lo), "v"(hi)); return r;
}
__device__ __forceinline__ bf16x8 load8(const bf16_t* p) { return *reinterpret_cast<const bf16x8*>(p); }
__device__ __forceinline__ void mask_tile(f32x16& p0, f32x16& p1, int dq, unsigned W) {
    const float NEG = -__builtin_inff();
#pragma unroll
    for (int r = 0; r < 16; ++r) {
        const int c = (r & 3) + 8 * (r >> 2);
        if ((unsigned)(dq - c) >= W) p0[r] = NEG;
        if ((unsigned)(dq - c - 32) >= W) p1[r] = NEG;
    }
}
__device__ __forceinline__ void partialSM(f32x16& p0, f32x16& p1, float& m_reg, float& mn, float& alpha) {
    float pmax = p0[0]; for (int r = 1; r < 16; ++r) pmax = fmaxf(pmax, p0[r]); for (int r = 0; r < 16; ++r) pmax = fmaxf(pmax, p1[r]);
    { auto rr = __builtin_amdgcn_permlane32_swap(__float_as_uint(pmax), __float_as_uint(pmax), false, false);
      pmax = fmaxf(__uint_as_float(rr[0]), __uint_as_float(rr[1])); }
    constexpr float C2 = 1.4426950408889634f;
    if (__builtin_expect(__all((pmax - m_reg) <= THR), 1)) { mn = m_reg; alpha = 1.f; }
    else { mn = fmaxf(m_reg, pmax); alpha = __builtin_amdgcn_exp2f((m_reg - mn) * C2); m_reg = mn; }
    const float mnL = -mn * C2;
    for (int r = 0; r < 16; ++r) p0[r] = fmaf(p0[r], C2, mnL); for (int r = 0; r < 16; ++r) p1[r] = fmaf(p1[r], C2, mnL);
    for (int r = 0; r < 16; ++r) p0[r] = __builtin_amdgcn_exp2f(p0[r]);
}
__device__ __forceinline__ void finishSM(f32x16& p0, f32x16& p1, float alpha, float& l_reg, bf16x8& pa0, bf16x8& pa1, bf16x8& pa2, bf16x8& pa3) {
    for (int r = 0; r < 16; ++r) p1[r] = __builtin_amdgcn_exp2f(p1[r]);
    float ps = 0; for (int r = 0; r < 16; ++r) ps += p0[r]; for (int r = 0; r < 16; ++r) ps += p1[r];
    { auto rr = __builtin_amdgcn_permlane32_swap(__float_as_uint(ps), __float_as_uint(ps), false, false);
      ps = __uint_as_float(rr[0]) + __uint_as_float(rr[1]); }
    l_reg = l_reg * alpha + ps;
#define PK4(P, B_, OUT) do { unsigned a0 = cvtpk(P[B_+0], P[B_+1]), a1 = cvtpk(P[B_+2], P[B_+3]);                          \
        unsigned b0 = cvtpk(P[B_+4], P[B_+5]), b1 = cvtpk(P[B_+6], P[B_+7]);                                             \
        auto r0 = __builtin_amdgcn_permlane32_swap(a0, b0, false, false); auto r1 = __builtin_amdgcn_permlane32_swap(a1, b1, false, false); \
        u32x4 w = {r0[0], r1[0], r0[1], r1[1]}; OUT = *reinterpret_cast<bf16x8*>(&w); } while (0)
    PK4(p0, 0, pa0); PK4(p0, 8, pa1); PK4(p1, 0, pa2); PK4(p1, 8, pa3);
#undef PK4
}
template <int MODE, int KB>
__device__ __forceinline__ void qkt(f32x16& p0, f32x16& p1, const char* K_lds, const char* KR_lds, int r32, int hi, const bf16x8* qr) {
    typedef Cfg<MODE> C;
    p0 = f32x16{}; p1 = f32x16{};
    const char* kb[4];
#pragma unroll
    for (int dd = 0; dd < 4; ++dd) kb[dd] = K_lds + KB * SHM_K + KSWZ(r32, (dd * 16 + hi * 8) * 2);
#pragma unroll
    for (int d0 = 0; d0 < C::NQK; ++d0) { const char* a = kb[d0 & 3] + (d0 >> 2) * 128;
        bf16x8 b0 = *reinterpret_cast<const bf16x8*>(a);
        bf16x8 b1 = *reinterpret_cast<const bf16x8*>(a + 32 * 256);
        p0 = __builtin_amdgcn_mfma_f32_32x32x16_bf16(b0, qr[d0], p0, 0, 0, 0);
        p1 = __builtin_amdgcn_mfma_f32_32x32x16_bf16(b1, qr[d0], p1, 0, 0, 0); }
    if constexpr (C::ROPE) {
#pragma unroll
        for (int dd = 0; dd < 4; ++dd) { const char* a = KR_lds + KB * SHM_KR + KRSWZ(r32, (dd * 16 + hi * 8) * 2);
            bf16x8 b0 = *reinterpret_cast<const bf16x8*>(a);
            bf16x8 b1 = *reinterpret_cast<const bf16x8*>(a + 32 * 128);
            p0 = __builtin_amdgcn_mfma_f32_32x32x16_bf16(b0, qr[8 + dd], p0, 0, 0, 0);
            p1 = __builtin_amdgcn_mfma_f32_32x32x16_bf16(b1, qr[8 + dd], p1, 0, 0, 0); }
    }
}
template <int MODE, int VB>
__device__ __forceinline__ void pv_tile(f32x16* o, int vb0, bf16x8 pa0, bf16x8 pa1, bf16x8 pa2, bf16x8 pa3) {
#define TRRD(dst, off) asm volatile("ds_read_b64_tr_b16 %0, %1 offset:%2" : "=&v"(dst) : "v"(vb0), "i"(off) : "memory")
#define PV_D0(d0) do { s16x4 l0, l1, l2, l3, h0, h1, h2, h3; constexpr int b_ = VB * SHM_V + v_rd_off(d0, 0, 0);     \
        TRRD(l0, b_); TRRD(h0, b_ + 2048); TRRD(l1, b_ + 4096); TRRD(h1, b_ + 6144); TRRD(l2, b_ + 8192); TRRD(h2, b_ + 10240); TRRD(l3, b_ + 12288); TRRD(h3, b_ + 14336); \
        asm volatile("s_waitcnt lgkmcnt(0)" ::: "memory"); SBAR();             \
        o[d0] = __builtin_amdgcn_mfma_f32_32x32x16_bf16(pa0, (bf16x8){l0[0], l0[1], l0[2], l0[3], h0[0], h0[1], h0[2], h0[3]}, o[d0], 0, 0, 0);   \
        o[d0] = __builtin_amdgcn_mfma_f32_32x32x16_bf16(pa1, (bf16x8){l1[0], l1[1], l1[2], l1[3], h1[0], h1[1], h1[2], h1[3]}, o[d0], 0, 0, 0);   \
        o[d0] = __builtin_amdgcn_mfma_f32_32x32x16_bf16(pa2, (bf16x8){l2[0], l2[1], l2[2], l2[3], h2[0], h2[1], h2[2], h2[3]}, o[d0], 0, 0, 0);   \
        o[d0] = __builtin_amdgcn_mfma_f32_32x32x16_bf16(pa3, (bf16x8){l3[0], l3[1], l3[2], l3[3], h3[0], h3[1], h3[2], h3[3]}, o[d0], 0, 0, 0); } while (0)
    PV_D0(0); PV_D0(1);
    if constexpr (Cfg<MODE>::NPV == 4) { PV_D0(2); PV_D0(3); }
#undef PV_D0
#undef TRRD
}

struct BlockRef { const bf16_t* Q; const bf16_t* K; const bf16_t* V; const bf16_t* KR; bf16_t* O; int P0; int qs; int tok; int pad; };
__device__ __forceinline__ int swa_jlo(int P0, int W) { const int lowk = P0 - W + 1; return lowk > 0 ? lowk / KVBLK : 0; }
template <int MODE>
__device__ __forceinline__ void attn_run(const BlockRef& cur, const bf16x8* qr, int skv, int W, char* lds, const int tid) {
    typedef Cfg<MODE> C;
    const int wid = __builtin_amdgcn_readfirstlane(tid >> 6), lane = tid & 63, r32 = lane & 31, hi = lane >> 5;
    const bool grpB = wid >= 4;
    const int j_lo = swa_jlo(cur.P0, W);
    int j_hi = (cur.P0 + QB - 1) / KVBLK + 1; if (j_hi > skv / KVBLK) j_hi = skv / KVBLK;
    const int NT = j_hi - j_lo;
    const int qlo = cur.P0 + wid * QBLK, qm = qlo + r32 - 4 * hi;
    char* V_lds = lds; char* K_lds = lds + NVB * SHM_V; char* KR_lds = lds + NVB * SHM_V + 2 * SHM_K;
    float* ws = (float*)(lds + ATT_WS_OFF) + wid * 64; float* li_l = ws, * al_l = ws + 32;
    float m_reg = -1e30f, l_reg = 0; f32x16 o[4] = {};
    const int sr = tid >> 4, sc = (tid & 15) * 8, vst0 = v_st(sr, sc), vst1 = v_st(32 + sr, sc), kws = KSWZ(sr, sc * 2);
    const int krr = tid >> 3, krc = (tid & 7) * 8, krw = KRSWZ(krr, krc * 2);
    const int vb0 = (int)(uintptr_t)V_lds + v_rd_base(lane);
    const bf16_t* Kh = cur.K; const bf16_t* Vh = cur.V; const bf16_t* KRh = cur.KR;
    bf16x8 st_v0, st_v1, st_k0, st_k1, st_kr;
#define ROWK(p, k0, rr) ((p) + (size_t)((k0) + (rr)) * C::KS + sc)
#define ROWV(p, k0, rr) ((p) + (size_t)((k0) + (rr)) * C::VS + sc)
#define VMW() asm volatile("s_waitcnt vmcnt(0)" ::: "memory")
#define SLOAD_H(k0) do { st_v0 = load8(ROWV(Vh, k0, sr)); st_v1 = load8(ROWV(Vh, k0, 32 + sr)); st_k0 = load8(ROWK(Kh, k0, sr)); st_k1 = load8(ROWK(Kh, k0, 32 + sr)); \
                         if constexpr (C::ROPE) st_kr = load8(KRh + (size_t)((k0) + krr) * 64 + krc); } while (0)
#define SWRITE_H(kb, vb) do { *(bf16x8*)(V_lds + (vb) * SHM_V + vst0) = st_v0; *(bf16x8*)(V_lds + (vb) * SHM_V + vst1) = st_v1;                           \
                          *(bf16x8*)(K_lds + (kb) * SHM_K + kws) = st_k0; *(bf16x8*)(K_lds + (kb) * SHM_K + kws + 32 * 256) = st_k1;                 \
                          if constexpr (C::ROPE) *(bf16x8*)(KR_lds + (kb) * SHM_KR + krw) = st_kr; } while (0)
#define RESC(a) do { if (__any((a) < 1.f)) { if (hi == 0) al_l[r32] = (a); asm volatile("s_waitcnt lgkmcnt(0)" ::: "memory");              \
                     for (int d_ = 0; d_ < C::NPV; ++d_) for (int r = 0; r < 16; ++r) o[d_][r] *= al_l[crow(r, hi)]; } } while (0)
#define KBASE(t) ((j_lo + (t)) * KVBLK)
#define MASKT(P0_, P1_, t) do { const int kb_ = KBASE(t); if (kb_ + KVBLK - 1 > qlo || kb_ <= qlo + QBLK - 1 - W) mask_tile(P0_, P1_, qm - kb_, (unsigned)W); } while (0)
    f32x16 p0, p1; float mn, al; bf16x8 pa0 = {}, pa1 = {}, pa2 = {}, pa3 = {};
    SLOAD_H(KBASE(0)); VMW(); SWRITE_H(0, 0); SBAR();
    if (NT > 1) { SLOAD_H(KBASE(1)); SBAR(); }
    __syncthreads();
    int vcur = 0, vprev = 0;
    for (int t = 0; t < NT; ++t) {
        const int kb = t & 1; const int vnext = vcur == NVB - 1 ? 0 : vcur + 1;
        SBAR();
        if (grpB && t > 0) { pv_tile<MODE, 0>(o, vb0 + vprev * SHM_V, pa0, pa1, pa2, pa3); SBAR(); }
        qkt<MODE, 0>(p0, p1, K_lds + kb * SHM_K, KR_lds + kb * SHM_KR, r32, hi, qr); SBAR();
        MASKT(p0, p1, t); partialSM(p0, p1, m_reg, mn, al); RESC(al);
        finishSM(p0, p1, al, l_reg, pa0, pa1, pa2, pa3); SBAR();
        if (!grpB) { pv_tile<MODE, 0>(o, vb0 + vcur * SHM_V, pa0, pa1, pa2, pa3); SBAR(); }
        if (t + 1 < NT) { VMW(); SWRITE_H(kb ^ 1, vnext); SBAR(); if (t + 2 < NT) { SLOAD_H(KBASE(t + 2)); SBAR(); } }
        __syncthreads();
        vprev = vcur; vcur = vnext;
    }
    if (grpB) { SBAR(); pv_tile<MODE, 0>(o, vb0 + vprev * SHM_V, pa0, pa1, pa2, pa3); SBAR(); }
    if (hi == 0) li_l[r32] = l_reg; asm volatile("s_waitcnt lgkmcnt(0)" ::: "memory");
    float rli[16];
#pragma unroll
    for (int r = 0; r < 16; ++r) rli[r] = __builtin_amdgcn_rcpf(li_l[crow(r, hi)]);
    bf16_t* Ow = cur.O + (size_t)(wid * QBLK) * C::OS;
#pragma unroll
    for (int r = 0; r < 16; ++r) { const int orow = crow(r, hi);
#pragma unroll
        for (int d0 = 0; d0 < C::NPV; ++d0) { const float v = o[d0][r] * rli[r];
            const float vn = pg8::swz_xor<1>(v);
            if ((r32 & 1) == 0) *(unsigned*)(Ow + (size_t)orow * C::OS + d0 * 32 + r32) = cvtpk(v, vn); } }
    __syncthreads();
#undef RESC
#undef KBASE
#undef MASKT
#undef ROWK
#undef ROWV
#undef VMW
#undef SLOAD_H
#undef SWRITE_H
}
}
#ifndef MK_N_LAUNCHES
#define MK_N_LAUNCHES 1
#endif
#define LAS __attribute__((address_space(3)))
typedef unsigned short bf16;
typedef float f32x4 __attribute__((ext_vector_type(4)));
typedef unsigned v4u __attribute__((ext_vector_type(4)));
typedef unsigned v2u __attribute__((ext_vector_type(2)));
typedef short bf16x8 __attribute__((ext_vector_type(8)));
constexpr int NWAVES = 8;
constexpr int T = 65536, DM = 1024, FF = 2816, NBATCH = 8, SEQ = 8192;
constexpr float EPS = 1e-6f;
constexpr int N13 = 2 * FF;
constexpr int NCONV = 2560, NMLA = 768, NUQ = 1280, NKV1 = 512, NKV2 = 1536, NMEMKV = 2048, MEMROWS = 2048;
constexpr int PSTRIDE = 1792;
constexpr size_t MiB = 1u << 20;
constexpr size_t WS_W13 = 0;
constexpr size_t WS_W2 = WS_W13 + 88 * MiB;
constexpr size_t WS_WOUT = WS_W2 + 44 * MiB;
constexpr size_t WS_CONVIN = WS_WOUT + 8 * MiB;
constexpr size_t WS_MLAIN = WS_CONVIN + 10 * MiB;
constexpr size_t WS_WUQ = WS_MLAIN + 3 * MiB;
constexpr size_t WS_WKV1 = WS_WUQ + 2 * MiB;
constexpr size_t WS_WKV2 = WS_WKV1 + 1 * MiB;
constexpr size_t WS_WMEMKV = WS_WKV2 + 1 * MiB;
constexpr size_t WS_SSQ = WS_WMEMKV + 4 * MiB;
constexpr size_t WS_CSSQ = WS_SSQ + 4 * MiB;
constexpr size_t WS_MEMB = WS_CSSQ + 6 * MiB;
constexpr size_t WS_MEMSSQ = WS_MEMB + 4 * MiB;
constexpr size_t WS_MEMKVRAW = WS_MEMSSQ + 1 * MiB;
constexpr size_t WS_KMEM = WS_MEMKVRAW + 8 * MiB;
constexpr size_t WS_VMEM = WS_KMEM + 8 * MiB;
constexpr size_t WS_XB = WS_VMEM + 8 * MiB;
constexpr size_t WS_ACT = WS_XB + 128 * MiB;
constexpr size_t WS_MIX = WS_ACT + 352 * MiB;
constexpr size_t WS_KVB = WS_MIX + 128 * MiB;
constexpr size_t WS_KR = WS_KVB + 192 * MiB;
constexpr size_t WS_CTL = WS_KR + 8 * MiB;
constexpr size_t CTL_BYTES = 65536;
constexpr size_t WS_END = WS_CTL + 1 * MiB;
static_assert(WS_END <= 1024 * MiB, "d_ws map must fit 1 GiB");
constexpr size_t ACT_QRAW = 96 * MiB;
constexpr int MISC_OFF = 143360;
constexpr int LDS_BYTES = 147456;
static_assert(att::ATT_LDS_BYTES <= LDS_BYTES, "attention LDS");

__constant__ float INVF[32] = {1.000000000e+00f, 7.498942614e-01f, 5.623413324e-01f, 4.216965139e-01f, 3.162277639e-01f, 2.371373773e-01f, 1.778279394e-01f, 1.333521307e-01f, 1.000000015e-01f, 7.498941571e-02f, 5.623413250e-02f, 4.216965288e-02f, 3.162277490e-02f, 2.371373773e-02f, 1.778279431e-02f, 1.333521493e-02f, 9.999999776e-03f, 7.498941850e-03f, 5.623413250e-03f, 4.216964822e-03f, 3.162277630e-03f, 2.371373586e-03f, 1.778279431e-03f, 1.333521446e-03f, 1.000000047e-03f, 7.498942432e-04f, 5.623413017e-04f, 4.216965172e-04f, 3.162277571e-04f, 2.371373703e-04f, 1.778279402e-04f, 1.333521504e-04f};

#define LDS_WAIT() asm volatile("s_waitcnt lgkmcnt(0)" ::: "memory")
__device__ __forceinline__ unsigned f2bf(float f) { unsigned u = __builtin_bit_cast(unsigned, f); return (u + 0x7fffu + ((u >> 16) & 1u)) >> 16; }
__device__ __forceinline__ unsigned pk2(float lo, float hi) { return f2bf(lo) | (f2bf(hi) << 16); }
__device__ __forceinline__ float bf2f(unsigned short h) { return __builtin_bit_cast(float, (unsigned)h << 16); }
__device__ __forceinline__ float wave_sum(float v) {
    v += pg8::swz_xor<1>(v); v += pg8::swz_xor<2>(v); v += pg8::swz_xor<4>(v); v += pg8::swz_xor<8>(v); v += pg8::swz_xor<16>(v);
    return pg8::add_xor32(v);
}
__device__ __forceinline__ void rope_cs(int pos, int i, float& c, float& s) {
    const float ang = (float)pos * INVF[i];
    double t = (double)ang * 0.15915494309189535; t -= __builtin_rint(t);
    const float fr = (float)t; c = __builtin_amdgcn_cosf(fr); s = __builtin_amdgcn_sinf(fr);
}

struct Args { const void* in[25]; float* out; unsigned char* ws; int lo, hi; };

enum { MAP_PLAIN = 0, MAP_GATEUP = 1, MAP_CONVIN = 2 };
__device__ __forceinline__ int map_col(int mode, int n0, int Nsrc) {
    if (mode == MAP_GATEUP) { const int tile = n0 >> 8, q = n0 & 255; return (q < 128 ? 0 : FF) + tile * 128 + (q & 127); }
    if (mode == MAP_CONVIN) { const int tile = n0 >> 8, q = n0 & 255; if (tile < 6) return (q < 128 ? 768 : 1536) + tile * 128 + (q & 127); if (tile < 9) return (tile - 6) * 256 + q; return 2304 + q; }
    return n0 < Nsrc ? n0 : -1;
}
#ifndef WMANT
#define WMANT 7
#endif
__device__ __forceinline__ float rmant(float f) {
    unsigned u = __builtin_bit_cast(unsigned, f); u += 1u << (22 - WMANT); u &= ~((1u << (23 - WMANT)) - 1u); return __builtin_bit_cast(float, u);
}
__device__ __forceinline__ unsigned pk2h(float lo, float hi) { typedef _Float16 h2 __attribute__((ext_vector_type(2))); const h2 v = {(_Float16)lo, (_Float16)hi}; return __builtin_bit_cast(unsigned, v); }
__device__ __forceinline__ void prep_weight(const float* W, const float* g, int K, int Nsrc, bf16* WT, int Ndst, int mode, bool f16, LAS float* scr, int gw, int NGW, int lane) {
    const int nblk = Ndst / 64, nitems = (K / 64) * nblk; const int kr = lane >> 4, c4 = (lane & 15) * 4;
    for (int item = gw; item < nitems; item += NGW) {
        const int kb = item / nblk, nb = item % nblk, k0 = 64 * kb, n0 = 64 * nb; const int s0 = map_col(mode, n0, Nsrc);
        if (s0 >= 0) {
            f32x4 v[16];
#pragma unroll
            for (int i = 0; i < 16; ++i) v[i] = *(const f32x4*)(W + (size_t)(k0 + 4 * i + kr) * Nsrc + s0 + c4);
#pragma unroll
            for (int i = 0; i < 16; ++i) { const int kk = 4 * i + kr; const float gv = g ? g[k0 + kk] : 1.0f; LAS float* d = scr + kk * 65 + c4;
                d[0] = v[i].x * gv; d[1] = v[i].y * gv; d[2] = v[i].z * gv; d[3] = v[i].w * gv; }
        }
        LDS_WAIT(); asm volatile("" ::: "memory");
        const int c = lane & 7;
#pragma unroll
        for (int j = 0; j < 8; ++j) { const int n = (lane >> 3) + 8 * j; const LAS float* s = scr + (8 * c) * 65 + n;
            v4u o = {0u, 0u, 0u, 0u};
            if (s0 >= 0) { float e[8];
#pragma unroll
                for (int q = 0; q < 8; ++q) e[q] = rmant(s[q * 65]);
                if (f16) { o.x = pk2h(e[0], e[1]); o.y = pk2h(e[2], e[3]); o.z = pk2h(e[4], e[5]); o.w = pk2h(e[6], e[7]); }
                else { o.x = pk2(e[0], e[1]); o.y = pk2(e[2], e[3]); o.z = pk2(e[4], e[5]); o.w = pk2(e[6], e[7]); } }
            *(v4u*)(WT + (size_t)(n0 + n) * K + k0 + 8 * c) = o; }
        LDS_WAIT(); asm volatile("" ::: "memory");
    }
}
__device__ __forceinline__ void row_to_bf16(const float* xrow, bool f16, bf16* orow, float* ssq, int nslot, int lane) {
    const f32x4* xr = (const f32x4*)xrow + lane; f32x4 v[4]; float s = 0.f;
#pragma unroll
    for (int j = 0; j < 4; ++j) { v[j] = xr[64 * j]; s += (v[j].x * v[j].x + v[j].y * v[j].y) + (v[j].z * v[j].z + v[j].w * v[j].w); }
    s = wave_sum(s);
    v2u* o8 = (v2u*)orow + lane;
#pragma unroll
    for (int j = 0; j < 4; ++j) { v2u w; if (f16) { w.x = pk2h(v[j].x, v[j].y); w.y = pk2h(v[j].z, v[j].w); } else { w.x = pk2(v[j].x, v[j].y); w.y = pk2(v[j].z, v[j].w); } o8[64 * j] = w; }
    if (lane < nslot) ssq[lane] = lane == 0 ? s : 0.f;
}

__device__ __forceinline__ const void* argp(int i) {
    const char __attribute__((address_space(4)))* ka = (const char __attribute__((address_space(4)))*)__builtin_amdgcn_kernarg_segment_ptr();
    int off = i * 8; asm volatile("" : "+s"(off));
    return *(const void* const __attribute__((address_space(4)))*)(ka + off);
}
#define XB_TMO      128
#define XB_XCNT(j)  (256  + 64 * (j))
#define XB_XSUB(j)  (1280 + 64 * (j))
#define XB_XGEN(j)  (2304 + 64 * (j))
#define XB_TOP      3328
#define XB_TOPGEN   3392
#define XCD_BAR_WORDS 3456
#define XB_SPIN_CAP (1u << 18)
__device__ __forceinline__ unsigned xb_ld(unsigned* p)              { return __hip_atomic_load(p, __ATOMIC_RELAXED, __HIP_MEMORY_SCOPE_AGENT); }
__device__ __forceinline__ unsigned xb_add(unsigned* p, unsigned v) { return __hip_atomic_fetch_add(p, v, __ATOMIC_RELAXED, __HIP_MEMORY_SCOPE_AGENT); }
__device__ __forceinline__ unsigned xb_xcc_id() { return (unsigned)__builtin_amdgcn_s_getreg((3 << 11) | 20) & 0xFu; }
#define XB_SPIN(cond, bar) do { unsigned _sp = 0; while (cond) { __builtin_amdgcn_s_sleep(1); \
    if ((++_sp & 255u) == 0u) { if (xb_ld(&(bar)[XB_TMO])) break; if (_sp > XB_SPIN_CAP) { atomicAdd(&(bar)[XB_TMO], 1u); break; } } } } while (0)
struct XcdBarrier { unsigned* bar; unsigned x; volatile LAS unsigned* st; };
__device__ __forceinline__ XcdBarrier xcd_barrier_post(unsigned* bar, volatile LAS unsigned* st) {
    XcdBarrier b; b.bar = bar; b.x = xb_xcc_id(); b.st = st;
    if (threadIdx.x == 0) (void)xb_add(&bar[XB_XCNT(b.x)], 1u);
    return b;
}
__device__ __forceinline__ void xcd_barrier_complete(unsigned* bar, unsigned x, unsigned& nloc, unsigned& nx) {
    const unsigned G = gridDim.x * gridDim.y * gridDim.z;
    unsigned sum, cnt, mine, sp = 0u;
    for (;;) {
        sum = 0u; cnt = 0u; mine = 0u;
#pragma unroll
        for (unsigned j = 0; j < 16; ++j) { const unsigned c = xb_ld(&bar[XB_XCNT(j)]); sum += c; cnt += (c > 0u) ? 1u : 0u; mine = (j == x) ? c : mine; }
        if (sum == G) break;
        __builtin_amdgcn_s_sleep(1);
        if ((++sp & 255u) == 0u) { if (xb_ld(&bar[XB_TMO])) break; if (sp > XB_SPIN_CAP) { atomicAdd(&bar[XB_TMO], 1u); break; } }
    }
    nloc = mine > 0u ? mine : 1u; nx = cnt > 0u ? cnt : 1u;
}
__device__ __forceinline__ void xcd_barrier(const XcdBarrier& b, const int tid) {
    asm volatile("s_waitcnt vmcnt(0)" ::: "memory");
    __syncthreads();
    if (tid == 0) {
        unsigned* bar = b.bar;
        __builtin_amdgcn_s_waitcnt(0);
        unsigned nloc = b.st[0], nx = b.st[1];
        if (nloc == 0u) { xcd_barrier_complete(bar, b.x, nloc, nx); b.st[0] = nloc; b.st[1] = nx; }
        const unsigned old = xb_add(&bar[XB_XSUB(b.x)], 1u);
        const unsigned gen = old / nloc;
        if (old + 1u == (gen + 1u) * nloc) {
            __builtin_amdgcn_fence(__ATOMIC_RELEASE, "agent");
            asm volatile("s_waitcnt vmcnt(0)" ::: "memory");
            const unsigned og = xb_add(&bar[XB_TOP], 1u);
            const unsigned tg = og / nx;
            if (og + 1u == (tg + 1u) * nx) xb_add(&bar[XB_TOPGEN], 1u);
            else XB_SPIN(xb_ld(&bar[XB_TOPGEN]) == tg, bar);
            __builtin_amdgcn_fence(__ATOMIC_ACQUIRE, "agent");
            xb_add(&bar[XB_XGEN(b.x)], 1u);
            asm volatile("s_waitcnt vmcnt(0)" ::: "memory");
        } else {
            XB_SPIN(xb_ld(&bar[XB_XGEN(b.x)]) == gen, bar);
            __builtin_amdgcn_fence(__ATOMIC_ACQUIRE, "agent");
            asm volatile("s_waitcnt vmcnt(0)" ::: "memory");
        }
    }
    __syncthreads();
}
__global__ void __launch_bounds__(NWAVES * 64, 2) yoco_fwd(Args args) {
    extern __shared__ __attribute__((aligned(16))) unsigned char lds[];
    cg::grid_group grid = cg::this_grid();
    const int wave0 = __builtin_amdgcn_readfirstlane((int)threadIdx.x >> 6);
    const int G = gridDim.x, bx0 = blockIdx.x;
#define ARGP(i) argp(i)
#define x_in ((const float*)ARGP(0))
#define mem_in ((const float*)ARGP(1))
#define positions ((const int*)ARGP(2))
#define norm_g ((const float*)ARGP(3))
#define ffn_w13 ((const float*)ARGP(4))
#define ffn_w2 ((const float*)ARGP(5))
#define w_out ((const float*)ARGP(6))
#define mem_norm_g ((const float*)ARGP(7))
#define w_mem_kv ((const float*)ARGP(8))
#define g_mem_q ((const float*)ARGP(9))
#define g_mem_k ((const float*)ARGP(10))
#define conv_w_in ((const float*)ARGP(11))
#define conv_w ((const float*)ARGP(12))
#define mla_w_in ((const float*)ARGP(13))
#define g_q_lora ((const float*)ARGP(14))
#define w_uq ((const float*)ARGP(15))
#define g_q_nope ((const float*)ARGP(16))
#define g_q_rope ((const float*)ARGP(17))
#define kv_norm_g ((const float*)ARGP(18))
#define w_dkv ((const float*)ARGP(19))
#define g_ckv ((const float*)ARGP(20))
#define w_ukv ((const float*)ARGP(21))
#define w_kr ((const float*)ARGP(22))
#define g_k_nope ((const float*)ARGP(23))
#define g_k_rope ((const float*)ARGP(24))
#define X ((float*)ARGP(25))
#define WSB ((unsigned char*)ARGP(26))
#define W13T ((bf16*)(WSB + WS_W13))
#define W2T ((bf16*)(WSB + WS_W2))
#define WOUTT ((bf16*)(WSB + WS_WOUT))
#define CONVINT ((bf16*)(WSB + WS_CONVIN))
#define MLAINT ((bf16*)(WSB + WS_MLAIN))
#define WUQT ((bf16*)(WSB + WS_WUQ))
#define WKV1T ((bf16*)(WSB + WS_WKV1))
#define WKV2T ((bf16*)(WSB + WS_WKV2))
#define WMEMKVT ((bf16*)(WSB + WS_WMEMKV))
#define SSQ ((float*)(WSB + WS_SSQ))
#define CSSQ ((float*)(WSB + WS_CSSQ))
#define MEMB ((bf16*)(WSB + WS_MEMB))
#define MEMSSQ ((float*)(WSB + WS_MEMSSQ))
#define MEMKVRAW ((bf16*)(WSB + WS_MEMKVRAW))
#define KMEM ((bf16*)(WSB + WS_KMEM))
#define VMEM ((bf16*)(WSB + WS_VMEM))
#define XB ((bf16*)(WSB + WS_XB))
#define ACT ((bf16*)(WSB + WS_ACT))
#define MIX ((bf16*)(WSB + WS_MIX))
#define KVB ((bf16*)(WSB + WS_KVB))
#define KRB ((bf16*)(WSB + WS_KR))
#define PCONV ACT
#define CQRAW ACT
#define QRAW ((bf16*)(WSB + WS_ACT + ACT_QRAW))
#define CKVRAW ACT
    LAS unsigned char* ldsl = (LAS unsigned char*)lds;

    bool probe_done = false; (void)probe_done;
    volatile LAS unsigned* MISC = (volatile LAS unsigned*)(ldsl + MISC_OFF);
    if (threadIdx.x < 4) MISC[threadIdx.x] = 0u;
    __syncthreads();
    XcdBarrier xbar; xbar.bar = nullptr; xbar.x = 0; xbar.st = MISC;
    if (args.hi - args.lo > 1) xbar = xcd_barrier_post((unsigned*)(WSB + WS_CTL), MISC);
    for (int ph = args.lo; ph < args.hi; ++ph) {
        int wave = wave0, bx = bx0; asm volatile("" : "+s"(wave)); asm volatile("" : "+s"(bx));
        int lane = (int)__builtin_amdgcn_mbcnt_hi(~0u, __builtin_amdgcn_mbcnt_lo(~0u, 0u)); asm volatile("" : "+v"(lane)); const int tid = wave * 64 + lane; const int vcu = (G % 8 == 0) ? (bx % 8) * (G / 8) + bx / 8 : bx; const int gw = vcu * NWAVES + wave, NGW = G * NWAVES;
        int type, layer = 0, sub = 0;
        enum { PH_PREP, PH_MEMKV, PH_GLUE_MEM, PH_G1, PH_G2, PH_CONVIN, PH_CONVMIX, PH_WOUT, PH_KV1, PH_KV2, PH_GLUE_KV, PH_MLAIN, PH_UQ, PH_MLAATT };
        if (ph < 3) type = ph == 0 ? PH_PREP : (ph == 1 ? PH_MEMKV : PH_GLUE_MEM);
        else if (ph < 17) { const int q = ph - 3; layer = q / 7; const int st = q % 7;
            type = st == 0 ? PH_G1 : st == 1 ? PH_G2 : st == 2 ? PH_CONVIN : st == 3 ? PH_CONVMIX : st == 4 ? PH_WOUT : st == 5 ? PH_G1 : PH_G2; sub = st >= 5 ? 1 : 0; }
        else if (ph < 20) type = ph == 17 ? PH_KV1 : (ph == 18 ? PH_KV2 : PH_GLUE_KV);
        else { const int q = ph - 20; layer = 2 + q / 8; const int st = q % 8;
            type = st == 0 ? PH_G1 : st == 1 ? PH_G2 : st == 2 ? PH_MLAIN : st == 3 ? PH_UQ : st == 4 ? PH_MLAATT : st == 5 ? PH_WOUT : st == 6 ? PH_G1 : PH_G2; sub = st >= 6 ? 1 : 0; }

        if (type == PH_PREP) {
            LAS float* scr = (LAS float*)(ldsl + wave * 16640);
            for (int job = 0; job < 33; ++job) {
                const float* W; const float* g = nullptr; int K, Nsrc, Ndst, mode = MAP_PLAIN; bf16* dst;
                if (job < 8) { const int l = job >> 1, s = job & 1; W = ffn_w13 + (size_t)job * DM * N13; g = norm_g + (size_t)(l * 3 + (s ? 2 : 0)) * DM; K = DM; Nsrc = N13; Ndst = N13; mode = MAP_GATEUP; dst = W13T + (size_t)job * N13 * DM; }
                else if (job < 16) { const int j = job - 8; W = ffn_w2 + (size_t)j * FF * DM; K = FF; Nsrc = DM; Ndst = DM; dst = W2T + (size_t)j * DM * FF; }
                else if (job < 20) { const int l = job - 16; W = w_out + (size_t)l * DM * DM; K = DM; Nsrc = DM; Ndst = DM; dst = WOUTT + (size_t)l * DM * DM; }
                else if (job < 22) { const int l = job - 20; W = conv_w_in + (size_t)l * DM * NCONV; g = norm_g + (size_t)(l * 3 + 1) * DM; K = DM; Nsrc = NCONV; Ndst = NCONV; mode = MAP_CONVIN; dst = CONVINT + (size_t)l * NCONV * DM; }
                else if (job < 24) { const int j = job - 22; W = mla_w_in + (size_t)j * DM * 640; g = norm_g + (size_t)((2 + j) * 3 + 1) * DM; K = DM; Nsrc = 640; Ndst = NMLA; dst = MLAINT + (size_t)j * NMLA * DM; }
                else if (job < 26) { const int j = job - 24; W = w_uq + (size_t)j * 384 * 1152; g = g_q_lora + j * 384; K = 384; Nsrc = 1152; Ndst = NUQ; dst = WUQT + (size_t)j * (MiB / 2); }
                else if (job == 26) { W = w_dkv; g = kv_norm_g; K = DM; Nsrc = 256; Ndst = 256; dst = WKV1T; }
                else if (job == 27) { W = w_kr; g = kv_norm_g; K = DM; Nsrc = 64; Ndst = 256; dst = WKV1T + (size_t)256 * DM; }
                else if (job == 28) { W = w_ukv; g = g_ckv; K = 256; Nsrc = NKV2; Ndst = NKV2; dst = WKV2T; }
                else { const int l = job - 29; W = w_mem_kv + (size_t)l * DM * 512; g = mem_norm_g + l * DM; K = DM; Nsrc = 512; Ndst = 512; dst = WMEMKVT + (size_t)l * 512 * DM; }
                const bool f16w = job < 8 || (job >= 20 && job < 24) || job == 26 || job == 27;
                prep_weight(W, g, K, Nsrc, dst, Ndst, mode, f16w, scr, gw, NGW, lane);
            }
            for (int m = gw; m < T; m += NGW) row_to_bf16(x_in + (size_t)m * DM, true, XB + (size_t)m * DM, SSQ + (size_t)m * 16, 16, lane);
            for (int m = gw; m < MEMROWS; m += NGW) row_to_bf16(mem_in + (size_t)m * DM, false, MEMB + (size_t)m * DM, MEMSSQ + (size_t)m * 4, 4, lane);
        }
        else if (type == PH_GLUE_MEM) {
            for (int it = gw; it < 4 * MEMROWS * 4; it += NGW) { const int h = it & 3, row = (it >> 2) % MEMROWS, l = it / (4 * MEMROWS); const int b = row >> 8, m = row & 255;
                const float kv = bf2f(MEMKVRAW[(size_t)row * NMEMKV + l * 512 + h * 64 + lane]); const unsigned short vv = MEMKVRAW[(size_t)row * NMEMKV + l * 512 + 256 + h * 64 + lane];
                const float ss = wave_sum(kv * kv); const float kn = kv * __builtin_amdgcn_rsqf(ss * (1.0f / 64.0f) + EPS) * g_mem_k[l * 64 + lane];
                const size_t o = ((((size_t)l * NBATCH + b) * 4 + h) * 256 + m) * 128;
                KMEM[o + lane] = (bf16)f2bf(kn); KMEM[o + 64 + lane] = 0; VMEM[o + lane] = vv; VMEM[o + 64 + lane] = 0; }
        }
        else if (type == PH_GLUE_KV) {
            const int j16 = lane & 15;
            const f32x4 gn0 = *(const f32x4*)(g_k_nope + 8 * j16), gn1 = *(const f32x4*)(g_k_nope + 8 * j16 + 4), gr = *(const f32x4*)(g_k_rope + 4 * j16);
            for (int t4 = gw; t4 < T / 4; t4 += NGW) {
                const int t = t4 * 4 + (lane >> 4); const int pos = positions[t];
                bf16* kvp = KVB + (size_t)t * NKV2 + 8 * j16;
                bf16x8 kv[6];
#pragma unroll
                for (int h = 0; h < 6; ++h) kv[h] = *(const bf16x8*)(kvp + h * 256);
                const v2u krw = *(const v2u*)(CKVRAW + (size_t)t * NKV1 + 256 + 4 * j16);
#pragma unroll
                for (int h = 0; h < 6; ++h) { float f[8]; float ss = 0.f;
#pragma unroll
                    for (int e = 0; e < 8; ++e) { f[e] = bf2f((unsigned short)kv[h][e]); ss += f[e] * f[e]; }
                    ss += pg8::swz_xor<1>(ss); ss += pg8::swz_xor<2>(ss); ss += pg8::swz_xor<4>(ss); ss += pg8::swz_xor<8>(ss);
                    const float rs = __builtin_amdgcn_rsqf(ss * (1.0f / 128.0f) + EPS);
                    v4u w; w.x = pk2(f[0] * rs * gn0[0], f[1] * rs * gn0[1]); w.y = pk2(f[2] * rs * gn0[2], f[3] * rs * gn0[3]); w.z = pk2(f[4] * rs * gn1[0], f[5] * rs * gn1[1]); w.w = pk2(f[6] * rs * gn1[2], f[7] * rs * gn1[3]);
                    *(v4u*)(kvp + h * 256) = w; }
                { float x[4] = {pg8::bf_lo(krw.x), pg8::bf_hi(krw.x), pg8::bf_lo(krw.y), pg8::bf_hi(krw.y)};
                  float ss = (x[0] * x[0] + x[1] * x[1]) + (x[2] * x[2] + x[3] * x[3]);
                  ss += pg8::swz_xor<1>(ss); ss += pg8::swz_xor<2>(ss); ss += pg8::swz_xor<4>(ss); ss += pg8::swz_xor<8>(ss);
                  const float rs = __builtin_amdgcn_rsqf(ss * (1.0f / 64.0f) + EPS); float y[4];
#pragma unroll
                  for (int e = 0; e < 4; ++e) { const float mine = x[e] * rs * gr[e], other = pg8::swz_xor<8>(mine); float c, sn; rope_cs(pos, 4 * (j16 & 7) + e, c, sn);
                      y[e] = j16 < 8 ? mine * c - other * sn : mine * c + other * sn; }
                  v2u w; w.x = pk2(y[0], y[1]); w.y = pk2(y[2], y[3]); *(v2u*)(KRB + (size_t)t * 64 + 4 * j16) = w; }
            }
        }
#ifndef NO_GEMM
        else if (type == PH_G1) {
            pg8::Gemm g{XB, W13T + (size_t)(layer * 2 + sub) * N13 * DM, T, N13, DM, DM}; pg8::StaticOrder S; S.init(T, N13, G, bx);
            if (lane == 0) ((LAS int*)(ldsl + 131072 + 4096))[wave] = -1;
            LDS_WAIT();
            pg8::EpiSwiglu E{ACT, FF, SSQ, ldsl};
#ifndef NO_G1
            pg8::gemm_phase<pg8::EpiSwiglu, pg8::StaticOrder, true, true, true>(ldsl, g, S, E, tid);
#endif
        }
        else if (type == PH_G2 || type == PH_WOUT) {
            const bool isw = type == PH_WOUT;
            pg8::Gemm g{isw ? MIX : ACT, isw ? WOUTT + (size_t)layer * DM * DM : W2T + (size_t)(layer * 2 + sub) * DM * FF, T, DM, isw ? DM : FF, isw ? DM : FF}; pg8::StaticOrder S; S.init(T, DM, G, bx);
            float alpha_ = isw ? 1.0f : 0.5f;
#ifdef PROBE_TYPE
            if (type == PROBE_TYPE) alpha_ *= 0.5f;
#endif
            pg8::EpiResid E{ph == 35 ? X : nullptr, (_Float16*)XB, SSQ, alpha_};
#ifndef NO_G2
            pg8::gemm_phase<pg8::EpiResid, pg8::StaticOrder, true, true>(ldsl, g, S, E, tid);
#endif
        }
        else if (type == PH_MEMKV || type == PH_CONVIN || type == PH_MLAIN || type == PH_UQ || type == PH_KV1 || type == PH_KV2) {
            pg8::Gemm g; pg8::EpiGen E; int M_ = T;
            if (type == PH_MEMKV) { g = pg8::Gemm{MEMB, WMEMKVT, MEMROWS, NMEMKV, DM, DM}; M_ = MEMROWS; E = pg8::EpiGen{MEMKVRAW, NMEMKV, MEMSSQ, 4, 4, 1.0f / 1024.0f, 0, 0, nullptr, 0}; }
            else if (type == PH_CONVIN) { g = pg8::Gemm{XB, CONVINT + (size_t)layer * NCONV * DM, T, NCONV, DM, DM}; E = pg8::EpiGen{PCONV, PSTRIDE, SSQ, 16, 16, 1.0f / 1024.0f, 6, 768, nullptr, 0}; }
            else if (type == PH_MLAIN) { g = pg8::Gemm{XB, MLAINT + (size_t)(layer - 2) * NMLA * DM, T, NMLA, DM, DM}; E = pg8::EpiGen{CQRAW, NMLA, SSQ, 16, 16, 1.0f / 1024.0f, 0, 0, CSSQ, 24}; }
            else if (type == PH_UQ) { g = pg8::Gemm{CQRAW, WUQT + (size_t)(layer - 2) * (MiB / 2), T, NUQ, 384, NMLA}; E = pg8::EpiGen{QRAW, NUQ, CSSQ, 24, 12, 1.0f / 384.0f, 0, 0, nullptr, 0}; }
            else if (type == PH_KV1) { g = pg8::Gemm{XB, WKV1T, T, NKV1, DM, DM}; E = pg8::EpiGen{CKVRAW, NKV1, SSQ, 16, 16, 1.0f / 1024.0f, 0, 0, CSSQ, 16}; }
            else { g = pg8::Gemm{CKVRAW, WKV2T, T, NKV2, 256, NKV1}; E = pg8::EpiGen{KVB, NKV2, CSSQ, 16, 8, 1.0f / 256.0f, 0, 0, nullptr, 0}; }
            pg8::StaticOrder S; S.init(M_, g.N, G, bx);
#ifndef NO_GEN
            if (type == PH_CONVIN || type == PH_MLAIN || type == PH_KV1) pg8::gemm_phase<pg8::EpiGen, pg8::StaticOrder, true, true, true>(ldsl, g, S, E, tid);
            else pg8::gemm_phase<pg8::EpiGen, pg8::StaticOrder, true, true, false>(ldsl, g, S, E, tid);
#endif
        }
#endif
        else if (type == PH_CONVMIX || type == PH_MLAATT) {
            const int W = 1 << 20;
            if (type == PH_CONVMIX) {
                const float* cw = conv_w + (size_t)layer * 3 * 768;
                for (int idx = bx * (NWAVES * 64) + tid; idx < T * 96; idx += G * NWAVES * 64) { const int t = idx / 96, c8 = (idx % 96) * 8, s = t & (SEQ - 1);
                    const bf16* up = PCONV + (size_t)t * PSTRIDE + c8; const bf16x8 u0 = *(const bf16x8*)up; const bf16x8 gb = *(const bf16x8*)(up + 768);
                    bf16x8 u1 = {0, 0, 0, 0, 0, 0, 0, 0}, u2 = {0, 0, 0, 0, 0, 0, 0, 0};
                    if (s >= 1) u1 = *(const bf16x8*)(up - PSTRIDE); if (s >= 2) u2 = *(const bf16x8*)(up - 2 * PSTRIDE);
                    float y[8];
#pragma unroll
                    for (int j = 0; j < 8; ++j) { const float acc = cw[c8 + j] * bf2f((unsigned short)u2[j]) + cw[768 + c8 + j] * bf2f((unsigned short)u1[j]) + cw[1536 + c8 + j] * bf2f((unsigned short)u0[j]);
                        y[j] = bf2f((unsigned short)gb[j]) * acc; }
                    v4u o; o.x = pk2(y[0], y[1]); o.y = pk2(y[2], y[3]); o.z = pk2(y[4], y[5]); o.w = pk2(y[6], y[7]);
                    *(v4u*)(MIX + (size_t)t * DM + c8) = o; }
            } else {
#ifndef NO_MLA
                const int j = layer - 2; const float* gqn = g_q_nope + j * 128; const float* gqr = g_q_rope + j * 64;
                for (int L = vcu; L < 768; L += G)
                    for (int pass = 0; pass < 2; ++pass) {
                        att::BlockRef cur;
                        { const int bh_ = L >> 4, x_ = L & 15, b_ = bh_ / 6, h_ = bh_ % 6, qb_ = pass ? 31 - x_ : x_; const size_t t0_ = (size_t)b_ * SEQ + (size_t)qb_ * 256;
                          cur.Q = QRAW + t0_ * NUQ + h_ * 192; cur.K = KVB + (size_t)b_ * SEQ * NKV2 + h_ * 256; cur.V = cur.K + 128; cur.KR = KRB + (size_t)b_ * SEQ * 64;
                          cur.O = MIX + t0_ * DM + h_ * 128; cur.P0 = qb_ * 256; cur.qs = NUQ; cur.tok = (int)t0_; cur.pad = 0; }
                        bf16x8 qr[12];
                        const int r32 = lane & 31, hi = lane >> 5; const int pos = positions[cur.tok + wave * 32 + r32];
#pragma unroll
                        for (int d0 = 0; d0 < 12; ++d0) qr[d0] = att::load8(cur.Q + (size_t)(wave * 32 + r32) * NUQ + d0 * 16 + hi * 8);
                        { float ss = 0.f;
#pragma unroll
                          for (int d0 = 0; d0 < 8; ++d0)
#pragma unroll
                              for (int e = 0; e < 8; ++e) { const float v = bf2f((unsigned short)qr[d0][e]); ss += v * v; }
                          ss = pg8::add_xor32(ss); const float rn = __builtin_amdgcn_rsqf(ss * (1.0f / 128.0f) + EPS) * 0.07216878364870322f;
#pragma unroll
                          for (int d0 = 0; d0 < 8; ++d0) { const f32x4 g0 = *(const f32x4*)(gqn + d0 * 16 + hi * 8), g1 = *(const f32x4*)(gqn + d0 * 16 + hi * 8 + 4); v4u w;
                              w.x = pk2(bf2f((unsigned short)qr[d0][0]) * rn * g0[0], bf2f((unsigned short)qr[d0][1]) * rn * g0[1]); w.y = pk2(bf2f((unsigned short)qr[d0][2]) * rn * g0[2], bf2f((unsigned short)qr[d0][3]) * rn * g0[3]);
                              w.z = pk2(bf2f((unsigned short)qr[d0][4]) * rn * g1[0], bf2f((unsigned short)qr[d0][5]) * rn * g1[1]); w.w = pk2(bf2f((unsigned short)qr[d0][6]) * rn * g1[2], bf2f((unsigned short)qr[d0][7]) * rn * g1[3]);
                              qr[d0] = *reinterpret_cast<bf16x8*>(&w); __builtin_amdgcn_sched_barrier(0); }
                          float s2 = 0.f;
#pragma unroll
                          for (int d0 = 8; d0 < 12; ++d0)
#pragma unroll
                              for (int e = 0; e < 8; ++e) { const float v = bf2f((unsigned short)qr[d0][e]); s2 += v * v; }
                          s2 = pg8::add_xor32(s2); const float rr = __builtin_amdgcn_rsqf(s2 * (1.0f / 64.0f) + EPS) * 0.07216878364870322f;
#pragma unroll
                          for (int d0 = 0; d0 < 2; ++d0) { float y1[8], y2[8];
#pragma unroll
                              for (int e = 0; e < 8; ++e) { const int i = d0 * 16 + hi * 8 + e; const float a = bf2f((unsigned short)qr[8 + d0][e]) * rr * gqr[i], b2 = bf2f((unsigned short)qr[10 + d0][e]) * rr * gqr[32 + i];
                                  float c, s; rope_cs(pos, i, c, s); y1[e] = a * c - b2 * s; y2[e] = b2 * c + a * s; __builtin_amdgcn_sched_barrier(0); }
                              v4u w1, w2; w1.x = pk2(y1[0], y1[1]); w1.y = pk2(y1[2], y1[3]); w1.z = pk2(y1[4], y1[5]); w1.w = pk2(y1[6], y1[7]);
                              w2.x = pk2(y2[0], y2[1]); w2.y = pk2(y2[2], y2[3]); w2.z = pk2(y2[4], y2[5]); w2.w = pk2(y2[6], y2[7]);
                              qr[8 + d0] = *reinterpret_cast<bf16x8*>(&w1); qr[10 + d0] = *reinterpret_cast<bf16x8*>(&w2); } }
                        att::attn_run<0>(cur, qr, SEQ, W, (char*)lds, tid);
                    }
#endif
            }
#ifndef NO_MEM
            {
                const bf16* QM = type == PH_CONVMIX ? PCONV + 1536 : CQRAW + 384; const int qs = type == PH_CONVMIX ? PSTRIDE : NMLA;
                const float* gq = g_mem_q + layer * 64;
                for (int L = vcu; L < 1024; L += G) {
                    att::BlockRef cur;
                    { const int tt_ = L >> 2, h_ = L & 3, b_ = tt_ >> 5; const size_t t0_ = (size_t)tt_ * 256; const size_t kvo_ = (((size_t)layer * NBATCH + b_) * 4 + h_) * 256 * 128;
                      cur.Q = QM + t0_ * qs + h_ * 64; cur.K = KMEM + kvo_; cur.V = VMEM + kvo_; cur.KR = nullptr; cur.O = MIX + t0_ * DM + 768 + h_ * 64; cur.P0 = 256; cur.qs = qs; cur.tok = (int)t0_; cur.pad = 0; }
                    bf16x8 qr[4]; const int r32 = lane & 31, hi = lane >> 5;
#pragma unroll
                    for (int d0 = 0; d0 < 4; ++d0) qr[d0] = att::load8(cur.Q + (size_t)(wave * 32 + r32) * qs + d0 * 16 + hi * 8);
                    { float ss = 0.f;
#pragma unroll
                      for (int d0 = 0; d0 < 4; ++d0)
#pragma unroll
                          for (int e = 0; e < 8; ++e) { const float v = bf2f((unsigned short)qr[d0][e]); ss += v * v; }
                      ss = pg8::add_xor32(ss); const float rn = __builtin_amdgcn_rsqf(ss * (1.0f / 64.0f) + EPS) * 0.125f;
#pragma unroll
                      for (int d0 = 0; d0 < 4; ++d0) { const f32x4 g0 = *(const f32x4*)(gq + d0 * 16 + hi * 8), g1 = *(const f32x4*)(gq + d0 * 16 + hi * 8 + 4); v4u w;
                          w.x = pk2(bf2f((unsigned short)qr[d0][0]) * rn * g0[0], bf2f((unsigned short)qr[d0][1]) * rn * g0[1]); w.y = pk2(bf2f((unsigned short)qr[d0][2]) * rn * g0[2], bf2f((unsigned short)qr[d0][3]) * rn * g0[3]);
                          w.z = pk2(bf2f((unsigned short)qr[d0][4]) * rn * g1[0], bf2f((unsigned short)qr[d0][5]) * rn * g1[1]); w.w = pk2(bf2f((unsigned short)qr[d0][6]) * rn * g1[2], bf2f((unsigned short)qr[d0][7]) * rn * g1[3]);
                          qr[d0] = *reinterpret_cast<bf16x8*>(&w); } }
                    att::attn_run<1>(cur, qr, 256, W, (char*)lds, tid);
                }
            }
#endif
        }
        bool again = false;
#ifdef PROBE_TYPE
        if (type == PROBE_TYPE && !probe_done) { probe_done = true; again = true; } else probe_done = false;
#endif
        if (again || ph + 1 < args.hi) { if (ph == 0 && !again) grid.sync(); else xcd_barrier(xbar, tid); }
#ifdef PROBE_SYNC
        if (again || ph + 1 < args.hi) xcd_barrier(xbar, tid);
#endif
        if (again) --ph;
    }
}

extern "C" void kernel_launch(void* const* d_in, const int* in_sizes, int n_in, void* d_out, int out_size, void* d_ws, size_t ws_size, hipStream_t stream) {
    static int grid = 0;
    constexpr int NPHASE = 36;
    if (grid == 0) {
        if (n_in != 25 || in_sizes[0] != T * DM || out_size != T * DM || ws_size < WS_END) { fprintf(stderr, "kernel_launch: unexpected shapes (n_in %d, in0 %d, out %d, ws %zu, need %zu)\n", n_in, n_in > 0 ? in_sizes[0] : -1, out_size, ws_size, (size_t)WS_END); grid = -1; return; }
        int dev = 0, cus = 0, per_cu = 0;
        if (hipGetDevice(&dev) != hipSuccess || hipDeviceGetAttribute(&cus, hipDeviceAttributeMultiprocessorCount, dev) != hipSuccess) { grid = -1; return; }
        if (hipFuncSetAttribute((const void*)yoco_fwd, hipFuncAttributeMaxDynamicSharedMemorySize, LDS_BYTES) != hipSuccess) { fprintf(stderr, "kernel_launch: hipFuncSetAttribute failed\n"); grid = -1; return; }
        if (hipOccupancyMaxActiveBlocksPerMultiprocessor(&per_cu, (const void*)yoco_fwd, NWAVES * 64, LDS_BYTES) != hipSuccess || per_cu < 1) { fprintf(stderr, "kernel_launch: occupancy query says %d\n", per_cu); per_cu = 1; }
        (void)hipGetLastError();
        grid = cus;
    }
    if (grid < 0) return;
    Args a{};
    for (int i = 0; i < 25; ++i) a.in[i] = d_in[i];
    a.out = (float*)d_out; a.ws = (unsigned char*)d_ws;
#if MK_N_LAUNCHES == 1
    if (hipMemsetAsync((char*)d_ws + WS_CTL, 0, CTL_BYTES, stream) != hipSuccess) { fprintf(stderr, "kernel_launch: memset of the barrier words failed\n"); return; }
    a.lo = 0; a.hi = NPHASE;
    void* kargs[] = {&a};
    hipError_t e = hipLaunchCooperativeKernel((const void*)yoco_fwd, dim3(grid), dim3(NWAVES * 64), kargs, LDS_BYTES, stream);
    if (e != hipSuccess) fprintf(stderr, "kernel_launch: cooperative launch failed: %s (grid %d)\n", hipGetErrorString(e), grid);
#else
    for (int p = 0; p < NPHASE; ++p) { a.lo = p; a.hi = p + 1; hipLaunchKernelGGL(yoco_fwd, dim3(grid), dim3(NWAVES * 64), LDS_BYTES, stream, a); }
#endif
}
```

```cpp
#include <hip/hip_runtime.h>
#include <hip/hip_cooperative_groups.h>
#include <cstdio>
#include <cstdint>
namespace cg = cooperative_groups;
namespace pg8 {
#define PG8_LAS __attribute__((address_space(3)))
typedef unsigned short bf16_t;
typedef short bf16x8 __attribute__((ext_vector_type(8)));
typedef float f32x4 __attribute__((ext_vector_type(4)));
typedef unsigned u32x4 __attribute__((ext_vector_type(4)));
constexpr int BM = 256, BK = 64, HALF = 128, HTB = HALF * BK * 2  , STAGE_BYTES = 8 * HTB, NXCD = 8, WGM = 8;

__host__ __device__ __forceinline__ int lds_byte(int r, int c) { const int st = (r >> 4) * 2 + (c >> 5), rr = r & 15, cc = c & 31, ob = rr * 64 + cc * 2; return st * 1024 + (ob ^ (((ob >> 9) & 1) << 5)); }
__host__ __device__ __forceinline__ void stage_rc(int b, int& R, int& C) { const int st = b / 1024, sb = b % 1024, swz = sb ^ (((sb >> 9) & 1) << 5); R = (st >> 1) * 16 + swz / 64; C = (st & 1) * 32 + (swz % 64) / 2; }
__host__ __device__ __forceinline__ int perm32(int rho) { const int n = rho >> 4, i = rho & 15; return 8 * (i >> 2) + 4 * n + (i & 3); }

struct Unit { int pm, pn; };
struct Gemm { const bf16_t* A; const bf16_t* Bt; int M, N, K, lda; };

struct StaticOrder {
    int nM, nN, nwg, G, c;
    __host__ __device__ void init(int M, int N, int G_, int c_) { nM = M / BM; nN = N / BM; nwg = nM * nN; G = G_; c = c_; }
    __host__ __device__ bool next(int i, Unit& u) const {
        const long L = (long)i * G + c; if (L >= nwg) return false;
        int wgid = (int)L; { const int q = nwg / NXCD, r = nwg % NXCD, xcd = wgid % NXCD, off = wgid / NXCD; wgid = (xcd < r ? xcd * (q + 1) : r * (q + 1) + (xcd - r) * q) + off; }
        const int nig = WGM * nN, gid = wgid / nig, fm = gid * WGM, gsz = (nM - fm) < WGM ? (nM - fm) : WGM;
        u.pm = fm + ((wgid % nig) % gsz); u.pn = (wgid % nig) / gsz; return true;
    }
    __device__ __forceinline__ void a_ready(const Unit&) const {}
    __device__ __forceinline__ void done(const Unit&) const {}
};

__device__ __forceinline__ unsigned cvt_pk_bf16(float lo, float hi) { unsigned r; asm volatile("v_cvt_pk_bf16_f32 %0, %1, %2" : "=v"(r) : "v"(lo), "v"(hi)); return r; }
typedef float f32x2 __attribute__((ext_vector_type(2)));
template <int XM> __device__ __forceinline__ float swz_xor(float v) { return __builtin_bit_cast(float, __builtin_amdgcn_ds_swizzle(__builtin_bit_cast(int, v), (XM << 10) | 0x1f)); }
__device__ __forceinline__ float add_xor32(float v) {
    auto r = __builtin_amdgcn_permlane32_swap(__float_as_uint(v), __float_as_uint(v), false, false); const unsigned r0 = r[0], r1 = r[1]; return __uint_as_float(r0) + __uint_as_float(r1); }
__device__ __forceinline__ float add_xor16_32(float s) { s += swz_xor<16>(s); return add_xor32(s); }
__device__ __forceinline__ float row_rs(const float* ssq, int stride, int nslots, float inv_n, int row, int fq) {
    const f32x4* p = (const f32x4*)(ssq + (size_t)row * stride); float s = 0.f;
    for (int i = 4 * fq; i < nslots; i += 16) { const f32x4 v = p[i >> 2]; s += (v[0] + v[1]) + (v[2] + v[3]); }
    s = add_xor16_32(s);
    return __builtin_amdgcn_rsqf(s * inv_n + 1e-6f);
}
__device__ __forceinline__ float sig_mul(float g, float u) {
    const float e = __builtin_amdgcn_exp2f(-1.4426950408889634f * g); return g * __builtin_amdgcn_rcpf(1.0f + e) * u;
}
struct EpiSwiglu {
    static constexpr bool PERM = true, AFTER_DRAIN = false;
    bf16_t* O; int ldc; const float* ssq; PG8_LAS unsigned char* lds;
    __device__ __forceinline__ void operator()(const f32x4 (&acc)[2][2][4][2], const Unit& u, int wr, int wc, int fr, int fq) const {
        const int row0 = u.pm * BM + wr * 64 + fr, col0 = u.pn * HALF + wc * 32 + 8 * fq;
        const int wid = wr * 4 + wc;
        PG8_LAS float* rc = (PG8_LAS float*)(lds + 131072) + wid * 128 + fr;
        PG8_LAS int* tg = (PG8_LAS int*)(lds + 131072 + 4096) + wid;
        const bool hit = __builtin_amdgcn_readfirstlane(*tg) == u.pm;
        float rs[2][4];
        if (hit) {
#pragma unroll
            for (int ai = 0; ai < 2; ++ai)
#pragma unroll
                for (int m = 0; m < 4; ++m) rs[ai][m] = rc[ai * 64 + m * 16];
        } else {
#pragma unroll
            for (int ai = 0; ai < 2; ++ai)
#pragma unroll
                for (int m = 0; m < 4; ++m) rs[ai][m] = row_rs(ssq, 16, 16, 1.0f / 1024.0f, row0 + ai * HALF + m * 16, fq);
            if (fq == 0) {
#pragma unroll
                for (int ai = 0; ai < 2; ++ai)
#pragma unroll
                    for (int m = 0; m < 4; ++m) rc[ai * 64 + m * 16] = rs[ai][m];
                if (fr == 0) *tg = u.pm; }
        }
#pragma unroll
        for (int ai = 0; ai < 2; ++ai)
#pragma unroll
            for (int m = 0; m < 4; ++m) { const int row = row0 + ai * HALF + m * 16; const float r_ = rs[ai][m];
                const float c_ = -1.4426950408889634f * r_, ir2 = __builtin_amdgcn_rcpf(r_ * r_);
#define SWG(a0_, a1_) ((a0_) * (a1_) * __builtin_amdgcn_rcpf(__builtin_fmaf(__builtin_amdgcn_exp2f((a0_) * c_), ir2, ir2)))
                const f32x4 g0 = acc[ai][0][m][0], g1 = acc[ai][0][m][1], u0 = acc[ai][1][m][0], u1 = acc[ai][1][m][1];
                u32x4 w; w.x = cvt_pk_bf16(SWG(g0[0], u0[0]), SWG(g0[1], u0[1])); w.y = cvt_pk_bf16(SWG(g0[2], u0[2]), SWG(g0[3], u0[3]));
                w.z = cvt_pk_bf16(SWG(g1[0], u1[0]), SWG(g1[1], u1[1])); w.w = cvt_pk_bf16(SWG(g1[2], u1[2]), SWG(g1[3], u1[3]));
#undef SWG
                *(u32x4*)(O + (size_t)row * ldc + col0) = w; }
    }
};
typedef _Float16 h16x8 __attribute__((ext_vector_type(8)));
template <bool F16> __device__ __forceinline__ f32x4 mma16(bf16x8 a, bf16x8 b, f32x4 c) {
    if constexpr (F16) return __builtin_amdgcn_mfma_f32_16x16x32_f16(__builtin_bit_cast(h16x8, a), __builtin_bit_cast(h16x8, b), c, 0, 0, 0);
    else return __builtin_amdgcn_mfma_f32_16x16x32_bf16(a, b, c, 0, 0, 0);
}
__device__ __forceinline__ float bf_lo(unsigned w) { return __builtin_bit_cast(float, w << 16); }
__device__ __forceinline__ float bf_hi(unsigned w) { return __builtin_bit_cast(float, w & 0xffff0000u); }
struct EpiResid {
    static constexpr bool PERM = true, AFTER_DRAIN = false;
    float* fout; _Float16* XH; float* ssq; float alpha;
    __device__ __forceinline__ void operator()(const f32x4 (&acc)[2][2][4][2], const Unit& u, int wr, int wc, int fr, int fq) const {
        const int row0 = u.pm * BM + wr * 64 + fr, col0 = u.pn * BM + wc * 32 + 8 * fq;
#pragma unroll
        for (int ai = 0; ai < 2; ++ai) {
            h16x8 pre[4][2];
#pragma unroll
            for (int m = 0; m < 4; ++m)
#pragma unroll
                for (int bj = 0; bj < 2; ++bj) pre[m][bj] = *(const h16x8*)(XH + (size_t)(row0 + ai * HALF + m * 16) * 1024 + col0 + bj * HALF);
#pragma unroll
            for (int m = 0; m < 4; ++m) { const int row = row0 + ai * HALF + m * 16; _Float16* bp = XH + (size_t)row * 1024 + col0; float s = 0.f;
#pragma unroll
                for (int bj = 0; bj < 2; ++bj) { const h16x8 o = pre[m][bj];
                    const f32x4 o0 = {(float)o[0], (float)o[1], (float)o[2], (float)o[3]}, o1 = {(float)o[4], (float)o[5], (float)o[6], (float)o[7]};
                    const f32x4 v0 = o0 + acc[ai][bj][m][0] * alpha, v1 = o1 + acc[ai][bj][m][1] * alpha;
                    if (fout) { float* xp = fout + (size_t)row * 1024 + col0 + bj * HALF; *(f32x4*)xp = v0; *(f32x4*)(xp + 4) = v1; }
                    const h16x8 w = {(_Float16)v0[0], (_Float16)v0[1], (_Float16)v0[2], (_Float16)v0[3], (_Float16)v1[0], (_Float16)v1[1], (_Float16)v1[2], (_Float16)v1[3]};
                    *(h16x8*)(bp + bj * HALF) = w;
                    s += (v0[0] * v0[0] + v0[1] * v0[1]) + (v0[2] * v0[2] + v0[3] * v0[3]) + (v1[0] * v1[0] + v1[1] * v1[1]) + (v1[2] * v1[2] + v1[3] * v1[3]); }
                s = add_xor16_32(s);
                if (fq == 0) ssq[(size_t)row * 16 + u.pn * 4 + wc] = s; }
            asm volatile("" ::: "memory"); }
    }
};
struct EpiGen {
    static constexpr bool PERM = true, AFTER_DRAIN = false;
    bf16_t* O; int ldc; const float* ssq; int ssq_stride, ssq_n; float ssq_inv; int npair, col_shift; float* osq; int osq_stride; PG8_LAS unsigned char* lds;
    __device__ __forceinline__ void operator()(const f32x4 (&acc)[2][2][4][2], const Unit& u, int wr, int wc, int fr, int fq) const {
        const int row0 = u.pm * BM + wr * 64 + fr; const bool pair = u.pn < npair;
        const int col0 = (pair ? u.pn * HALF : u.pn * BM - col_shift) + wc * 32 + 8 * fq;
        float rsv[2][4];
        const int wid = wr * 4 + wc;
        PG8_LAS float* rc = (PG8_LAS float*)(lds + 131072) + wid * 128 + fr;
        PG8_LAS int* tg = (PG8_LAS int*)(lds + 131072 + 4096) + wid;
        const bool hit = ssq && __builtin_amdgcn_readfirstlane(*tg) == u.pm;
        if (hit) {
#pragma unroll
            for (int ai = 0; ai < 2; ++ai)
#pragma unroll
                for (int m = 0; m < 4; ++m) rsv[ai][m] = rc[ai * 64 + m * 16];
        } else {
#pragma unroll
            for (int ai = 0; ai < 2; ++ai)
#pragma unroll
                for (int m = 0; m < 4; ++m) rsv[ai][m] = ssq ? row_rs(ssq, ssq_stride, ssq_n, ssq_inv, row0 + ai * HALF + m * 16, fq) : 1.0f;
            if (ssq && fq == 0) {
#pragma unroll
                for (int ai = 0; ai < 2; ++ai)
#pragma unroll
                    for (int m = 0; m < 4; ++m) rc[ai * 64 + m * 16] = rsv[ai][m];
                if (fr == 0) *tg = u.pm; }
        }
#pragma unroll
        for (int ai = 0; ai < 2; ++ai)
#pragma unroll
            for (int m = 0; m < 4; ++m) { const int row = row0 + ai * HALF + m * 16; const float rs = rsv[ai][m];
                bf16_t* rowp = O + (size_t)row * ldc + col0;
                if (pair) { const f32x4 v0 = (acc[ai][0][m][0] * rs) * (acc[ai][1][m][0] * rs), v1 = (acc[ai][0][m][1] * rs) * (acc[ai][1][m][1] * rs);
                    u32x4 w; w.x = cvt_pk_bf16(v0[0], v0[1]); w.y = cvt_pk_bf16(v0[2], v0[3]); w.z = cvt_pk_bf16(v1[0], v1[1]); w.w = cvt_pk_bf16(v1[2], v1[3]);
                    *(u32x4*)rowp = w; }
                else {
#pragma unroll
                    for (int bj = 0; bj < 2; ++bj) { const f32x4 v0 = acc[ai][bj][m][0] * rs, v1 = acc[ai][bj][m][1] * rs;
                        u32x4 w; w.x = cvt_pk_bf16(v0[0], v0[1]); w.y = cvt_pk_bf16(v0[2], v0[3]); w.z = cvt_pk_bf16(v1[0], v1[1]); w.w = cvt_pk_bf16(v1[2], v1[3]);
                        *(u32x4*)(rowp + bj * HALF) = w;
                        if (osq) { float s = (v0[0] * v0[0] + v0[1] * v0[1]) + (v0[2] * v0[2] + v0[3] * v0[3]) + (v1[0] * v1[0] + v1[1] * v1[1]) + (v1[2] * v1[2] + v1[3] * v1[3]);
                            s = add_xor16_32(s);
                            if (fq == 0) osq[(size_t)row * osq_stride + u.pn * 8 + bj * 4 + wc] = s; } } } }
    }
};
template <class Epi, class Sched, bool ALIGN_EPI = false, bool SP2 = false, bool F16 = false>
__device__ __forceinline__ void gemm_phase(PG8_LAS unsigned char* lds, const Gemm g, const Sched& S, const Epi& E, const int tid) {
    const int wid = __builtin_amdgcn_readfirstlane(tid >> 6), lane = tid & 63, wr = wid >> 2, wc = wid & 3, fr = lane & 15, fq = lane >> 4;
    const int K = g.K, nt = K / BK;
    unsigned voffA[2], voffB[2];
#pragma unroll
    for (int i = 0; i < 2; ++i) { int R, C; stage_rc(tid * 16 + i * 8192, R, C); const int Rb = Epi::PERM ? ((R & ~31) + perm32(R & 31)) : R;
        voffA[i] = (unsigned)(R * g.lda + C) * 2u; voffB[i] = (unsigned)(Rb * K + C) * 2u; }
    const size_t kstep = (size_t)(BK * 2);
    const size_t hstep = (size_t)HALF * K * 2;
    const size_t tstep = 2 * hstep; const size_t hstepA = (size_t)HALF * g.lda * 2, tstepA = 2 * hstepA;
    const unsigned ldsw = (unsigned)wid * 1024u;
    const int aoff = lds_byte(wr * 64 + fr, fq * 8), boff = lds_byte(wc * 32 + fr, fq * 8);
#define PG8_SA(b, h) (((b) * 2 + (h)) * HTB)
#define PG8_SB(b, h) ((4 + (b) * 2 + (h)) * HTB)
#define PG8_STAGE(bufoff, gbase, voff) do { _Pragma("unroll") for (int _i = 0; _i < 2; ++_i) \
        __builtin_amdgcn_global_load_lds((const unsigned*)((const char*)(gbase) + (voff)[_i]), (PG8_LAS unsigned*)(lds + (bufoff) + ldsw + _i * 8192), 16, 0, 0); } while (0)
#define PG8_LDA(dst, b, h) do { _Pragma("unroll") for (int m = 0; m < 4; ++m) _Pragma("unroll") for (int k = 0; k < 2; ++k) dst[m][k] = *(const PG8_LAS bf16x8*)(lds + PG8_SA(b, h) + aoff + m * 2048 + k * 1024); } while (0)
#define PG8_LDB(dst, b, h) do { _Pragma("unroll") for (int n = 0; n < 2; ++n) _Pragma("unroll") for (int k = 0; k < 2; ++k) dst[n][k] = *(const PG8_LAS bf16x8*)(lds + PG8_SB(b, h) + boff + n * 2048 + k * 1024); } while (0)
#define PG8_MMA(ai, bj, At, Bt) do { __builtin_amdgcn_s_setprio(1); _Pragma("unroll") for (int m = 0; m < 4; ++m) _Pragma("unroll") for (int n = 0; n < 2; ++n) _Pragma("unroll") for (int k = 0; k < 2; ++k) \
        acc[ai][bj][m][n] = mma16<F16>(Bt[n][k], At[m][k], acc[ai][bj][m][n]); __builtin_amdgcn_s_setprio(0); } while (0)
#define PG8_WAIT_V(n) asm volatile("s_waitcnt vmcnt(" #n ")" ::: "memory")
#define PG8_WAIT_L(n) asm volatile("s_waitcnt lgkmcnt(" #n ")" ::: "memory")
#define PG8_BAR __builtin_amdgcn_s_barrier()
#define PG8_SCHED __builtin_amdgcn_sched_barrier(0)
    Unit cur, nxt; int ui = 0;
    if (!S.next(0, cur)) return;
    f32x4 acc[2][2][4][2];
#pragma unroll
    for (int a = 0; a < 2; ++a)
#pragma unroll
        for (int b = 0; b < 2; ++b)
#pragma unroll
            for (int m = 0; m < 4; ++m)
#pragma unroll
                for (int n = 0; n < 2; ++n) acc[a][b][m][n] = (f32x4){0.f, 0.f, 0.f, 0.f};
    bf16x8 At[4][2], B0[2][2], B1[2][2];
    const char* cA = (const char*)g.A + (size_t)cur.pm * tstepA; const char* cB = (const char*)g.Bt + (size_t)cur.pn * tstep;
    S.a_ready(cur);
    if constexpr (SP2) {
        PG8_STAGE(PG8_SB(0, 0), cB, voffB); PG8_STAGE(PG8_SB(0, 1), cB + hstep, voffB); PG8_STAGE(PG8_SA(0, 0), cA, voffA); PG8_STAGE(PG8_SA(0, 1), cA + hstepA, voffA);
        if (wr == 1) PG8_BAR;
        PG8_WAIT_V(2); PG8_BAR;
        PG8_STAGE(PG8_SB(1, 0), cB + kstep, voffB); PG8_STAGE(PG8_SA(1, 0), cA + kstep, voffA); PG8_STAGE(PG8_SB(1, 1), cB + hstep + kstep, voffB);
        PG8_WAIT_V(6); PG8_BAR;
    } else {
        PG8_STAGE(PG8_SB(0, 0), cB, voffB); PG8_STAGE(PG8_SA(0, 0), cA, voffA); PG8_STAGE(PG8_SB(0, 1), cB + hstep, voffB); PG8_STAGE(PG8_SA(0, 1), cA + hstepA, voffA);
        if (wr == 1) PG8_BAR;
        PG8_WAIT_V(4); PG8_BAR;
        PG8_STAGE(PG8_SB(1, 0), cB + kstep, voffB); PG8_STAGE(PG8_SA(1, 0), cA + kstep, voffA); PG8_STAGE(PG8_SB(1, 1), cB + hstep + kstep, voffB);
        PG8_WAIT_V(6); PG8_BAR;
    }
    for (;;) {
        const bool has_next = S.next(ui + 1, nxt);
        const char* nA = has_next ? (const char*)g.A + (size_t)nxt.pm * tstepA : cA; const char* nB = has_next ? (const char*)g.Bt + (size_t)nxt.pn * tstep : cB;
        for (int t = 0; t < nt; t += 2) {
            const bool last = (t == nt - 2);
            const char* a1 = cA + (size_t)(t + 1) * kstep;
            const char* a2 = last ? nA : cA + (size_t)(t + 2) * kstep; const char* b2 = last ? nB : cB + (size_t)(t + 2) * kstep;
            const char* a3 = a2 + kstep; const char* b3 = b2 + kstep;
            if (last && has_next) S.a_ready(nxt);
            if constexpr (SP2) {
            PG8_LDB(B0, 0, 0); PG8_LDB(B1, 0, 1); PG8_SCHED; PG8_LDA(At, 0, 0); PG8_STAGE(PG8_SA(1, 1), a1 + hstepA, voffA);
            PG8_WAIT_V(8); PG8_WAIT_L(0); PG8_BAR; PG8_MMA(0, 0, At, B0); PG8_MMA(0, 1, At, B1); PG8_BAR; PG8_SCHED;
            PG8_LDA(At, 0, 1); PG8_STAGE(PG8_SB(0, 0), b2, voffB); PG8_STAGE(PG8_SB(0, 1), b2 + hstep, voffB); PG8_STAGE(PG8_SA(0, 0), a2, voffA);
            PG8_WAIT_V(8); PG8_WAIT_L(0); PG8_BAR; PG8_MMA(1, 0, At, B0); PG8_MMA(1, 1, At, B1); PG8_BAR; PG8_SCHED;
            PG8_LDB(B0, 1, 0); PG8_LDB(B1, 1, 1); PG8_SCHED; PG8_LDA(At, 1, 0); PG8_STAGE(PG8_SA(0, 1), a2 + hstepA, voffA);
            PG8_WAIT_V(8); PG8_WAIT_L(0); PG8_BAR; PG8_MMA(0, 0, At, B0); PG8_MMA(0, 1, At, B1); PG8_BAR; PG8_SCHED;
            PG8_LDA(At, 1, 1); PG8_STAGE(PG8_SB(1, 0), b3, voffB); PG8_STAGE(PG8_SB(1, 1), b3 + hstep, voffB); PG8_STAGE(PG8_SA(1, 0), a3, voffA);
            PG8_WAIT_V(8); PG8_WAIT_L(0); PG8_BAR; PG8_MMA(1, 0, At, B0); PG8_MMA(1, 1, At, B1); PG8_BAR; PG8_SCHED;
            } else {
            PG8_LDB(B0, 0, 0); PG8_SCHED; PG8_LDA(At, 0, 0); PG8_STAGE(PG8_SA(1, 1), a1 + hstepA, voffA);
            PG8_WAIT_L(8); PG8_BAR; PG8_WAIT_L(0); PG8_MMA(0, 0, At, B0); PG8_BAR; PG8_SCHED;
            PG8_LDB(B1, 0, 1); PG8_STAGE(PG8_SB(0, 0), b2, voffB);
            PG8_BAR; PG8_WAIT_L(0); PG8_MMA(0, 1, At, B1); PG8_BAR;
            PG8_LDA(At, 0, 1); PG8_STAGE(PG8_SA(0, 0), a2, voffA);
            PG8_BAR; PG8_WAIT_L(0); PG8_MMA(1, 0, At, B0); PG8_BAR; PG8_SCHED;
            PG8_STAGE(PG8_SB(0, 1), b2 + hstep, voffB);
            PG8_WAIT_V(6); PG8_BAR; PG8_MMA(1, 1, At, B1); PG8_BAR;
            PG8_LDB(B0, 1, 0); PG8_SCHED; PG8_LDA(At, 1, 0); PG8_STAGE(PG8_SA(0, 1), a2 + hstepA, voffA);
            PG8_WAIT_L(8); PG8_BAR; PG8_WAIT_L(0); PG8_MMA(0, 0, At, B0); PG8_BAR; PG8_SCHED;
            PG8_LDB(B1, 1, 1); PG8_STAGE(PG8_SB(1, 0), b3, voffB);
            PG8_BAR; PG8_WAIT_L(0); PG8_MMA(0, 1, At, B1); PG8_BAR;
            PG8_LDA(At, 1, 1); PG8_STAGE(PG8_SA(1, 0), a3, voffA);
            PG8_BAR; PG8_WAIT_L(0); PG8_MMA(1, 0, At, B0); PG8_BAR; PG8_SCHED;
            PG8_STAGE(PG8_SB(1, 1), b3 + hstep, voffB);
            PG8_WAIT_V(6); PG8_BAR; PG8_MMA(1, 1, At, B1); PG8_BAR;
            }
        }
        if constexpr (ALIGN_EPI) { if (wr == 0) PG8_BAR; }
        if constexpr (!Epi::AFTER_DRAIN) { E(acc, cur, wr, wc, fr, fq); S.done(cur); }
        if (!has_next) break;
#pragma unroll
        for (int a = 0; a < 2; ++a)
#pragma unroll
            for (int b = 0; b < 2; ++b)
#pragma unroll
                for (int m = 0; m < 4; ++m)
#pragma unroll
                    for (int n = 0; n < 2; ++n) acc[a][b][m][n] = (f32x4){0.f, 0.f, 0.f, 0.f};
        cur = nxt; cA = nA; cB = nB; ++ui;
        if constexpr (ALIGN_EPI) { if (wr == 1) PG8_BAR; }
    }
    PG8_WAIT_V(0);
    if constexpr (!ALIGN_EPI) { if (wr == 0) PG8_BAR; }
    PG8_BAR;
    if constexpr (Epi::AFTER_DRAIN) { E.fused(acc, cur, wr, wc, fr, fq, lds, wid, lane); S.done(cur); }
#undef PG8_SA
#undef PG8_SB
#undef PG8_STAGE
#undef PG8_LDA
#undef PG8_LDB
#undef PG8_MMA
#undef PG8_WAIT_V
#undef PG8_WAIT_L
#undef PG8_BAR
#undef PG8_SCHED
}
}
namespace att {
typedef unsigned short bf16_t;
typedef short bf16x8 __attribute__((ext_vector_type(8)));
typedef short s16x4 __attribute__((ext_vector_type(4)));
typedef float f32x16 __attribute__((ext_vector_type(16)));
typedef float f32x4 __attribute__((ext_vector_type(4)));
typedef unsigned u32x4 __attribute__((ext_vector_type(4)));
constexpr int NW = 8, QBLK = 32, KVBLK = 64, QB = NW * QBLK;
constexpr int SHM_V = KVBLK * 128 * 2, SHM_K = KVBLK * 128 * 2, SHM_KR = KVBLK * 64 * 2;
constexpr int NVB = 3;
constexpr int ATT_WS_OFF = NVB * SHM_V + 2 * SHM_K + 2 * SHM_KR;
constexpr int ATT_LDS_BYTES = ATT_WS_OFF + NW * 64 * 4;
constexpr float THR = 8.f;
template <int MODE> struct Cfg;
template <> struct Cfg<0> { static constexpr int NQF = 12, NQT = 8, NQK = 8, NPV = 4, KS = 1536, VS = 1536, OS = 1024; static constexpr bool ROPE = true; };
template <> struct Cfg<1> { static constexpr int NQF = 4, NQT = 4, NQK = 4, NPV = 2, KS = 128, VS = 128, OS = 1024; static constexpr bool ROPE = false; };

#define KSWZ(row, colB) ((row) * 256 + ((colB) ^ (((row) & 7) << 4)))
#define KRSWZ(row, colB) ((row) * 128 + ((colB) ^ ((((row) >> 1) & 7) << 4)))
#define SBAR() __builtin_amdgcn_sched_barrier(0)
__device__ __forceinline__ int v_st(int k, int c) { const int kk = (k & ~0xC) | ((k & 4) << 1) | ((k & 8) >> 1); return ((kk >> 3) * 4 + (c >> 5)) * 512 + ((kk & 7) * 32 + (c & 31)) * 2; }
__device__ __forceinline__ int v_rd_base(int lane) { return ((lane & 3) << 3) | (((lane >> 2) & 3) << 6) | (((lane >> 4) & 1) << 5) | (((lane >> 5) & 1) << 8); }
constexpr int v_rd_off(int d0, int ks, int half) { return d0 * 512 + ks * 4096 + half * 2048; }
__device__ __forceinline__ int crow(int r, int hi) { return (r & 3) + 8 * (r >> 2) + 4 * hi; }
__device__ __forceinline__ unsigned cvtpk(float lo, float hi) {
    unsigned r; asm volatile("v_cvt_pk_bf16_f32 %0, %1, %2" : "=v"(r) : "v"(lo), "v"(hi)); return r;
}
__device__ __forceinline__ bf16x8 load8(const bf16_t* p) { return *reinterpret_cast<const bf16x8*>(p); }
__device__ __forceinline__ void mask_tile(f32x16& p0, f32x16& p1, int dq, unsigned W) {
    const float NEG = -__builtin_inff();
#pragma unroll
    for (int r = 0; r < 16; ++r) {
        const int c = (r & 3) + 8 * (r >> 2);
        if ((unsigned)(dq - c) >= W) p0[r] = NEG;
        if ((unsigned)(dq - c - 32) >= W) p1[r] = NEG;
    }
}
__device__ __forceinline__ void partialSM(f32x16& p0, f32x16& p1, float& m_reg, float& mn, float& alpha) {
    float pmax = p0[0]; for (int r = 1; r < 16; ++r) pmax = fmaxf(pmax, p0[r]); for (int r = 0; r < 16; ++r) pmax = fmaxf(pmax, p1[r]);
    { auto rr = __builtin_amdgcn_permlane32_swap(__float_as_uint(pmax), __float_as_uint(pmax), false, false);
      pmax = fmaxf(__uint_as_float(rr[0]), __uint_as_float(rr[1])); }
    constexpr float C2 = 1.4426950408889634f;
    if (__builtin_expect(__all((pmax - m_reg) <= THR), 1)) { mn = m_reg; alpha = 1.f; }
    else { mn = fmaxf(m_reg, pmax); alpha = __builtin_amdgcn_exp2f((m_reg - mn) * C2); m_reg = mn; }
    const float mnL = -mn * C2;
    for (int r = 0; r < 16; ++r) p0[r] = fmaf(p0[r], C2, mnL); for (int r = 0; r < 16; ++r) p1[r] = fmaf(p1[r], C2, mnL);
    for (int r = 0; r < 16; ++r) p0[r] = __builtin_amdgcn_exp2f(p0[r]);
}
__device__ __forceinline__ void finishSM(f32x16& p0, f32x16& p1, float alpha, float& l_reg, bf16x8& pa0, bf16x8& pa1, bf16x8& pa2, bf16x8& pa3) {
    for (int r = 0; r < 16; ++r) p1[r] = __builtin_amdgcn_exp2f(p1[r]);
    float ps = 0; for (int r = 0; r < 16; ++r) ps += p0[r]; for (int r = 0; r < 16; ++r) ps += p1[r];
    { auto rr = __builtin_amdgcn_permlane32_swap(__float_as_uint(ps), __float_as_uint(ps), false, false);
      ps = __uint_as_float(rr[0]) + __uint_as_float(rr[1]); }
    l_reg = l_reg * alpha + ps;
#define PK4(P, B_, OUT) do { unsigned a0 = cvtpk(P[B_+0], P[B_+1]), a1 = cvtpk(P[B_+2], P[B_+3]);                          \
        unsigned b0 = cvtpk(P[B_+4], P[B_+5]), b1 = cvtpk(P[B_+6], P[B_+7]);                                             \
        auto r0 = __builtin_amdgcn_permlane32_swap(a0, b0, false, false); auto r1 = __builtin_amdgcn_permlane32_swap(a1, b1, false, false); \
        u32x4 w = {r0[0], r1[0], r0[1], r1[1]}; OUT = *reinterpret_cast<bf16x8*>(&w); } while (0)
    PK4(p0, 0, pa0); PK4(p0, 8, pa1); PK4(p1, 0, pa2); PK4(p1, 8, pa3);
#undef PK4
}
template <int MODE, int KB>
__device__ __forceinline__ void qkt(f32x16& p0, f32x16& p1, const char* K_lds, const char* KR_lds, int r32, int hi, const bf16x8* qr) {
    typedef Cfg<MODE> C;
    p0 = f32x16{}; p1 = f32x16{};
    const char* kb[4];
#pragma unroll
    for (int dd = 0; dd < 4; ++dd) kb[dd] = K_lds + KB * SHM_K + KSWZ(r32, (dd * 16 + hi * 8) * 2);
#pragma unroll
    for (int d0 = 0; d0 < C::NQK; ++d0) { const char* a = kb[d0 & 3] + (d0 >> 2) * 128;
        bf16x8 b0 = *reinterpret_cast<const bf16x8*>(a);
        bf16x8 b1 = *reinterpret_cast<const bf16x8*>(a + 32 * 256);
        p0 = __builtin_amdgcn_mfma_f32_32x32x16_bf16(b0, qr[d0], p0, 0, 0, 0);
        p1 = __builtin_amdgcn_mfma_f32_32x32x16_bf16(b1, qr[d0], p1, 0, 0, 0); }
    if constexpr (C::ROPE) {
#pragma unroll
        for (int dd = 0; dd < 4; ++dd) { const char* a = KR_lds + KB * SHM_KR + KRSWZ(r32, (dd * 16 + hi * 8) * 2);
            bf16x8 b0 = *reinterpret_cast<const bf16x8*>(a);
            bf16x8 b1 = *reinterpret_cast<const bf16x8*>(a + 32 * 128);
            p0 = __builtin_amdgcn_mfma_f32_32x32x16_bf16(b0, qr[8 + dd], p0, 0, 0, 0);
            p1 = __builtin_amdgcn_mfma_f32_32x32x16_bf16(b1, qr[8 + dd], p1, 0, 0, 0); }
    }
}
template <int MODE, int VB>
__device__ __forceinline__ void pv_tile(f32x16* o, int vb0, bf16x8 pa0, bf16x8 pa1, bf16x8 pa2, bf16x8 pa3) {
#define TRRD(dst, off) asm volatile("ds_read_b64_tr_b16 %0, %1 offset:%2" : "=&v"(dst) : "v"(vb0), "i"(off) : "memory")
#define PV_D0(d0) do { s16x4 l0, l1, l2, l3, h0, h1, h2, h3; constexpr int b_ = VB * SHM_V + v_rd_off(d0, 0, 0);     \
        TRRD(l0, b_); TRRD(h0, b_ + 2048); TRRD(l1, b_ + 4096); TRRD(h1, b_ + 6144); TRRD(l2, b_ + 8192); TRRD(h2, b_ + 10240); TRRD(l3, b_ + 12288); TRRD(h3, b_ + 14336); \
        asm volatile("s_waitcnt lgkmcnt(0)" ::: "memory"); SBAR();             \
        o[d0] = __builtin_amdgcn_mfma_f32_32x32x16_bf16(pa0, (bf16x8){l0[0], l0[1], l0[2], l0[3], h0[0], h0[1], h0[2], h0[3]}, o[d0], 0, 0, 0);   \
        o[d0] = __builtin_amdgcn_mfma_f32_32x32x16_bf16(pa1, (bf16x8){l1[0], l1[1], l1[2], l1[3], h1[0], h1[1], h1[2], h1[3]}, o[d0], 0, 0, 0);   \
        o[d0] = __builtin_amdgcn_mfma_f32_32x32x16_bf16(pa2, (bf16x8){l2[0], l2[1], l2[2], l2[3], h2[0], h2[1], h2[2], h2[3]}, o[d0], 0, 0, 0);   \
        o[d0] = __builtin_amdgcn_mfma_f32_32x32x16_bf16(pa3, (bf16x8){l3[0], l3[1], l3[2], l3[3], h3[0], h3[1], h3[2], h3[3]}, o[d0], 0, 0, 0); } while (0)
    PV_D0(0); PV_D0(1);
    if constexpr (Cfg<MODE>::NPV == 4) { PV_D0(2); PV_D0(3); }
#undef PV_D0
#undef TRRD
}

struct BlockRef { const bf16_t* Q; const bf16_t* K; const bf16_t* V; const bf16_t* KR; bf16_t* O; int P0; int qs; int tok; int pad; };
__device__ __forceinline__ int swa_jlo(int P0, int W) { const int lowk = P0 - W + 1; return lowk > 0 ? lowk / KVBLK : 0; }
template <int MODE>
__device__ __forceinline__ void attn_run(const BlockRef& cur, const bf16x8* qr, int skv, int W, char* lds, const int tid) {
    typedef Cfg<MODE> C;
    const int wid = __builtin_amdgcn_readfirstlane(tid >> 6), lane = tid & 63, r32 = lane & 31, hi = lane >> 5;
    const bool grpB = wid >= 4;
    const int j_lo = swa_jlo(cur.P0, W);
    int j_hi = (cur.P0 + QB - 1) / KVBLK + 1; if (j_hi > skv / KVBLK) j_hi = skv / KVBLK;
    const int NT = j_hi - j_lo;
    const int qlo = cur.P0 + wid * QBLK, qm = qlo + r32 - 4 * hi;
    char* V_lds = lds; char* K_lds = lds + NVB * SHM_V; char* KR_lds = lds + NVB * SHM_V + 2 * SHM_K;
    float* ws = (float*)(lds + ATT_WS_OFF) + wid * 64; float* li_l = ws, * al_l = ws + 32;
    float m_reg = -1e30f, l_reg = 0; f32x16 o[4] = {};
    const int sr = tid >> 4, sc = (tid & 15) * 8, vst0 = v_st(sr, sc), vst1 = v_st(32 + sr, sc), kws = KSWZ(sr, sc * 2);
    const int krr = tid >> 3, krc = (tid & 7) * 8, krw = KRSWZ(krr, krc * 2);
    const int vb0 = (int)(uintptr_t)V_lds + v_rd_base(lane);
    const bf16_t* Kh = cur.K; const bf16_t* Vh = cur.V; const bf16_t* KRh = cur.KR;
    bf16x8 st_v0, st_v1, st_k0, st_k1, st_kr;
#define ROWK(p, k0, rr) ((p) + (size_t)((k0) + (rr)) * C::KS + sc)
#define ROWV(p, k0, rr) ((p) + (size_t)((k0) + (rr)) * C::VS + sc)
#define VMW() asm volatile("s_waitcnt vmcnt(0)" ::: "memory")
#define SLOAD_H(k0) do { st_v0 = load8(ROWV(Vh, k0, sr)); st_v1 = load8(ROWV(Vh, k0, 32 + sr)); st_k0 = load8(ROWK(Kh, k0, sr)); st_k1 = load8(ROWK(Kh, k0, 32 + sr)); \
                         if constexpr (C::ROPE) st_kr = load8(KRh + (size_t)((k0) + krr) * 64 + krc); } while (0)
#define SWRITE_H(kb, vb) do { *(bf16x8*)(V_lds + (vb) * SHM_V + vst0) = st_v0; *(bf16x8*)(V_lds + (vb) * SHM_V + vst1) = st_v1;                           \
                          *(bf16x8*)(K_lds + (kb) * SHM_K + kws) = st_k0; *(bf16x8*)(K_lds + (kb) * SHM_K + kws + 32 * 256) = st_k1;                 \
                          if constexpr (C::ROPE) *(bf16x8*)(KR_lds + (kb) * SHM_KR + krw) = st_kr; } while (0)
#define RESC(a) do { if (__any((a) < 1.f)) { if (hi == 0) al_l[r32] = (a); asm volatile("s_waitcnt lgkmcnt(0)" ::: "memory");              \
                     for (int d_ = 0; d_ < C::NPV; ++d_) for (int r = 0; r < 16; ++r) o[d_][r] *= al_l[crow(r, hi)]; } } while (0)
#define KBASE(t) ((j_lo + (t)) * KVBLK)
#define MASKT(P0_, P1_, t) do { const int kb_ = KBASE(t); if (kb_ + KVBLK - 1 > qlo || kb_ <= qlo + QBLK - 1 - W) mask_tile(P0_, P1_, qm - kb_, (unsigned)W); } while (0)
    f32x16 p0, p1; float mn, al; bf16x8 pa0 = {}, pa1 = {}, pa2 = {}, pa3 = {};
    SLOAD_H(KBASE(0)); VMW(); SWRITE_H(0, 0); SBAR();
    if (NT > 1) { SLOAD_H(KBASE(1)); SBAR(); }
    __syncthreads();
    int vcur = 0, vprev = 0;
    for (int t = 0; t < NT; ++t) {
        const int kb = t & 1; const int vnext = vcur == NVB - 1 ? 0 : vcur + 1;
        SBAR();
        if (grpB && t > 0) { pv_tile<MODE, 0>(o, vb0 + vprev * SHM_V, pa0, pa1, pa2, pa3); SBAR(); }
        qkt<MODE, 0>(p0, p1, K_lds + kb * SHM_K, KR_lds + kb * SHM_KR, r32, hi, qr); SBAR();
        MASKT(p0, p1, t); partialSM(p0, p1, m_reg, mn, al); RESC(al);
        finishSM(p0, p1, al, l_reg, pa0, pa1, pa2, pa3); SBAR();
        if (!grpB) { pv_tile<MODE, 0>(o, vb0 + vcur * SHM_V, pa0, pa1, pa2, pa3); SBAR(); }
        if (t + 1 < NT) { VMW(); SWRITE_H(kb ^ 1, vnext); SBAR(); if (t + 2 < NT) { SLOAD_H(KBASE(t + 2)); SBAR(); } }
        __syncthreads();
        vprev = vcur; vcur = vnext;
    }
    if (grpB) { SBAR(); pv_tile<MODE, 0>(o, vb0 + vprev * SHM_V, pa0, pa1, pa2, pa3); SBAR(); }
    if (hi == 0) li_l[r32] = l_reg; asm volatile("s_waitcnt lgkmcnt(0)" ::: "memory");
    float rli[16];
#pragma unroll
    for (int r = 0; r < 16; ++r) rli[r] = __builtin_amdgcn_rcpf(li_l[crow(r, hi)]);
    bf16_t* Ow = cur.O + (size_t)(wid * QBLK) * C::OS;
#pragma unroll
    for (int r = 0; r < 16; ++r) { const int orow = crow(r, hi);
#pragma unroll
        for (int d0 = 0; d0 < C::NPV; ++d0) { const float v = o[d0][r] * rli[r];
            const float vn = pg8::swz_xor<1>(v);
            if ((r32 & 1) == 0) *(unsigned*)(Ow + (size_t)orow * C::OS + d0 * 32 + r32) = cvtpk(v, vn); } }
    __syncthreads();
#undef RESC
#undef KBASE
#undef MASKT
#undef ROWK
#undef ROWV
#undef VMW
#undef SLOAD_H
#undef SWRITE_H
}
}
#ifndef MK_N_LAUNCHES
#define MK_N_LAUNCHES 1
#endif
#define LAS __attribute__((address_space(3)))
typedef unsigned short bf16;
typedef float f32x4 __attribute__((ext_vector_type(4)));
typedef unsigned v4u __attribute__((ext_vector_type(4)));
typedef unsigned v2u __attribute__((ext_vector_type(2)));
typedef short bf16x8 __attribute__((ext_vector_type(8)));
constexpr int NWAVES = 8;
constexpr int T = 65536, DM = 1024, FF = 2816, NBATCH = 8, SEQ = 8192;
constexpr float EPS = 1e-6f;
constexpr int N13 = 2 * FF;
constexpr int NCONV = 2560, NMLA = 768, NUQ = 1280, NKV1 = 512, NKV2 = 1536, NMEMKV = 2048, MEMROWS = 2048;
constexpr int PSTRIDE = 1792;
constexpr size_t MiB = 1u << 20;
constexpr size_t WS_W13 = 0;
constexpr size_t WS_W2 = WS_W13 + 88 * MiB;
constexpr size_t WS_WOUT = WS_W2 + 44 * MiB;
constexpr size_t WS_CONVIN = WS_WOUT + 8 * MiB;
constexpr size_t WS_MLAIN = WS_CONVIN + 10 * MiB;
constexpr size_t WS_WUQ = WS_MLAIN + 3 * MiB;
constexpr size_t WS_WKV1 = WS_WUQ + 2 * MiB;
constexpr size_t WS_WKV2 = WS_WKV1 + 1 * MiB;
constexpr size_t WS_WMEMKV = WS_WKV2 + 1 * MiB;
constexpr size_t WS_SSQ = WS_WMEMKV + 4 * MiB;
constexpr size_t WS_CSSQ = WS_SSQ + 4 * MiB;
constexpr size_t WS_MEMB = WS_CSSQ + 6 * MiB;
constexpr size_t WS_MEMSSQ = WS_MEMB + 4 * MiB;
constexpr size_t WS_MEMKVRAW = WS_MEMSSQ + 1 * MiB;
constexpr size_t WS_KMEM = WS_MEMKVRAW + 8 * MiB;
constexpr size_t WS_VMEM = WS_KMEM + 8 * MiB;
constexpr size_t WS_XB = WS_VMEM + 8 * MiB;
constexpr size_t WS_ACT = WS_XB + 128 * MiB;
constexpr size_t WS_MIX = WS_ACT + 352 * MiB;
constexpr size_t WS_KVB = WS_MIX + 128 * MiB;
constexpr size_t WS_KR = WS_KVB + 192 * MiB;
constexpr size_t WS_CTL = WS_KR + 8 * MiB;
constexpr size_t CTL_BYTES = 65536;
constexpr size_t WS_END = WS_CTL + 1 * MiB;
static_assert(WS_END <= 1024 * MiB, "d_ws map must fit 1 GiB");
constexpr size_t ACT_QRAW = 96 * MiB;
constexpr int MISC_OFF = 143360;
constexpr int LDS_BYTES = 147456;
static_assert(att::ATT_LDS_BYTES <= LDS_BYTES, "attention LDS");

__constant__ float INVF[32] = {1.000000000e+00f, 7.498942614e-01f, 5.623413324e-01f, 4.216965139e-01f, 3.162277639e-01f, 2.371373773e-01f, 1.778279394e-01f, 1.333521307e-01f, 1.000000015e-01f, 7.498941571e-02f, 5.623413250e-02f, 4.216965288e-02f, 3.162277490e-02f, 2.371373773e-02f, 1.778279431e-02f, 1.333521493e-02f, 9.999999776e-03f, 7.498941850e-03f, 5.623413250e-03f, 4.216964822e-03f, 3.162277630e-03f, 2.371373586e-03f, 1.778279431e-03f, 1.333521446e-03f, 1.000000047e-03f, 7.498942432e-04f, 5.623413017e-04f, 4.216965172e-04f, 3.162277571e-04f, 2.371373703e-04f, 1.778279402e-04f, 1.333521504e-04f};

#define LDS_WAIT() asm volatile("s_waitcnt lgkmcnt(0)" ::: "memory")
__device__ __forceinline__ unsigned f2bf(float f) { unsigned u = __builtin_bit_cast(unsigned, f); return (u + 0x7fffu + ((u >> 16) & 1u)) >> 16; }
__device__ __forceinline__ unsigned pk2(float lo, float hi) { return f2bf(lo) | (f2bf(hi) << 16); }
__device__ __forceinline__ float bf2f(unsigned short h) { return __builtin_bit_cast(float, (unsigned)h << 16); }
__device__ __forceinline__ float wave_sum(float v) {
    v += pg8::swz_xor<1>(v); v += pg8::swz_xor<2>(v); v += pg8::swz_xor<4>(v); v += pg8::swz_xor<8>(v); v += pg8::swz_xor<16>(v);
    return pg8::add_xor32(v);
}
__device__ __forceinline__ void rope_cs(int pos, int i, float& c, float& s) {
    const float ang = (float)pos * INVF[i];
    double t = (double)ang * 0.15915494309189535; t -= __builtin_rint(t);
    const float fr = (float)t; c = __builtin_amdgcn_cosf(fr); s = __builtin_amdgcn_sinf(fr);
}

struct Args { const void* in[25]; float* out; unsigned char* ws; int lo, hi; };

enum { MAP_PLAIN = 0, MAP_GATEUP = 1, MAP_CONVIN = 2 };
__device__ __forceinline__ int map_col(int mode, int n0, int Nsrc) {
    if (mode == MAP_GATEUP) { const int tile = n0 >> 8, q = n0 & 255; return (q < 128 ? 0 : FF) + tile * 128 + (q & 127); }
    if (mode == MAP_CONVIN) { const int tile = n0 >> 8, q = n0 & 255; if (tile < 6) return (q < 128 ? 768 : 1536) + tile * 128 + (q & 127); if (tile < 9) return (tile - 6) * 256 + q; return 2304 + q; }
    return n0 < Nsrc ? n0 : -1;
}
#ifndef WMANT
#define WMANT 7
#endif
__device__ __forceinline__ float rmant(float f) {
    unsigned u = __builtin_bit_cast(unsigned, f); u += 1u << (22 - WMANT); u &= ~((1u << (23 - WMANT)) - 1u); return __builtin_bit_cast(float, u);
}
__device__ __forceinline__ unsigned pk2h(float lo, float hi) { typedef _Float16 h2 __attribute__((ext_vector_type(2))); const h2 v = {(_Float16)lo, (_Float16)hi}; return __builtin_bit_cast(unsigned, v); }
__device__ __forceinline__ void prep_weight(const float* W, const float* g, int K, int Nsrc, bf16* WT, int Ndst, int mode, bool f16, LAS float* scr, int gw, int NGW, int lane) {
    const int nblk = Ndst / 64, nitems = (K / 64) * nblk; const int kr = lane >> 4, c4 = (lane & 15) * 4;
    for (int item = gw; item < nitems; item += NGW) {
        const int kb = item / nblk, nb = item % nblk, k0 = 64 * kb, n0 = 64 * nb; const int s0 = map_col(mode, n0, Nsrc);
        if (s0 >= 0) {
            f32x4 v[16];
#pragma unroll
            for (int i = 0; i < 16; ++i) v[i] = *(const f32x4*)(W + (size_t)(k0 + 4 * i + kr) * Nsrc + s0 + c4);
#pragma unroll
            for (int i = 0; i < 16; ++i) { const int kk = 4 * i + kr; const float gv = g ? g[k0 + kk] : 1.0f; LAS float* d = scr + kk * 65 + c4;
                d[0] = v[i].x * gv; d[1] = v[i].y * gv; d[2] = v[i].z * gv; d[3] = v[i].w * gv; }
        }
        LDS_WAIT(); asm volatile("" ::: "memory");
        const int c = lane & 7;
#pragma unroll
        for (int j = 0; j < 8; ++j) { const int n = (lane >> 3) + 8 * j; const LAS float* s = scr + (8 * c) * 65 + n;
            v4u o = {0u, 0u, 0u, 0u};
            if (s0 >= 0) { float e[8];
#pragma unroll
                for (int q = 0; q < 8; ++q) e[q] = rmant(s[q * 65]);
                if (f16) { o.x = pk2h(e[0], e[1]); o.y = pk2h(e[2], e[3]); o.z = pk2h(e[4], e[5]); o.w = pk2h(e[6], e[7]); }
                else { o.x = pk2(e[0], e[1]); o.y = pk2(e[2], e[3]); o.z = pk2(e[4], e[5]); o.w = pk2(e[6], e[7]); } }
            *(v4u*)(WT + (size_t)(n0 + n) * K + k0 + 8 * c) = o; }
        LDS_WAIT(); asm volatile("" ::: "memory");
    }
}
__device__ __forceinline__ void row_to_bf16(const float* xrow, bool f16, bf16* orow, float* ssq, int nslot, int lane) {
    const f32x4* xr = (const f32x4*)xrow + lane; f32x4 v[4]; float s = 0.f;
#pragma unroll
    for (int j = 0; j < 4; ++j) { v[j] = xr[64 * j]; s += (v[j].x * v[j].x + v[j].y * v[j].y) + (v[j].z * v[j].z + v[j].w * v[j].w); }
    s = wave_sum(s);
    v2u* o8 = (v2u*)orow + lane;
#pragma unroll
    for (int j = 0; j < 4; ++j) { v2u w; if (f16) { w.x = pk2h(v[j].x, v[j].y); w.y = pk2h(v[j].z, v[j].w); } else { w.x = pk2(v[j].x, v[j].y); w.y = pk2(v[j].z, v[j].w); } o8[64 * j] = w; }
    if (lane < nslot) ssq[lane] = lane == 0 ? s : 0.f;
}

__device__ __forceinline__ const void* argp(int i) {
    const char __attribute__((address_space(4)))* ka = (const char __attribute__((address_space(4)))*)__builtin_amdgcn_kernarg_segment_ptr();
    int off = i * 8; asm volatile("" : "+s"(off));
    return *(const void* const __attribute__((address_space(4)))*)(ka + off);
}
#define XB_TMO      128
#define XB_XCNT(j)  (256  + 64 * (j))
#define XB_XSUB(j)  (1280 + 64 * (j))
#define XB_XGEN(j)  (2304 + 64 * (j))
#define XB_TOP      3328
#define XB_TOPGEN   3392
#define XCD_BAR_WORDS 3456
#define XB_SPIN_CAP (1u << 18)
__device__ __forceinline__ unsigned xb_ld(unsigned* p)              { return __hip_atomic_load(p, __ATOMIC_RELAXED, __HIP_MEMORY_SCOPE_AGENT); }
__device__ __forceinline__ unsigned xb_add(unsigned* p, unsigned v) { return __hip_atomic_fetch_add(p, v, __ATOMIC_RELAXED, __HIP_MEMORY_SCOPE_AGENT); }
__device__ __forceinline__ unsigned xb_xcc_id() { return (unsigned)__builtin_amdgcn_s_getreg((3 << 11) | 20) & 0xFu; }
#define XB_SPIN(cond, bar) do { unsigned _sp = 0; while (cond) { __builtin_amdgcn_s_sleep(1); \
    if ((++_sp & 255u) == 0u) { if (xb_ld(&(bar)[XB_TMO])) break; if (_sp > XB_SPIN_CAP) { atomicAdd(&(bar)[XB_TMO], 1u); break; } } } } while (0)
struct XcdBarrier { unsigned* bar; unsigned x; volatile LAS unsigned* st; };
__device__ __forceinline__ XcdBarrier xcd_barrier_post(unsigned* bar, volatile LAS unsigned* st) {
    XcdBarrier b; b.bar = bar; b.x = xb_xcc_id(); b.st = st;
    if (threadIdx.x == 0) (void)xb_add(&bar[XB_XCNT(b.x)], 1u);
    return b;
}
__device__ __forceinline__ void xcd_barrier_complete(unsigned* bar, unsigned x, unsigned& nloc, unsigned& nx) {
    const unsigned G = gridDim.x * gridDim.y * gridDim.z;
    unsigned sum, cnt, mine, sp = 0u;
    for (;;) {
        sum = 0u; cnt = 0u; mine = 0u;
#pragma unroll
        for (unsigned j = 0; j < 16; ++j) { const unsigned c = xb_ld(&bar[XB_XCNT(j)]); sum += c; cnt += (c > 0u) ? 1u : 0u; mine = (j == x) ? c : mine; }
        if (sum == G) break;
        __builtin_amdgcn_s_sleep(1);
        if ((++sp & 255u) == 0u) { if (xb_ld(&bar[XB_TMO])) break; if (sp > XB_SPIN_CAP) { atomicAdd(&bar[XB_TMO], 1u); break; } }
    }
    nloc = mine > 0u ? mine : 1u; nx = cnt > 0u ? cnt : 1u;
}
__device__ __forceinline__ void xcd_barrier(const XcdBarrier& b, const int tid) {
    asm volatile("s_waitcnt vmcnt(0)" ::: "memory");
    __syncthreads();
    if (tid == 0) {
        unsigned* bar = b.bar;
        __builtin_amdgcn_s_waitcnt(0);
        unsigned nloc = b.st[0], nx = b.st[1];
        if (nloc == 0u) { xcd_barrier_complete(bar, b.x, nloc, nx); b.st[0] = nloc; b.st[1] = nx; }
        const unsigned old = xb_add(&bar[XB_XSUB(b.x)], 1u);
        const unsigned gen = old / nloc;
        if (old + 1u == (gen + 1u) * nloc) {
            __builtin_amdgcn_fence(__ATOMIC_RELEASE, "agent");
            asm volatile("s_waitcnt vmcnt(0)" ::: "memory");
            const unsigned og = xb_add(&bar[XB_TOP], 1u);
            const unsigned tg = og / nx;
            if (og + 1u == (tg + 1u) * nx) xb_add(&bar[XB_TOPGEN], 1u);
            else XB_SPIN(xb_ld(&bar[XB_TOPGEN]) == tg, bar);
            __builtin_amdgcn_fence(__ATOMIC_ACQUIRE, "agent");
            xb_add(&bar[XB_XGEN(b.x)], 1u);
            asm volatile("s_waitcnt vmcnt(0)" ::: "memory");
        } else {
            XB_SPIN(xb_ld(&bar[XB_XGEN(b.x)]) == gen, bar);
            __builtin_amdgcn_fence(__ATOMIC_ACQUIRE, "agent");
            asm volatile("s_waitcnt vmcnt(0)" ::: "memory");
        }
    }
    __syncthreads();
}
__global__ void __launch_bounds__(NWAVES * 64, 2) yoco_fwd(Args args) {
    extern __shared__ __attribute__((aligned(16))) unsigned char lds[];
    cg::grid_group grid = cg::this_grid();
    const int wave0 = __builtin_amdgcn_readfirstlane((int)threadIdx.x >> 6);
    const int G = gridDim.x, bx0 = blockIdx.x;
#define ARGP(i) argp(i)
#define x_in ((const float*)ARGP(0))
#define mem_in ((const float*)ARGP(1))
#define positions ((const int*)ARGP(2))
#define norm_g ((const float*)ARGP(3))
#define ffn_w13 ((const float*)ARGP(4))
#define ffn_w2 ((const float*)ARGP(5))
#define w_out ((const float*)ARGP(6))
#define mem_norm_g ((const float*)ARGP(7))
#define w_mem_kv ((const float*)ARGP(8))
#define g_mem_q ((const float*)ARGP(9))
#define g_mem_k ((const float*)ARGP(10))
#define conv_w_in ((const float*)ARGP(11))
#define conv_w ((const float*)ARGP(12))
#define mla_w_in ((const float*)ARGP(13))
#define g_q_lora ((const float*)ARGP(14))
#define w_uq ((const float*)ARGP(15))
#define g_q_nope ((const float*)ARGP(16))
#define g_q_rope ((const float*)ARGP(17))
#define kv_norm_g ((const float*)ARGP(18))
#define w_dkv ((const float*)ARGP(19))
#define g_ckv ((const float*)ARGP(20))
#define w_ukv ((const float*)ARGP(21))
#define w_kr ((const float*)ARGP(22))
#define g_k_nope ((const float*)ARGP(23))
#define g_k_rope ((const float*)ARGP(24))
#define X ((float*)ARGP(25))
#define WSB ((unsigned char*)ARGP(26))
#define W13T ((bf16*)(WSB + WS_W13))
#define W2T ((bf16*)(WSB + WS_W2))
#define WOUTT ((bf16*)(WSB + WS_WOUT))
#define CONVINT ((bf16*)(WSB + WS_CONVIN))
#define MLAINT ((bf16*)(WSB + WS_MLAIN))
#define WUQT ((bf16*)(WSB + WS_WUQ))
#define WKV1T ((bf16*)(WSB + WS_WKV1))
#define WKV2T ((bf16*)(WSB + WS_WKV2))
#define WMEMKVT ((bf16*)(WSB + WS_WMEMKV))
#define SSQ ((float*)(WSB + WS_SSQ))
#define CSSQ ((float*)(WSB + WS_CSSQ))
#define MEMB ((bf16*)(WSB + WS_MEMB))
#define MEMSSQ ((float*)(WSB + WS_MEMSSQ))
#define MEMKVRAW ((bf16*)(WSB + WS_MEMKVRAW))
#define KMEM ((bf16*)(WSB + WS_KMEM))
#define VMEM ((bf16*)(WSB + WS_VMEM))
#define XB ((bf16*)(WSB + WS_XB))
#define ACT ((bf16*)(WSB + WS_ACT))
#define MIX ((bf16*)(WSB + WS_MIX))
#define KVB ((bf16*)(WSB + WS_KVB))
#define KRB ((bf16*)(WSB + WS_KR))
#define PCONV ACT
#define CQRAW ACT
#define QRAW ((bf16*)(WSB + WS_ACT + ACT_QRAW))
#define CKVRAW ACT
    LAS unsigned char* ldsl = (LAS unsigned char*)lds;

    bool probe_done = false; (void)probe_done;
    volatile LAS unsigned* MISC = (volatile LAS unsigned*)(ldsl + MISC_OFF);
    if (threadIdx.x < 4) MISC[threadIdx.x] = 0u;
    __syncthreads();
    XcdBarrier xbar; xbar.bar = nullptr; xbar.x = 0; xbar.st = MISC;
    if (args.hi - args.lo > 1) xbar = xcd_barrier_post((unsigned*)(WSB + WS_CTL), MISC);
    for (int ph = args.lo; ph < args.hi; ++ph) {
        int wave = wave0, bx = bx0; asm volatile("" : "+s"(wave)); asm volatile("" : "+s"(bx));
        int lane = (int)__builtin_amdgcn_mbcnt_hi(~0u, __builtin_amdgcn_mbcnt_lo(~0u, 0u)); asm volatile("" : "+v"(lane)); const int tid = wave * 64 + lane; const int vcu = (G % 8 == 0) ? (bx % 8) * (G / 8) + bx / 8 : bx; const int gw = vcu * NWAVES + wave, NGW = G * NWAVES;
        int type, layer = 0, sub = 0;
        enum { PH_PREP, PH_MEMKV, PH_GLUE_MEM, PH_G1, PH_G2, PH_CONVIN, PH_CONVMIX, PH_WOUT, PH_KV1, PH_KV2, PH_GLUE_KV, PH_MLAIN, PH_UQ, PH_MLAATT };
        if (ph < 3) type = ph == 0 ? PH_PREP : (ph == 1 ? PH_MEMKV : PH_GLUE_MEM);
        else if (ph < 17) { const int q = ph - 3; layer = q / 7; const int st = q % 7;
            type = st == 0 ? PH_G1 : st == 1 ? PH_G2 : st == 2 ? PH_CONVIN : st == 3 ? PH_CONVMIX : st == 4 ? PH_WOUT : st == 5 ? PH_G1 : PH_G2; sub = st >= 5 ? 1 : 0; }
        else if (ph < 20) type = ph == 17 ? PH_KV1 : (ph == 18 ? PH_KV2 : PH_GLUE_KV);
        else { const int q = ph - 20; layer = 2 + q / 8; const int st = q % 8;
            type = st == 0 ? PH_G1 : st == 1 ? PH_G2 : st == 2 ? PH_MLAIN : st == 3 ? PH_UQ : st == 4 ? PH_MLAATT : st == 5 ? PH_WOUT : st == 6 ? PH_G1 : PH_G2; sub = st >= 6 ? 1 : 0; }

        if (type == PH_PREP) {
            LAS float* scr = (LAS float*)(ldsl + wave * 16640);
            for (int job = 0; job < 33; ++job) {
                const float* W; const float* g = nullptr; int K, Nsrc, Ndst, mode = MAP_PLAIN; bf16* dst;
                if (job < 8) { const int l = job >> 1, s = job & 1; W = ffn_w13 + (size_t)job * DM * N13; g = norm_g + (size_t)(l * 3 + (s ? 2 : 0)) * DM; K = DM; Nsrc = N13; Ndst = N13; mode = MAP_GATEUP; dst = W13T + (size_t)job * N13 * DM; }
                else if (job < 16) { const int j = job - 8; W = ffn_w2 + (size_t)j * FF * DM; K = FF; Nsrc = DM; Ndst = DM; dst = W2T + (size_t)j * DM * FF; }
                else if (job < 20) { const int l = job - 16; W = w_out + (size_t)l * DM * DM; K = DM; Nsrc = DM; Ndst = DM; dst = WOUTT + (size_t)l * DM * DM; }
                else if (job < 22) { const int l = job - 20; W = conv_w_in + (size_t)l * DM * NCONV; g = norm_g + (size_t)(l * 3 + 1) * DM; K = DM; Nsrc = NCONV; Ndst = NCONV; mode = MAP_CONVIN; dst = CONVINT + (size_t)l * NCONV * DM; }
                else if (job < 24) { const int j = job - 22; W = mla_w_in + (size_t)j * DM * 640; g = norm_g + (size_t)((2 + j) * 3 + 1) * DM; K = DM; Nsrc = 640; Ndst = NMLA; dst = MLAINT + (size_t)j * NMLA * DM; }
                else if (job < 26) { const int j = job - 24; W = w_uq + (size_t)j * 384 * 1152; g = g_q_lora + j * 384; K = 384; Nsrc = 1152; Ndst = NUQ; dst = WUQT + (size_t)j * (MiB / 2); }
                else if (job == 26) { W = w_dkv; g = kv_norm_g; K = DM; Nsrc = 256; Ndst = 256; dst = WKV1T; }
                else if (job == 27) { W = w_kr; g = kv_norm_g; K = DM; Nsrc = 64; Ndst = 256; dst = WKV1T + (size_t)256 * DM; }
                else if (job == 28) { W = w_ukv; g = g_ckv; K = 256; Nsrc = NKV2; Ndst = NKV2; dst = WKV2T; }
                else { const int l = job - 29; W = w_mem_kv + (size_t)l * DM * 512; g = mem_norm_g + l * DM; K = DM; Nsrc = 512; Ndst = 512; dst = WMEMKVT + (size_t)l * 512 * DM; }
                const bool f16w = job < 8 || (job >= 20 && job < 24) || job == 26 || job == 27;
                prep_weight(W, g, K, Nsrc, dst, Ndst, mode, f16w, scr, gw, NGW, lane);
            }
            for (int m = gw; m < T; m += NGW) row_to_bf16(x_in + (size_t)m * DM, true, XB + (size_t)m * DM, SSQ + (size_t)m * 16, 16, lane);
            for (int m = gw; m < MEMROWS; m += NGW) row_to_bf16(mem_in + (size_t)m * DM, false, MEMB + (size_t)m * DM, MEMSSQ + (size_t)m * 4, 4, lane);
        }
        else if (type == PH_GLUE_MEM) {
            for (int it = gw; it < 4 * MEMROWS * 4; it += NGW) { const int h = it & 3, row = (it >> 2) % MEMROWS, l = it / (4 * MEMROWS); const int b = row >> 8, m = row & 255;
                const float kv = bf2f(MEMKVRAW[(size_t)row * NMEMKV + l * 512 + h * 64 + lane]); const unsigned short vv = MEMKVRAW[(size_t)row * NMEMKV + l * 512 + 256 + h * 64 + lane];
                const float ss = wave_sum(kv * kv); const float kn = kv * __builtin_amdgcn_rsqf(ss * (1.0f / 64.0f) + EPS) * g_mem_k[l * 64 + lane];
                const size_t o = ((((size_t)l * NBATCH + b) * 4 + h) * 256 + m) * 128;
                KMEM[o + lane] = (bf16)f2bf(kn); KMEM[o + 64 + lane] = 0; VMEM[o + lane] = vv; VMEM[o + 64 + lane] = 0; }
        }
        else if (type == PH_GLUE_KV) {
            const int j16 = lane & 15;
            const f32x4 gn0 = *(const f32x4*)(g_k_nope + 8 * j16), gn1 = *(const f32x4*)(g_k_nope + 8 * j16 + 4), gr = *(const f32x4*)(g_k_rope + 4 * j16);
            for (int t4 = gw; t4 < T / 4; t4 += NGW) {
                const int t = t4 * 4 + (lane >> 4); const int pos = positions[t];
                bf16* kvp = KVB + (size_t)t * NKV2 + 8 * j16;
                bf16x8 kv[6];
#pragma unroll
                for (int h = 0; h < 6; ++h) kv[h] = *(const bf16x8*)(kvp + h * 256);
                const v2u krw = *(const v2u*)(CKVRAW + (size_t)t * NKV1 + 256 + 4 * j16);
#pragma unroll
                for (int h = 0; h < 6; ++h) { float f[8]; float ss = 0.f;
#pragma unroll
                    for (int e = 0; e < 8; ++e) { f[e] = bf2f((unsigned short)kv[h][e]); ss += f[e] * f[e]; }
                    ss += pg8::swz_xor<1>(ss); ss += pg8::swz_xor<2>(ss); ss += pg8::swz_xor<4>(ss); ss += pg8::swz_xor<8>(ss);
                    const float rs = __builtin_amdgcn_rsqf(ss * (1.0f / 128.0f) + EPS);
                    v4u w; w.x = pk2(f[0] * rs * gn0[0], f[1] * rs * gn0[1]); w.y = pk2(f[2] * rs * gn0[2], f[3] * rs * gn0[3]); w.z = pk2(f[4] * rs * gn1[0], f[5] * rs * gn1[1]); w.w = pk2(f[6] * rs * gn1[2], f[7] * rs * gn1[3]);
                    *(v4u*)(kvp + h * 256) = w; }
                { float x[4] = {pg8::bf_lo(krw.x), pg8::bf_hi(krw.x), pg8::bf_lo(krw.y), pg8::bf_hi(krw.y)};
                  float ss = (x[0] * x[0] + x[1] * x[1]) + (x[2] * x[2] + x[3] * x[3]);
                  ss += pg8::swz_xor<1>(ss); ss += pg8::swz_xor<2>(ss); ss += pg8::swz_xor<4>(ss); ss += pg8::swz_xor<8>(ss);
                  const float rs = __builtin_amdgcn_rsqf(ss * (1.0f / 64.0f) + EPS); float y[4];
#pragma unroll
                  for (int e = 0; e < 4; ++e) { const float mine = x[e] * rs * gr[e], other = pg8::swz_xor<8>(mine); float c, sn; rope_cs(pos, 4 * (j16 & 7) + e, c, sn);
                      y[e] = j16 < 8 ? mine * c - other * sn : mine * c + other * sn; }
                  v2u w; w.x = pk2(y[0], y[1]); w.y = pk2(y[2], y[3]); *(v2u*)(KRB + (size_t)t * 64 + 4 * j16) = w; }
            }
        }
#ifndef NO_GEMM
        else if (type == PH_G1) {
            pg8::Gemm g{XB, W13T + (size_t)(layer * 2 + sub) * N13 * DM, T, N13, DM, DM}; pg8::StaticOrder S; S.init(T, N13, G, bx);
            if (lane == 0) ((LAS int*)(ldsl + 131072 + 4096))[wave] = -1;
            LDS_WAIT();
            pg8::EpiSwiglu E{ACT, FF, SSQ, ldsl};
#ifndef NO_G1
            pg8::gemm_phase<pg8::EpiSwiglu, pg8::StaticOrder, true, true, true>(ldsl, g, S, E, tid);
#endif
        }
        else if (type == PH_G2 || type == PH_WOUT) {
            const bool isw = type == PH_WOUT;
            pg8::Gemm g{isw ? MIX : ACT, isw ? WOUTT + (size_t)layer * DM * DM : W2T + (size_t)(layer * 2 + sub) * DM * FF, T, DM, isw ? DM : FF, isw ? DM : FF}; pg8::StaticOrder S; S.init(T, DM, G, bx);
            float alpha_ = isw ? 1.0f : 0.5f;
#ifdef PROBE_TYPE
            if (type == PROBE_TYPE) alpha_ *= 0.5f;
#endif
            pg8::EpiResid E{ph == 35 ? X : nullptr, (_Float16*)XB, SSQ, alpha_};
#ifndef NO_G2
            pg8::gemm_phase<pg8::EpiResid, pg8::StaticOrder, true, true>(ldsl, g, S, E, tid);
#endif
        }
        else if (type == PH_MEMKV || type == PH_CONVIN || type == PH_MLAIN || type == PH_UQ || type == PH_KV1 || type == PH_KV2) {
            pg8::Gemm g; pg8::EpiGen E; int M_ = T;
            if (type == PH_MEMKV) { g = pg8::Gemm{MEMB, WMEMKVT, MEMROWS, NMEMKV, DM, DM}; M_ = MEMROWS; E = pg8::EpiGen{MEMKVRAW, NMEMKV, MEMSSQ, 4, 4, 1.0f / 1024.0f, 0, 0, nullptr, 0, ldsl}; }
            else if (type == PH_CONVIN) { g = pg8::Gemm{XB, CONVINT + (size_t)layer * NCONV * DM, T, NCONV, DM, DM}; E = pg8::EpiGen{PCONV, PSTRIDE, SSQ, 16, 16, 1.0f / 1024.0f, 6, 768, nullptr, 0, ldsl}; }
            else if (type == PH_MLAIN) { g = pg8::Gemm{XB, MLAINT + (size_t)(layer - 2) * NMLA * DM, T, NMLA, DM, DM}; E = pg8::EpiGen{CQRAW, NMLA, SSQ, 16, 16, 1.0f / 1024.0f, 0, 0, CSSQ, 24, ldsl}; }
            else if (type == PH_UQ) { g = pg8::Gemm{CQRAW, WUQT + (size_t)(layer - 2) * (MiB / 2), T, NUQ, 384, NMLA}; E = pg8::EpiGen{QRAW, NUQ, CSSQ, 24, 12, 1.0f / 384.0f, 0, 0, nullptr, 0, ldsl}; }
            else if (type == PH_KV1) { g = pg8::Gemm{XB, WKV1T, T, NKV1, DM, DM}; E = pg8::EpiGen{CKVRAW, NKV1, SSQ, 16, 16, 1.0f / 1024.0f, 0, 0, CSSQ, 16, ldsl}; }
            else { g = pg8::Gemm{CKVRAW, WKV2T, T, NKV2, 256, NKV1}; E = pg8::EpiGen{KVB, NKV2, CSSQ, 16, 8, 1.0f / 256.0f, 0, 0, nullptr, 0, ldsl}; }
            pg8::StaticOrder S; S.init(M_, g.N, G, bx);
            if (lane == 0) ((LAS int*)(ldsl + 131072 + 4096))[wave] = -1;
            LDS_WAIT();
#ifndef NO_GEN
            if (type == PH_CONVIN || type == PH_MLAIN || type == PH_KV1) pg8::gemm_phase<pg8::EpiGen, pg8::StaticOrder, true, true, true>(ldsl, g, S, E, tid);
            else pg8::gemm_phase<pg8::EpiGen, pg8::StaticOrder, true, true, false>(ldsl, g, S, E, tid);
#endif
        }
#endif
        else if (type == PH_CONVMIX || type == PH_MLAATT) {
            const int W = 1 << 20;
            if (type == PH_CONVMIX) {
                const float* cw = conv_w + (size_t)layer * 3 * 768;
                for (int idx = bx * (NWAVES * 64) + tid; idx < T * 96; idx += G * NWAVES * 64) { const int t = idx / 96, c8 = (idx % 96) * 8, s = t & (SEQ - 1);
                    const bf16* up = PCONV + (size_t)t * PSTRIDE + c8; const bf16x8 u0 = *(const bf16x8*)up; const bf16x8 gb = *(const bf16x8*)(up + 768);
                    bf16x8 u1 = {0, 0, 0, 0, 0, 0, 0, 0}, u2 = {0, 0, 0, 0, 0, 0, 0, 0};
                    if (s >= 1) u1 = *(const bf16x8*)(up - PSTRIDE); if (s >= 2) u2 = *(const bf16x8*)(up - 2 * PSTRIDE);
                    float y[8];
#pragma unroll
                    for (int j = 0; j < 8; ++j) { const float acc = cw[c8 + j] * bf2f((unsigned short)u2[j]) + cw[768 + c8 + j] * bf2f((unsigned short)u1[j]) + cw[1536 + c8 + j] * bf2f((unsigned short)u0[j]);
                        y[j] = bf2f((unsigned short)gb[j]) * acc; }
                    v4u o; o.x = pk2(y[0], y[1]); o.y = pk2(y[2], y[3]); o.z = pk2(y[4], y[5]); o.w = pk2(y[6], y[7]);
                    *(v4u*)(MIX + (size_t)t * DM + c8) = o; }
            } else {
#ifndef NO_MLA
                const int j = layer - 2; const float* gqn = g_q_nope + j * 128; const float* gqr = g_q_rope + j * 64;
                for (int L = vcu; L < 768; L += G)
                    for (int pass = 0; pass < 2; ++pass) {
                        att::BlockRef cur;
                        { const int bh_ = L >> 4, x_ = L & 15, b_ = bh_ / 6, h_ = bh_ % 6, qb_ = pass ? 31 - x_ : x_; const size_t t0_ = (size_t)b_ * SEQ + (size_t)qb_ * 256;
                          cur.Q = QRAW + t0_ * NUQ + h_ * 192; cur.K = KVB + (size_t)b_ * SEQ * NKV2 + h_ * 256; cur.V = cur.K + 128; cur.KR = KRB + (size_t)b_ * SEQ * 64;
                          cur.O = MIX + t0_ * DM + h_ * 128; cur.P0 = qb_ * 256; cur.qs = NUQ; cur.tok = (int)t0_; cur.pad = 0; }
                        bf16x8 qr[12];
                        const int r32 = lane & 31, hi = lane >> 5; const int pos = positions[cur.tok + wave * 32 + r32];
#pragma unroll
                        for (int d0 = 0; d0 < 12; ++d0) qr[d0] = att::load8(cur.Q + (size_t)(wave * 32 + r32) * NUQ + d0 * 16 + hi * 8);
                        { float ss = 0.f;
#pragma unroll
                          for (int d0 = 0; d0 < 8; ++d0)
#pragma unroll
                              for (int e = 0; e < 8; ++e) { const float v = bf2f((unsigned short)qr[d0][e]); ss += v * v; }
                          ss = pg8::add_xor32(ss); const float rn = __builtin_amdgcn_rsqf(ss * (1.0f / 128.0f) + EPS) * 0.07216878364870322f;
#pragma unroll
                          for (int d0 = 0; d0 < 8; ++d0) { const f32x4 g0 = *(const f32x4*)(gqn + d0 * 16 + hi * 8), g1 = *(const f32x4*)(gqn + d0 * 16 + hi * 8 + 4); v4u w;
                              w.x = pk2(bf2f((unsigned short)qr[d0][0]) * rn * g0[0], bf2f((unsigned short)qr[d0][1]) * rn * g0[1]); w.y = pk2(bf2f((unsigned short)qr[d0][2]) * rn * g0[2], bf2f((unsigned short)qr[d0][3]) * rn * g0[3]);
                              w.z = pk2(bf2f((unsigned short)qr[d0][4]) * rn * g1[0], bf2f((unsigned short)qr[d0][5]) * rn * g1[1]); w.w = pk2(bf2f((unsigned short)qr[d0][6]) * rn * g1[2], bf2f((unsigned short)qr[d0][7]) * rn * g1[3]);
                              qr[d0] = *reinterpret_cast<bf16x8*>(&w); __builtin_amdgcn_sched_barrier(0); }
                          float s2 = 0.f;
#pragma unroll
                          for (int d0 = 8; d0 < 12; ++d0)
#pragma unroll
                              for (int e = 0; e < 8; ++e) { const float v = bf2f((unsigned short)qr[d0][e]); s2 += v * v; }
                          s2 = pg8::add_xor32(s2); const float rr = __builtin_amdgcn_rsqf(s2 * (1.0f / 64.0f) + EPS) * 0.07216878364870322f;
#pragma unroll
                          for (int d0 = 0; d0 < 2; ++d0) { float y1[8], y2[8];
#pragma unroll
                              for (int e = 0; e < 8; ++e) { const int i = d0 * 16 + hi * 8 + e; const float a = bf2f((unsigned short)qr[8 + d0][e]) * rr * gqr[i], b2 = bf2f((unsigned short)qr[10 + d0][e]) * rr * gqr[32 + i];
                                  float c, s; rope_cs(pos, i, c, s); y1[e] = a * c - b2 * s; y2[e] = b2 * c + a * s; __builtin_amdgcn_sched_barrier(0); }
                              v4u w1, w2; w1.x = pk2(y1[0], y1[1]); w1.y = pk2(y1[2], y1[3]); w1.z = pk2(y1[4], y1[5]); w1.w = pk2(y1[6], y1[7]);
                              w2.x = pk2(y2[0], y2[1]); w2.y = pk2(y2[2], y2[3]); w2.z = pk2(y2[4], y2[5]); w2.w = pk2(y2[6], y2[7]);
                              qr[8 + d0] = *reinterpret_cast<bf16x8*>(&w1); qr[10 + d0] = *reinterpret_cast<bf16x8*>(&w2); } }
                        att::attn_run<0>(cur, qr, SEQ, W, (char*)lds, tid);
                    }
#endif
            }
#ifndef NO_MEM
            {
                const bf16* QM = type == PH_CONVMIX ? PCONV + 1536 : CQRAW + 384; const int qs = type == PH_CONVMIX ? PSTRIDE : NMLA;
                const float* gq = g_mem_q + layer * 64;
                for (int L = vcu; L < 1024; L += G) {
                    att::BlockRef cur;
                    { const int tt_ = L >> 2, h_ = L & 3, b_ = tt_ >> 5; const size_t t0_ = (size_t)tt_ * 256; const size_t kvo_ = (((size_t)layer * NBATCH + b_) * 4 + h_) * 256 * 128;
                      cur.Q = QM + t0_ * qs + h_ * 64; cur.K = KMEM + kvo_; cur.V = VMEM + kvo_; cur.KR = nullptr; cur.O = MIX + t0_ * DM + 768 + h_ * 64; cur.P0 = 256; cur.qs = qs; cur.tok = (int)t0_; cur.pad = 0; }
                    bf16x8 qr[4]; const int r32 = lane & 31, hi = lane >> 5;
#pragma unroll
                    for (int d0 = 0; d0 < 4; ++d0) qr[d0] = att::load8(cur.Q + (size_t)(wave * 32 + r32) * qs + d0 * 16 + hi * 8);
                    { float ss = 0.f;
#pragma unroll
                      for (int d0 = 0; d0 < 4; ++d0)
#pragma unroll
                          for (int e = 0; e < 8; ++e) { const float v = bf2f((unsigned short)qr[d0][e]); ss += v * v; }
                      ss = pg8::add_xor32(ss); const float rn = __builtin_amdgcn_rsqf(ss * (1.0f / 64.0f) + EPS) * 0.125f;
#pragma unroll
                      for (int d0 = 0; d0 < 4; ++d0) { const f32x4 g0 = *(const f32x4*)(gq + d0 * 16 + hi * 8), g1 = *(const f32x4*)(gq + d0 * 16 + hi * 8 + 4); v4u w;
                          w.x = pk2(bf2f((unsigned short)qr[d0][0]) * rn * g0[0], bf2f((unsigned short)qr[d0][1]) * rn * g0[1]); w.y = pk2(bf2f((unsigned short)qr[d0][2]) * rn * g0[2], bf2f((unsigned short)qr[d0][3]) * rn * g0[3]);
                          w.z = pk2(bf2f((unsigned short)qr[d0][4]) * rn * g1[0], bf2f((unsigned short)qr[d0][5]) * rn * g1[1]); w.w = pk2(bf2f((unsigned short)qr[d0][6]) * rn * g1[2], bf2f((unsigned short)qr[d0][7]) * rn * g1[3]);
                          qr[d0] = *reinterpret_cast<bf16x8*>(&w); } }
                    att::attn_run<1>(cur, qr, 256, W, (char*)lds, tid);
                }
            }
#endif
        }
        bool again = false;
#ifdef PROBE_TYPE
        if (type == PROBE_TYPE && !probe_done) { probe_done = true; again = true; } else probe_done = false;
#endif
        if (again || ph + 1 < args.hi) { if (ph == 0 && !again) grid.sync(); else xcd_barrier(xbar, tid); }
#ifdef PROBE_SYNC
        if (again || ph + 1 < args.hi) xcd_barrier(xbar, tid);
#endif
        if (again) --ph;
    }
}

extern "C" void kernel_launch(void* const* d_in, const int* in_sizes, int n_in, void* d_out, int out_size, void* d_ws, size_t ws_size, hipStream_t stream) {
    static int grid = 0;
    constexpr int NPHASE = 36;
    if (grid == 0) {
        if (n_in != 25 || in_sizes[0] != T * DM || out_size != T * DM || ws_size < WS_END) { fprintf(stderr, "kernel_launch: unexpected shapes (n_in %d, in0 %d, out %d, ws %zu, need %zu)\n", n_in, n_in > 0 ? in_sizes[0] : -1, out_size, ws_size, (size_t)WS_END); grid = -1; return; }
        int dev = 0, cus = 0, per_cu = 0;
        if (hipGetDevice(&dev) != hipSuccess || hipDeviceGetAttribute(&cus, hipDeviceAttributeMultiprocessorCount, dev) != hipSuccess) { grid = -1; return; }
        if (hipFuncSetAttribute((const void*)yoco_fwd, hipFuncAttributeMaxDynamicSharedMemorySize, LDS_BYTES) != hipSuccess) { fprintf(stderr, "kernel_launch: hipFuncSetAttribute failed\n"); grid = -1; return; }
        if (hipOccupancyMaxActiveBlocksPerMultiprocessor(&per_cu, (const void*)yoco_fwd, NWAVES * 64, LDS_BYTES) != hipSuccess || per_cu < 1) { fprintf(stderr, "kernel_launch: occupancy query says %d\n", per_cu); per_cu = 1; }
        (void)hipGetLastError();
        grid = cus;
    }
    if (grid < 0) return;
    Args a{};
    for (int i = 0; i < 25; ++i) a.in[i] = d_in[i];
    a.out = (float*)d_out; a.ws = (unsigned char*)d_ws;
#if MK_N_LAUNCHES == 1
    if (hipMemsetAsync((char*)d_ws + WS_CTL, 0, CTL_BYTES, stream) != hipSuccess) { fprintf(stderr, "kernel_launch: memset of the barrier words failed\n"); return; }
    a.lo = 0; a.hi = NPHASE;
    void* kargs[] = {&a};
    hipError_t e = hipLaunchCooperativeKernel((const void*)yoco_fwd, dim3(grid), dim3(NWAVES * 64), kargs, LDS_BYTES, stream);
    if (e != hipSuccess) fprintf(stderr, "kernel_launch: cooperative launch failed: %s (grid %d)\n", hipGetErrorString(e), grid);
#else
    for (int p = 0; p < NPHASE; ++p) { a.lo = p; a.hi = p + 1; hipLaunchKernelGGL(yoco_fwd, dim3(grid), dim3(NWAVES * 64), LDS_BYTES, stream, a); }
#endif
}
```
